# Optimizing an MI355X kernel written in HIP

```python
import jax, jax.numpy as jnp
from jax import lax
import numpy as np

D_MODEL = 1024
BATCH = 16
SEQ = 4096
DEPTH = 4

MIX_WIDTH = D_MODEL
POOL_CH = D_MODEL // 4
POOL_GROUPS = 4
POOL_GROUP_DIM = POOL_CH // POOL_GROUPS
POOL_WINDOWS = (2, 4, 8, 16)
CONV_CH = D_MODEL // 4
DW_CONV_LEN = 31
MEM_TOKENS = 256
MEM_HEADS = 4
MEM_CH = D_MODEL // 2
MEM_HEAD_DIM = MEM_CH // MEM_HEADS
IN_PROJ_WIDTH = POOL_CH + 2 * CONV_CH + MEM_CH
N_EXPERTS = 64
TOP_K = 8
EXPERT_DIM = D_MODEL // 4
SHARED_DIM = D_MODEL // 4
ROUTED_SCALE = 2.5
MOE_BLOCK = 128
LN_EPS = 1e-5
DEEPNORM_ALPHA = float((2 * DEPTH) ** 0.25)
DEEPNORM_BETA = float((8 * DEPTH) ** -0.25)

kernel_name = "hymba_pool_conformer_memattn_moe_deepnorm"


def layer_norm(x, g, b):
    xf = x.astype(jnp.float32)
    mu = jnp.mean(xf, axis=-1, keepdims=True)
    var = jnp.mean(jnp.square(xf - mu), axis=-1, keepdims=True)
    y = (xf - mu) * lax.rsqrt(var + LN_EPS) * g.astype(jnp.float32) + b.astype(jnp.float32)
    return y.astype(x.dtype)


def pool_mixer(u, w_pool, pool_scale):
    bsz, seq, _ = u.shape
    uf = u.astype(jnp.float32)
    csum = jnp.concatenate([jnp.zeros_like(uf[:, :1]), jnp.cumsum(uf, axis=1)], axis=1)
    t = jnp.arange(seq)
    pooled = []
    for g, w in enumerate(POOL_WINDOWS):
        lo = w // 2
        hi = w - 1 - lo
        start = jnp.clip(t - lo, 0, seq)
        end = jnp.clip(t + hi + 1, 0, seq)
        cs = csum[:, :, g * POOL_GROUP_DIM:(g + 1) * POOL_GROUP_DIM]
        win_sum = jnp.take(cs, end, axis=1) - jnp.take(cs, start, axis=1)
        cnt = (end - start).astype(jnp.float32)[None, :, None]
        pooled.append(win_sum / cnt)
    pooled = jnp.stack(pooled, axis=2)
    diff = pooled - uf.reshape(bsz, seq, POOL_GROUPS, POOL_GROUP_DIM)
    mixed = jnp.einsum('bsgc,gcd->bsgd', diff, w_pool.astype(jnp.float32))
    out = mixed.reshape(bsz, seq, POOL_CH) * pool_scale.astype(jnp.float32)
    return out.astype(u.dtype)


def conv_mixer(v, w_dw, b_dw, g_cn, b_cn):
    a, gate = jnp.split(v, 2, axis=-1)
    glu = a * jax.nn.sigmoid(gate)
    pad = DW_CONV_LEN // 2
    y = lax.conv_general_dilated(
        glu, w_dw[:, None, :].astype(glu.dtype), window_strides=(1,), padding=[(pad, pad)],
        dimension_numbers=('NWC', 'WIO', 'NWC'), feature_group_count=CONV_CH) + b_dw
    return jax.nn.silu(layer_norm(y, g_cn, b_cn))


def mem_attention(q, mem_n, w_kv):
    bsz, seq, _ = q.shape
    kv = mem_n @ w_kv
    k, v = jnp.split(kv, 2, axis=-1)
    q = q.reshape(bsz, seq, MEM_HEADS, MEM_HEAD_DIM)
    k = k.reshape(bsz, -1, MEM_HEADS, MEM_HEAD_DIM)
    v = v.reshape(bsz, -1, MEM_HEADS, MEM_HEAD_DIM)
    s = jnp.einsum('bshd,bmhd->bhsm', q, k).astype(jnp.float32) * (MEM_HEAD_DIM ** -0.5)
    p = jax.nn.softmax(s, axis=-1).astype(v.dtype)
    o = jnp.einsum('bhsm,bmhd->bshd', p, v)
    return o.reshape(bsz, seq, MEM_CH)


def swiglu(x, wg, wu, wd):
    return (jax.nn.silu(x @ wg) * (x @ wu)) @ wd


def moe(x, w_router, router_bias, w_gate, w_up, w_down, w_gate_sh, w_up_sh, w_down_sh):
    bsz, seq, d = x.shape
    n_tok = bsz * seq
    xt = x.reshape(n_tok, d)
    scores = jax.nn.sigmoid((xt @ w_router).astype(jnp.float32))
    _, idx = lax.top_k(scores + router_bias.astype(jnp.float32), TOP_K)
    sel = jnp.take_along_axis(scores, idx, axis=-1)
    gates = sel / jnp.sum(sel, axis=-1, keepdims=True) * ROUTED_SCALE

    n_assign = n_tok * TOP_K
    e_flat = idx.reshape(-1)
    tok_flat = jnp.arange(n_assign, dtype=jnp.int32) // TOP_K
    gate_flat = gates.reshape(-1)
    order = jnp.argsort(e_flat)
    e_sorted = e_flat[order]
    counts = jnp.bincount(e_flat, length=N_EXPERTS)
    starts = jnp.cumsum(counts) - counts
    padded = (counts + MOE_BLOCK - 1) // MOE_BLOCK * MOE_BLOCK
    padded_end = jnp.cumsum(padded)
    padded_start = padded_end - padded
    dest = padded_start[e_sorted] + jnp.arange(n_assign, dtype=jnp.int32) - starts[e_sorted]
    n_blocks = -(-n_assign // MOE_BLOCK) + N_EXPERTS
    buf_len = n_blocks * MOE_BLOCK
    tok_buf = jnp.full((buf_len,), n_tok, jnp.int32).at[dest].set(tok_flat[order])
    gate_buf = jnp.zeros((buf_len,), jnp.float32).at[dest].set(gate_flat[order])
    block_expert = jnp.minimum(
        jnp.searchsorted(padded_end, jnp.arange(n_blocks) * MOE_BLOCK, side='right'), N_EXPERTS - 1)
    x_pad = jnp.concatenate([xt, jnp.zeros((1, d), xt.dtype)], axis=0)

    def expert_block(acc, blk):
        tok, g, e = blk
        xb = x_pad[tok]
        h = jax.nn.silu(xb @ w_gate[e]) * (xb @ w_up[e])
        y = (h @ w_down[e]) * g[:, None].astype(xb.dtype)
        return acc.at[tok].add(y), None

    routed, _ = lax.scan(
        expert_block, jnp.zeros_like(x_pad),
        (tok_buf.reshape(n_blocks, MOE_BLOCK), gate_buf.reshape(n_blocks, MOE_BLOCK), block_expert))
    shared = swiglu(xt, w_gate_sh, w_up_sh, w_down_sh)
    return (routed[:n_tok] + shared).reshape(bsz, seq, d)


def setup_inputs(seed: int = 0) -> dict:
    key = jax.random.key(seed)
    ks = jax.random.split(key, 26)
    f32 = jnp.float32
    nrm = lambda k, shape, scale: jax.random.normal(k, shape, f32) * scale
    L = DEPTH
    return {
        "x": nrm(ks[0], (BATCH, SEQ, D_MODEL), 1.0),
        "mem": nrm(ks[1], (BATCH, MEM_TOKENS, D_MODEL), 1.0),
        "w_in": nrm(ks[2], (L, D_MODEL, IN_PROJ_WIDTH), D_MODEL ** -0.5),
        "w_pool": nrm(ks[3], (L, POOL_GROUPS, POOL_GROUP_DIM, POOL_GROUP_DIM), POOL_GROUP_DIM ** -0.5),
        "pool_scale": 1.0 + nrm(ks[4], (L, POOL_CH), 0.02),
        "w_dw": nrm(ks[5], (L, DW_CONV_LEN, CONV_CH), DW_CONV_LEN ** -0.5),
        "b_dw": nrm(ks[6], (L, CONV_CH), 0.02),
        "conv_norm_g": 1.0 + nrm(ks[7], (L, CONV_CH), 0.02),
        "conv_norm_b": nrm(ks[8], (L, CONV_CH), 0.02),
        "w_kv": nrm(ks[9], (L, D_MODEL, 2 * MEM_CH), D_MODEL ** -0.5),
        "w_out": nrm(ks[10], (L, MIX_WIDTH, D_MODEL), MIX_WIDTH ** -0.5 * DEEPNORM_BETA),
        "ln1_g": 1.0 + nrm(ks[11], (L, D_MODEL), 0.02),
        "ln1_b": nrm(ks[12], (L, D_MODEL), 0.02),
        "w_router": nrm(ks[13], (L, D_MODEL, N_EXPERTS), D_MODEL ** -0.5),
        "router_bias": nrm(ks[14], (L, N_EXPERTS), 0.01),
        "w_gate": nrm(ks[15], (L, N_EXPERTS, D_MODEL, EXPERT_DIM), D_MODEL ** -0.5),
        "w_up": nrm(ks[16], (L, N_EXPERTS, D_MODEL, EXPERT_DIM), D_MODEL ** -0.5),
        "w_down": nrm(ks[17], (L, N_EXPERTS, EXPERT_DIM, D_MODEL), EXPERT_DIM ** -0.5 * DEEPNORM_BETA),
        "w_gate_sh": nrm(ks[18], (L, D_MODEL, SHARED_DIM), D_MODEL ** -0.5),
        "w_up_sh": nrm(ks[19], (L, D_MODEL, SHARED_DIM), D_MODEL ** -0.5),
        "w_down_sh": nrm(ks[20], (L, SHARED_DIM, D_MODEL), SHARED_DIM ** -0.5 * DEEPNORM_BETA),
        "ln2_g": 1.0 + nrm(ks[21], (L, D_MODEL), 0.02),
        "ln2_b": nrm(ks[22], (L, D_MODEL), 0.02),
        "mem_norm_g": 1.0 + nrm(ks[23], (D_MODEL,), 0.02),
        "mem_norm_b": nrm(ks[24], (D_MODEL,), 0.02),
    }


def reference(x, mem, w_in, w_pool, pool_scale, w_dw, b_dw, conv_norm_g, conv_norm_b, w_kv, w_out,
              ln1_g, ln1_b, w_router, router_bias, w_gate, w_up, w_down, w_gate_sh, w_up_sh, w_down_sh,
              ln2_g, ln2_b, mem_norm_g, mem_norm_b):
    mem_n = layer_norm(mem, mem_norm_g, mem_norm_b)
    for l in range(DEPTH):
        proj = x @ w_in[l]
        u = proj[..., :POOL_CH]
        v = proj[..., POOL_CH:POOL_CH + 2 * CONV_CH]
        q = proj[..., POOL_CH + 2 * CONV_CH:]
        y_pool = pool_mixer(u, w_pool[l], pool_scale[l])
        y_conv = conv_mixer(v, w_dw[l], b_dw[l], conv_norm_g[l], conv_norm_b[l])
        y_mem = mem_attention(q, mem_n, w_kv[l])
        mix = jnp.concatenate([y_pool, y_conv, y_mem], axis=-1) @ w_out[l]
        x = layer_norm(DEEPNORM_ALPHA * x + mix, ln1_g[l], ln1_b[l])
        ffn = moe(x, w_router[l], router_bias[l], w_gate[l], w_up[l], w_down[l],
                  w_gate_sh[l], w_up_sh[l], w_down_sh[l])
        x = layer_norm(DEEPNORM_ALPHA * x + ffn, ln2_g[l], ln2_b[l])
    return x
```

```cpp
#include <hip/hip_runtime.h>
#include <cstdio>
#include <cstdint>

#ifndef MK_ONE_LAUNCH
#define MK_ONE_LAUNCH 0
#endif

#define LAS __attribute__((address_space(3)))
typedef unsigned short bf16;
typedef short bf16x8 __attribute__((ext_vector_type(8)));
typedef float f32x4 __attribute__((ext_vector_type(4)));
typedef float f32x2 __attribute__((ext_vector_type(2)));
typedef unsigned u32x4 __attribute__((ext_vector_type(4)));
typedef unsigned u32x2 __attribute__((ext_vector_type(2)));

constexpr int D = 1024, NBATCH = 16, SEQ = 4096, T = NBATCH * SEQ, DEPTH = 4;
constexpr int MEMT = 256, MROWS = NBATCH * MEMT;
constexpr int NPROJ = 1280, POOL_CH = 256, CONV_CH = 256, MEM_CH = 512, HEADS = 4, HD = 128;
constexpr int NE = 64, TOPK = 8, EH = 256;
constexpr int NCH = 4, CH_TOK = T / NCH, CH_SLOTS = CH_TOK * TOPK + NE * 256, CH_TILES_MAX = CH_SLOTS / 256;
constexpr int TBLK = 256, NTB = T / TBLK, TB_PER_CH = NTB / NCH;
constexpr int SH_ROW0 = NCH * CH_SLOTS;
constexpr float LN_EPS = 1e-5f;
constexpr float ALPHA = 1.6817928305074290f;
constexpr float ROUTED_SCALE = 2.5f;

constexpr size_t MiB = 1u << 20;
constexpr size_t WS_CTL = 0;
constexpr size_t CTL_BYTES = 1 * MiB;
constexpr size_t WS_TAB = WS_CTL + CTL_BYTES;
constexpr size_t TAB_HIST = WS_TAB, TAB_NT = WS_TAB + 65536, TAB_TE = WS_TAB + 65536 + 256;
constexpr size_t WS_TOK = WS_TAB + 1 * MiB;
constexpr size_t TOK_E = WS_TOK, TOK_G = WS_TOK + 2 * MiB, TOK_R = WS_TOK + 4 * MiB, TOK_SLOT = WS_TOK + 6 * MiB;
constexpr size_t WS_ROW = WS_TOK + 8 * MiB;
constexpr size_t ROW_TOK = WS_ROW, ROW_GATE = WS_ROW + 2560 * 1024;
constexpr size_t WS_SMALLW = WS_ROW + 5 * MiB;
constexpr size_t W_RT = WS_SMALLW, W_PT = WS_SMALLW + 131072, W_DWT = WS_SMALLW + 196608;
constexpr size_t WS_WIN = WS_SMALLW + 1 * MiB;
constexpr size_t WS_WOUT = WS_WIN + (size_t)NPROJ * D * 2;
constexpr size_t WS_WGU = WS_WOUT + (size_t)D * D * 2;
constexpr size_t WS_WD = WS_WGU + (size_t)NE * 512 * D * 2;
constexpr size_t WS_WSGU = WS_WD + (size_t)NE * D * EH * 2;
constexpr size_t WS_WSD = WS_WSGU + (size_t)512 * D * 2;
constexpr size_t WS_WKV = WS_WSD + (size_t)D * EH * 2;
constexpr size_t WS_MEMN = WS_WKV + (size_t)DEPTH * D * D * 2;
constexpr size_t WS_KB = WS_MEMN + (size_t)MROWS * D * 2;
constexpr size_t WS_VT = WS_KB + (size_t)DEPTH * MROWS * MEM_CH * 2;
constexpr size_t WS_XB = WS_VT + (size_t)DEPTH * MROWS * MEM_CH * 2;
constexpr size_t WS_U = WS_XB + (size_t)T * D * 2;
constexpr size_t U_PROJ = WS_U, U_CAT = WS_U + (size_t)T * NPROJ * 2, U_H = WS_U;
constexpr size_t U_BYTES = (size_t)(NCH * CH_SLOTS + T) * EH * 2;
static_assert(U_BYTES >= (size_t)T * NPROJ * 2 + (size_t)T * D * 2, "union region");
constexpr size_t WS_Y = WS_U + U_BYTES;
constexpr size_t WS_END = WS_Y + (size_t)CH_SLOTS * D * 2;

constexpr int LDS_STAGE = 0, STAGE_BYTES = 131072;
constexpr int MAXU = 24;
constexpr int LDS_TBL = STAGE_BYTES, LDS_CTLW = LDS_TBL + MAXU * 1024, LDS_BYTES = LDS_CTLW + 1024;
constexpr int NTHREADS = 512, NWAVES = 8;

__device__ __forceinline__ unsigned cvt_pk_bf16(float lo, float hi) { unsigned r; asm volatile("v_cvt_pk_bf16_f32 %0, %1, %2" : "=v"(r) : "v"(lo), "v"(hi)); return r; }
__device__ __forceinline__ float bf2f(unsigned h) { return __uint_as_float(h << 16); }
__device__ __forceinline__ float wave_sum(float v) {
#pragma unroll
    for (int o = 1; o < 64; o <<= 1) v += __shfl_xor(v, o);
    return v;
}
__device__ __forceinline__ float wave_max(float v) {
#pragma unroll
    for (int o = 1; o < 64; o <<= 1) v = fmaxf(v, __shfl_xor(v, o));
    return v;
}
__device__ __forceinline__ float fast_sigmoid(float x) { return __builtin_amdgcn_rcpf(1.0f + __builtin_amdgcn_exp2f(-1.4426950408889634f * x)); }
__device__ __forceinline__ float fast_silu(float x) { return x * fast_sigmoid(x); }
#define LDS_WAIT() asm volatile("s_waitcnt lgkmcnt(0)" ::: "memory")
#define RSRC_W3 0x00020000
__device__ __forceinline__ bf16x8 bufld8(__amdgpu_buffer_rsrc_t rs, unsigned voff, unsigned soff) { const u32x4 v = __builtin_amdgcn_raw_buffer_load_b128(rs, (int)voff, (int)soff, 0); return __builtin_bit_cast(bf16x8, v); }

#define XB_TMO      128
#define XB_XCNT(j)  (256  + 64 * (j))
#define XB_XSUB(j)  (1280 + 64 * (j))
#define XB_XGEN(j)  (2304 + 64 * (j))
#define XB_TOP      3328
#define XB_TOPGEN   3392
#define XCD_BAR_WORDS 3456
#define XB_SPIN_CAP (1u << 18)
__device__ __forceinline__ unsigned xb_ld(unsigned* p)              { return __hip_atomic_load(p, __ATOMIC_RELAXED, __HIP_MEMORY_SCOPE_AGENT); }
__device__ __forceinline__ unsigned xb_add(unsigned* p, unsigned v) { return __hip_atomic_fetch_add(p, v, __ATOMIC_RELAXED, __HIP_MEMORY_SCOPE_AGENT); }
__device__ __forceinline__ unsigned xb_xcc_id() { return (unsigned)__builtin_amdgcn_s_getreg((3 << 11) | 20) & 0xFu; }
#define XB_SPIN(cond, bar) do { unsigned _sp = 0; while (cond) { __builtin_amdgcn_s_sleep(1); \
    if ((++_sp & 255u) == 0u) { if (xb_ld(&(bar)[XB_TMO])) break; if (_sp > XB_SPIN_CAP) { atomicAdd(&(bar)[XB_TMO], 1u); break; } } } } while (0)
struct XcdBarrier { unsigned* bar; unsigned x; volatile LAS unsigned* st; };
__device__ __forceinline__ XcdBarrier xcd_barrier_post(unsigned* bar, volatile LAS unsigned* st) {
    XcdBarrier b; b.bar = bar; b.x = xb_xcc_id(); b.st = st;
    if (threadIdx.x == 0) (void)xb_add(&bar[XB_XCNT(b.x)], 1u);
    return b;
}
__device__ __forceinline__ void xcd_barrier_complete(unsigned* bar, unsigned x, unsigned& nloc, unsigned& nx) {
    const unsigned G = gridDim.x * gridDim.y * gridDim.z;
    unsigned sum, cnt, mine, sp = 0u;
    for (;;) {
        sum = 0u; cnt = 0u; mine = 0u;
#pragma unroll
        for (unsigned j = 0; j < 16; ++j) { const unsigned c = xb_ld(&bar[XB_XCNT(j)]); sum += c; cnt += (c > 0u) ? 1u : 0u; mine = (j == x) ? c : mine; }
        if (sum == G) break;
        __builtin_amdgcn_s_sleep(1);
        if ((++sp & 255u) == 0u) { if (xb_ld(&bar[XB_TMO])) break; if (sp > XB_SPIN_CAP) { atomicAdd(&bar[XB_TMO], 1u); break; } }
    }
    nloc = mine > 0u ? mine : 1u; nx = cnt > 0u ? cnt : 1u;
}
__device__ __forceinline__ void xcd_barrier(const XcdBarrier& b) {
    asm volatile("s_waitcnt vmcnt(0)" ::: "memory");
    __syncthreads();
    if (threadIdx.x == 0) {
        unsigned* bar = b.bar;
        __builtin_amdgcn_s_waitcnt(0);
        unsigned nloc = b.st[0], nx = b.st[1];
        if (nloc == 0u) { xcd_barrier_complete(bar, b.x, nloc, nx); b.st[0] = nloc; b.st[1] = nx; }
        const unsigned old = xb_add(&bar[XB_XSUB(b.x)], 1u);
        const unsigned gen = old / nloc;
        if (old + 1u == (gen + 1u) * nloc) {
            __builtin_amdgcn_fence(__ATOMIC_RELEASE, "agent");
            asm volatile("s_waitcnt vmcnt(0)" ::: "memory");
            const unsigned og = xb_add(&bar[XB_TOP], 1u);
            const unsigned tg = og / nx;
            if (og + 1u == (tg + 1u) * nx) xb_add(&bar[XB_TOPGEN], 1u);
            else XB_SPIN(xb_ld(&bar[XB_TOPGEN]) == tg, bar);
            __builtin_amdgcn_fence(__ATOMIC_ACQUIRE, "agent");
            xb_add(&bar[XB_XGEN(b.x)], 1u);
            asm volatile("s_waitcnt vmcnt(0)" ::: "memory");
        } else {
            XB_SPIN(xb_ld(&bar[XB_XGEN(b.x)]) == gen, bar);
            __builtin_amdgcn_fence(__ATOMIC_ACQUIRE, "agent");
            asm volatile("s_waitcnt vmcnt(0)" ::: "memory");
        }
    }
    __syncthreads();
}

namespace ge {
constexpr int BM = 256, BK = 64, HALF = 128, HTB = HALF * BK * 2, NXCD = 8, WGM = 8;
__device__ __forceinline__ int lds_byte(int r, int c) { const int st = (r >> 4) * 2 + (c >> 5), rr = r & 15, cc = c & 31, ob = rr * 64 + cc * 2; return st * 1024 + (ob ^ (((ob >> 9) & 1) << 5)); }
__device__ __forceinline__ void stage_rc(int b, int& R, int& C) { const int st = b / 1024, sb = b % 1024, swz = sb ^ (((sb >> 9) & 1) << 5); R = (st >> 1) * 16 + swz / 64; C = (st & 1) * 32 + (swz % 64) / 2; }
__device__ __forceinline__ int perm32(int rho) { const int n = rho >> 4, i = rho & 15; return 8 * (i >> 2) + 4 * n + (i & 3); }
__device__ __forceinline__ int xcd_remap(int L, int n) { const int q = n / NXCD, r = n % NXCD, xcd = L % NXCD, off = L / NXCD; return (xcd < r ? xcd * (q + 1) : r * (q + 1) + (xcd - r) * q) + off; }

struct Unit {
    const char* A;
    const char* B;
    char* O;
    int ldc, row0, col0, aux, tbl;
};

template <int K, bool GATHER, class Epi, class Sched>
__device__ __forceinline__ void gemm_phase(LAS unsigned char* lds, const LAS int* tbl, const Sched& S, const Epi& E) {
    const int tid = threadIdx.x, wid = __builtin_amdgcn_readfirstlane(tid >> 6), lane = tid & 63, wr = wid >> 2, wc = wid & 3, fr = lane & 15, fq = lane >> 4;
    constexpr int nt = K / BK;
    static_assert(K % 128 == 0 && K >= 256, "K");
    int Rr[2], Cc[2]; unsigned voffB[2];
#pragma unroll
    for (int i = 0; i < 2; ++i) { int R, C; stage_rc(tid * 16 + i * 8192, R, C); const int Rb = (R & ~31) + perm32(R & 31); Rr[i] = R; Cc[i] = C; voffB[i] = (unsigned)(Rb * K + C) * 2u; }
    constexpr size_t kstep = (size_t)(BK * 2);
    constexpr size_t hstep = (size_t)HALF * K * 2;
    const unsigned ldsw = (unsigned)wid * 1024u;
    const int aoff = lds_byte(wr * 64 + fr, fq * 8), boff = lds_byte(wc * 32 + fr, fq * 8);
#define GE_SA(b, h) (((b) * 2 + (h)) * HTB)
#define GE_SB(b, h) ((4 + (b) * 2 + (h)) * HTB)
#define GE_STAGE_B(bufoff, gbase) do { _Pragma("unroll") for (int _i = 0; _i < 2; ++_i) \
        __builtin_amdgcn_global_load_lds((const unsigned*)((const char*)(gbase) + voffB[_i]), (LAS unsigned*)(lds + (bufoff) + ldsw + _i * 8192), 16, 0, 0); } while (0)
#define GE_STAGE_A(bufoff, gbase, o0, o1) do { \
        __builtin_amdgcn_global_load_lds((const unsigned*)((const char*)(gbase) + (o0)), (LAS unsigned*)(lds + (bufoff) + ldsw), 16, 0, 0); \
        __builtin_amdgcn_global_load_lds((const unsigned*)((const char*)(gbase) + (o1)), (LAS unsigned*)(lds + (bufoff) + ldsw + 8192), 16, 0, 0); } while (0)
#define GE_LDA(dst, b, h) do { _Pragma("unroll") for (int m = 0; m < 4; ++m) _Pragma("unroll") for (int k = 0; k < 2; ++k) dst[m][k] = *(const LAS bf16x8*)(lds + GE_SA(b, h) + aoff + m * 2048 + k * 1024); } while (0)
#define GE_LDB(dst, b, h) do { _Pragma("unroll") for (int n = 0; n < 2; ++n) _Pragma("unroll") for (int k = 0; k < 2; ++k) dst[n][k] = *(const LAS bf16x8*)(lds + GE_SB(b, h) + boff + n * 2048 + k * 1024); } while (0)
#define GE_MMA(ai, bj, At, Bt) do { __builtin_amdgcn_s_setprio(1); _Pragma("unroll") for (int m = 0; m < 4; ++m) _Pragma("unroll") for (int n = 0; n < 2; ++n) _Pragma("unroll") for (int k = 0; k < 2; ++k) \
        acc[ai][bj][m][n] = __builtin_amdgcn_mfma_f32_16x16x32_bf16(Bt[n][k], At[m][k], acc[ai][bj][m][n], 0, 0, 0); __builtin_amdgcn_s_setprio(0); } while (0)
#define GE_WAIT_V(n) asm volatile("s_waitcnt vmcnt(" #n ")" ::: "memory")
#define GE_WAIT_L(n) asm volatile("s_waitcnt lgkmcnt(" #n ")" ::: "memory")
#define GE_BAR __builtin_amdgcn_s_barrier()
#define GE_SCHED __builtin_amdgcn_sched_barrier(0)
#define GE_LOAD_VA(dst, u) do { _Pragma("unroll") for (int _h = 0; _h < 2; ++_h) _Pragma("unroll") for (int _i = 0; _i < 2; ++_i) { \
        if constexpr (GATHER) dst[_h][_i] = (unsigned)tbl[(u).tbl * 256 + _h * 128 + Rr[_i]] * (unsigned)(K * 2) + (unsigned)(Cc[_i] * 2); \
        else dst[_h][_i] = (unsigned)((_h * 128 + Rr[_i]) * K + Cc[_i]) * 2u; } } while (0)
    Unit cur, nxt; int ui = 0;
    if (!S.next(0, cur)) return;
    f32x4 acc[2][2][4][2];
#pragma unroll
    for (int a = 0; a < 2; ++a)
#pragma unroll
        for (int b = 0; b < 2; ++b)
#pragma unroll
            for (int m = 0; m < 4; ++m)
#pragma unroll
                for (int n = 0; n < 2; ++n) acc[a][b][m][n] = (f32x4){0.f, 0.f, 0.f, 0.f};
    bf16x8 At[4][2], B0[2][2], B1[2][2];
    unsigned va[2][2], vn[2][2];
    GE_LOAD_VA(va, cur);
#pragma unroll
    for (int h = 0; h < 2; ++h)
#pragma unroll
        for (int i = 0; i < 2; ++i) vn[h][i] = va[h][i];
    const char* cA = cur.A; const char* cB = cur.B;
    GE_STAGE_B(GE_SB(0, 0), cB); GE_STAGE_B(GE_SB(0, 1), cB + hstep); GE_STAGE_A(GE_SA(0, 0), cA, va[0][0], va[0][1]); GE_STAGE_A(GE_SA(0, 1), cA, va[1][0], va[1][1]);
    if (wr == 1) GE_BAR;
    GE_WAIT_V(2); GE_BAR;
    GE_STAGE_B(GE_SB(1, 0), cB + kstep); GE_STAGE_A(GE_SA(1, 0), cA + kstep, va[0][0], va[0][1]); GE_STAGE_B(GE_SB(1, 1), cB + hstep + kstep);
    GE_WAIT_V(6); GE_BAR;
    for (;;) {
        const bool has_next = S.next(ui + 1, nxt);
        const char* nA = has_next ? nxt.A : cA; const char* nB = has_next ? nxt.B : cB;
        for (int t = 0; t < nt; t += 2) {
            const bool last = (t == nt - 2);
            if (last && has_next) { GE_LOAD_VA(vn, nxt); }
            const char* a1 = cA + (size_t)(t + 1) * kstep;
            const char* a2 = last ? nA : cA + (size_t)(t + 2) * kstep; const char* b2 = last ? nB : cB + (size_t)(t + 2) * kstep;
            const char* a3 = a2 + kstep; const char* b3 = b2 + kstep;
            const unsigned x00 = last ? vn[0][0] : va[0][0], x01 = last ? vn[0][1] : va[0][1], x10 = last ? vn[1][0] : va[1][0], x11 = last ? vn[1][1] : va[1][1];
            GE_LDB(B0, 0, 0); GE_LDB(B1, 0, 1); GE_SCHED; GE_LDA(At, 0, 0); GE_STAGE_A(GE_SA(1, 1), a1, va[1][0], va[1][1]);
            GE_WAIT_V(8); GE_WAIT_L(0); GE_BAR; GE_MMA(0, 0, At, B0); GE_MMA(0, 1, At, B1); GE_BAR; GE_SCHED;
            GE_LDA(At, 0, 1); GE_STAGE_B(GE_SB(0, 0), b2); GE_STAGE_B(GE_SB(0, 1), b2 + hstep); GE_STAGE_A(GE_SA(0, 0), a2, x00, x01);
            GE_WAIT_V(8); GE_WAIT_L(0); GE_BAR; GE_MMA(1, 0, At, B0); GE_MMA(1, 1, At, B1); GE_BAR; GE_SCHED;
            GE_LDB(B0, 1, 0); GE_LDB(B1, 1, 1); GE_SCHED; GE_LDA(At, 1, 0); GE_STAGE_A(GE_SA(0, 1), a2, x10, x11);
            GE_WAIT_V(8); GE_WAIT_L(0); GE_BAR; GE_MMA(0, 0, At, B0); GE_MMA(0, 1, At, B1); GE_BAR; GE_SCHED;
            GE_LDA(At, 1, 1); GE_STAGE_B(GE_SB(1, 0), b3); GE_STAGE_B(GE_SB(1, 1), b3 + hstep); GE_STAGE_A(GE_SA(1, 0), a3, x00, x01);
            GE_WAIT_V(8); GE_WAIT_L(0); GE_BAR; GE_MMA(1, 0, At, B0); GE_MMA(1, 1, At, B1); GE_BAR; GE_SCHED;
        }
        if (wr == 0) GE_BAR;
        E(acc, cur, wr, wc, fr, fq);
        if (!has_next) break;
#pragma unroll
        for (int a = 0; a < 2; ++a)
#pragma unroll
            for (int b = 0; b < 2; ++b)
#pragma unroll
                for (int m = 0; m < 4; ++m)
#pragma unroll
                    for (int n = 0; n < 2; ++n) acc[a][b][m][n] = (f32x4){0.f, 0.f, 0.f, 0.f};
        cur = nxt; cA = nA; cB = nB; ++ui;
#pragma unroll
        for (int h = 0; h < 2; ++h)
#pragma unroll
            for (int i = 0; i < 2; ++i) va[h][i] = vn[h][i];
        if (wr == 1) GE_BAR;
    }
    GE_WAIT_V(0);
    GE_BAR;
#undef GE_SA
#undef GE_SB
#undef GE_STAGE_A
#undef GE_STAGE_B
#undef GE_LDA
#undef GE_LDB
#undef GE_MMA
#undef GE_WAIT_V
#undef GE_WAIT_L
#undef GE_BAR
#undef GE_SCHED
#undef GE_LOAD_VA
}

struct EpiBf16 {
    __device__ __forceinline__ void operator()(const f32x4 (&acc)[2][2][4][2], const Unit& u, int wr, int wc, int fr, int fq) const {
#pragma unroll
        for (int ai = 0; ai < 2; ++ai)
#pragma unroll
            for (int m = 0; m < 4; ++m) { bf16* rowp = (bf16*)u.O + (size_t)(u.row0 + ai * HALF + wr * 64 + m * 16 + fr) * u.ldc + u.col0 + wc * 32 + 8 * fq;
#pragma unroll
                for (int bj = 0; bj < 2; ++bj) { const f32x4 v0 = acc[ai][bj][m][0], v1 = acc[ai][bj][m][1];
                    u32x4 w; w.x = cvt_pk_bf16(v0[0], v0[1]); w.y = cvt_pk_bf16(v0[2], v0[3]); w.z = cvt_pk_bf16(v1[0], v1[1]); w.w = cvt_pk_bf16(v1[2], v1[3]);
                    *(u32x4*)(rowp + bj * HALF) = w; } }
    }
};
struct EpiResF32 {
    const float* res; float* out;
    __device__ __forceinline__ void operator()(const f32x4 (&acc)[2][2][4][2], const Unit& u, int wr, int wc, int fr, int fq) const {
#pragma unroll
        for (int ai = 0; ai < 2; ++ai)
#pragma unroll
            for (int m = 0; m < 4; ++m) { const size_t off = (size_t)(u.row0 + ai * HALF + wr * 64 + m * 16 + fr) * D + u.col0 + wc * 32 + 8 * fq;
#pragma unroll
                for (int bj = 0; bj < 2; ++bj) { const f32x4 r0 = *(const f32x4*)(res + off + bj * HALF), r1 = *(const f32x4*)(res + off + bj * HALF + 4);
                    *(f32x4*)(out + off + bj * HALF) = r0 * ALPHA + acc[ai][bj][m][0]; *(f32x4*)(out + off + bj * HALF + 4) = r1 * ALPHA + acc[ai][bj][m][1]; }
                asm volatile("" ::: "memory"); }
    }
};
struct EpiSwiGLU {
    __device__ __forceinline__ void operator()(const f32x4 (&acc)[2][2][4][2], const Unit& u, int wr, int wc, int fr, int fq) const {
#pragma unroll
        for (int ai = 0; ai < 2; ++ai)
#pragma unroll
            for (int m = 0; m < 4; ++m) { bf16* rowp = (bf16*)u.O + (size_t)(u.row0 + ai * HALF + wr * 64 + m * 16 + fr) * EH + u.col0 + wc * 32 + 8 * fq;
                const f32x4 g0 = acc[ai][0][m][0], g1 = acc[ai][0][m][1], u0 = acc[ai][1][m][0], u1 = acc[ai][1][m][1];
                float v[8];
#pragma unroll
                for (int j = 0; j < 4; ++j) { v[j] = fast_silu(g0[j]) * u0[j]; v[4 + j] = fast_silu(g1[j]) * u1[j]; }
                u32x4 w; w.x = cvt_pk_bf16(v[0], v[1]); w.y = cvt_pk_bf16(v[2], v[3]); w.z = cvt_pk_bf16(v[4], v[5]); w.w = cvt_pk_bf16(v[6], v[7]);
                *(u32x4*)rowp = w; }
    }
};
struct EpiDown {
    const float* gate;
    __device__ __forceinline__ void operator()(const f32x4 (&acc)[2][2][4][2], const Unit& u, int wr, int wc, int fr, int fq) const {
        if (u.aux >= 0) {
#pragma unroll
            for (int ai = 0; ai < 2; ++ai)
#pragma unroll
                for (int m = 0; m < 4; ++m) { const int r = ai * HALF + wr * 64 + m * 16 + fr; const float g = gate[u.aux + r];
                    bf16* rowp = (bf16*)u.O + (size_t)(u.row0 + r) * D + u.col0 + wc * 32 + 8 * fq;
#pragma unroll
                    for (int bj = 0; bj < 2; ++bj) { const f32x4 v0 = acc[ai][bj][m][0] * g, v1 = acc[ai][bj][m][1] * g;
                        u32x4 w; w.x = cvt_pk_bf16(v0[0], v0[1]); w.y = cvt_pk_bf16(v0[2], v0[3]); w.z = cvt_pk_bf16(v1[0], v1[1]); w.w = cvt_pk_bf16(v1[2], v1[3]);
                        *(u32x4*)(rowp + bj * HALF) = w; } }
        } else {
            float* out = (float*)u.O;
#pragma unroll
            for (int ai = 0; ai < 2; ++ai)
#pragma unroll
                for (int m = 0; m < 4; ++m) { const size_t off = (size_t)(u.row0 + ai * HALF + wr * 64 + m * 16 + fr) * D + u.col0 + wc * 32 + 8 * fq;
#pragma unroll
                    for (int bj = 0; bj < 2; ++bj) { const f32x4 r0 = *(const f32x4*)(out + off + bj * HALF), r1 = *(const f32x4*)(out + off + bj * HALF + 4);
                        *(f32x4*)(out + off + bj * HALF) = r0 * ALPHA + acc[ai][bj][m][0]; *(f32x4*)(out + off + bj * HALF + 4) = r1 * ALPHA + acc[ai][bj][m][1]; }
                    asm volatile("" ::: "memory"); }
        }
    }
};

template <int K> struct SchedDense {
    const char* A; const char* B; char* O; int ldc, nM, nN, G, c;
    __device__ __forceinline__ bool next(int i, Unit& u) const {
        const int nwg = nM * nN; const long L = (long)i * G + c; if (L >= nwg) return false;
        const int wgid = xcd_remap((int)L, nwg);
        const int nig = WGM * nN, gid = wgid / nig, fm = gid * WGM, gsz = (nM - fm) < WGM ? (nM - fm) : WGM;
        const int pm = fm + ((wgid % nig) % gsz), pn = (wgid % nig) / gsz;
        u.A = A + (size_t)pm * (256 * K * 2); u.B = B + (size_t)pn * (256 * K * 2); u.O = O; u.ldc = ldc; u.row0 = pm * 256; u.col0 = pn * 256; u.aux = 0; u.tbl = 0; return true;
    }
};
struct SchedKV {
    const char* memn; const char* wkv; char* kb; char* vt; int G, c;
    __device__ __forceinline__ bool next(int i, Unit& u) const {
        const long L = (long)i * G + c; if (L >= 256) return false;
        const int idx = (int)L, l = idx >> 6, r = idx & 63; u.aux = 0; u.tbl = 0;
        const char* w = wkv + (size_t)l * D * D * 2;
        if (r < 32) { const int pm = r >> 1, pn = r & 1;
            u.A = memn + (size_t)pm * 256 * D * 2; u.B = w + (size_t)pn * 256 * D * 2; u.O = kb + (size_t)l * MROWS * MEM_CH * 2; u.ldc = MEM_CH; u.row0 = pm * 256; u.col0 = pn * 256; }
        else { const int q = r - 32, pm = q >> 4, pn = q & 15;
            u.A = w + (size_t)(512 + pm * 256) * D * 2; u.B = memn + (size_t)pn * 256 * D * 2; u.O = vt + (size_t)l * MROWS * MEM_CH * 2; u.ldc = MROWS; u.row0 = pm * 256; u.col0 = pn * 256; }
        return true;
    }
};
struct SchedGU {
    const char* xb; const char* wgu; const char* wsgu; char* h; const int* ntiles; const int* tile_e; int G, c;
    int n0, n1, n2, n3;
    __device__ __forceinline__ void init() { n0 = ntiles[0]; n1 = ntiles[1]; n2 = ntiles[2]; n3 = ntiles[3]; }
    __device__ __forceinline__ bool next(int i, Unit& u) const {
        const int ntot = n0 + n1 + n2 + n3 + T / 256, nun = ntot * 2; const long L = (long)i * G + c; if (L >= nun || i >= MAXU) return false;
        const int idx = xcd_remap((int)L, nun), pn = idx & 1; int rt = idx >> 1;
        u.A = xb; u.O = h; u.ldc = EH; u.col0 = pn * 128; u.tbl = i;
        int ch = -1, lt = 0;
        if (rt < n0) { ch = 0; lt = rt; } else { rt -= n0; if (rt < n1) { ch = 1; lt = rt; } else { rt -= n1; if (rt < n2) { ch = 2; lt = rt; } else { rt -= n2; if (rt < n3) { ch = 3; lt = rt; } else { rt -= n3; } } } }
        if (ch >= 0) { const int e = tile_e[ch * CH_TILES_MAX + lt]; u.B = wgu + (size_t)e * 512 * D * 2 + (size_t)pn * 256 * D * 2; u.row0 = ch * CH_SLOTS + lt * 256; u.aux = -1; }
        else { u.B = wsgu + (size_t)pn * 256 * D * 2; u.row0 = SH_ROW0 + rt * 256; u.aux = rt * 256; }
        return true;
    }
};
struct SchedDN {
    const char* h; const char* wd; const char* wsd; char* y; char* dout; const int* tile_e; int ch, nt, G, c;
    __device__ __forceinline__ bool next(int i, Unit& u) const {
        const int nun = (CH_TOK / 256 + nt) * 4; const long L = (long)i * G + c; if (L >= nun) return false;
        const int idx = xcd_remap((int)L, nun), pn = idx & 3; int rt = idx >> 2; u.tbl = 0; u.ldc = D; u.col0 = pn * 256;
        if (rt < CH_TOK / 256) { const int row = ch * CH_TOK + rt * 256; u.A = h + (size_t)(SH_ROW0 + row) * EH * 2; u.B = wsd + (size_t)pn * 256 * EH * 2; u.O = dout; u.row0 = row; u.aux = -1; }
        else { rt -= CH_TOK / 256; const int e = tile_e[ch * CH_TILES_MAX + rt]; const int slot0 = ch * CH_SLOTS + rt * 256;
            u.A = h + (size_t)slot0 * EH * 2; u.B = wd + (size_t)e * D * EH * 2 + (size_t)pn * 256 * EH * 2; u.O = y; u.row0 = rt * 256; u.aux = slot0; }
        return true;
    }
};
}

struct KArgs { const float* in[25]; float* out; unsigned char* ws; int layer; int chunk; };
enum { I_X = 0, I_MEM, I_WIN, I_WPOOL, I_PSCALE, I_WDW, I_BDW, I_CNG, I_CNB, I_WKV, I_WOUT, I_LN1G, I_LN1B, I_WR, I_RB, I_WG, I_WU, I_WD, I_WGS, I_WUS, I_WDS, I_LN2G, I_LN2B, I_MNG, I_MNB };

__device__ __forceinline__ void transpose_item(const float* W, int N, bf16* WT, int ldk, int row_off, LAS float* scr, int k0, int n0, int lane) {
#pragma unroll 8
    for (int i = 0; i < 32; ++i) { const int kk = 2 * i + (lane >> 5); scr[kk * 33 + (lane & 31)] = W[(size_t)(k0 + kk) * N + n0 + (lane & 31)]; }
    LDS_WAIT(); asm volatile("" ::: "memory");
    const int c = lane & 7;
#pragma unroll
    for (int j = 0; j < 4; ++j) { const int n = (lane >> 3) + 8 * j; const LAS float* s = scr + (8 * c) * 33 + n;
        u32x4 o; o.x = cvt_pk_bf16(s[0 * 33], s[1 * 33]); o.y = cvt_pk_bf16(s[2 * 33], s[3 * 33]); o.z = cvt_pk_bf16(s[4 * 33], s[5 * 33]); o.w = cvt_pk_bf16(s[6 * 33], s[7 * 33]);
        *(u32x4*)(WT + (size_t)(row_off + n) * ldk + k0 + 8 * c) = o; }
    LDS_WAIT(); asm volatile("" ::: "memory");
}

__device__ __forceinline__ void phase_convert_layer(const KArgs& a, int l, LAS unsigned char* lds, int bid, int G) {
    const int lane = threadIdx.x & 63, wave = threadIdx.x >> 6;
    LAS float* scr = (LAS float*)(lds + wave * 16384);
    unsigned char* ws = a.ws;
    constexpr int I_IN = 16 * 40, I_OUT = 16 * 32, I_GU = 64 * 128, I_DN = 64 * 128, I_SH = 128, I_R = 16 * 2, I_P = 4 * 2;
    constexpr int NIT = I_IN + I_OUT + 2 * I_GU + I_DN + 3 * I_SH + I_R + I_P;
    if (bid == 0) { float* dwt = (float*)(ws + W_DWT); const float* wdw = a.in[I_WDW] + (size_t)l * 31 * CONV_CH; const float* bdw = a.in[I_BDW] + (size_t)l * CONV_CH;
        for (int i = threadIdx.x; i < 256 * 32; i += NTHREADS) { const int ch = i >> 5, j = i & 31; dwt[i] = (j < 31) ? wdw[j * CONV_CH + ch] : bdw[ch]; } }
    for (int it = bid * NWAVES + wave; it < NIT; it += G * NWAVES) {
        int r = it;
        if (r < I_IN) { const int kb = r / 40, nb = r % 40; transpose_item(a.in[I_WIN] + (size_t)l * D * NPROJ, NPROJ, (bf16*)(ws + WS_WIN), D, 32 * nb, scr, 64 * kb, 32 * nb, lane); continue; } r -= I_IN;
        if (r < I_OUT) { const int kb = r / 32, nb = r % 32; transpose_item(a.in[I_WOUT] + (size_t)l * D * D, D, (bf16*)(ws + WS_WOUT), D, 32 * nb, scr, 64 * kb, 32 * nb, lane); continue; } r -= I_OUT;
        if (r < 2 * I_GU) { const int half = r / I_GU; r %= I_GU; const int e = r / 128, q = r % 128, kb = q / 8, nb = q % 8, n0 = 32 * nb;
            const float* W = a.in[half ? I_WU : I_WG] + ((size_t)l * NE + e) * D * EH;
            transpose_item(W, EH, (bf16*)(ws + WS_WGU) + (size_t)e * 512 * D, D, (n0 >> 7) * 256 + half * 128 + (n0 & 127), scr, 64 * kb, n0, lane); continue; } r -= 2 * I_GU;
        if (r < I_DN) { const int e = r / 128, q = r % 128, kb = q / 32, nb = q % 32;
            transpose_item(a.in[I_WD] + ((size_t)l * NE + e) * EH * D, D, (bf16*)(ws + WS_WD) + (size_t)e * D * EH, EH, 32 * nb, scr, 64 * kb, 32 * nb, lane); continue; } r -= I_DN;
        if (r < 2 * I_SH) { const int half = r / I_SH; r %= I_SH; const int kb = r / 8, nb = r % 8, n0 = 32 * nb;
            transpose_item(a.in[half ? I_WUS : I_WGS] + (size_t)l * D * EH, EH, (bf16*)(ws + WS_WSGU), D, (n0 >> 7) * 256 + half * 128 + (n0 & 127), scr, 64 * kb, n0, lane); continue; } r -= 2 * I_SH;
        if (r < I_SH) { const int kb = r / 32, nb = r % 32; transpose_item(a.in[I_WDS] + (size_t)l * EH * D, D, (bf16*)(ws + WS_WSD), EH, 32 * nb, scr, 64 * kb, 32 * nb, lane); continue; } r -= I_SH;
        if (r < I_R) { const int kb = r / 2, nb = r % 2; transpose_item(a.in[I_WR] + (size_t)l * D * NE, NE, (bf16*)(ws + W_RT), D, 32 * nb, scr, 64 * kb, 32 * nb, lane); continue; } r -= I_R;
        { const int g = r / 2, nb = r % 2; transpose_item(a.in[I_WPOOL] + ((size_t)l * 4 + g) * 64 * 64, 64, (bf16*)(ws + W_PT) + (size_t)g * 64 * 64, 64, 32 * nb, scr, 0, 32 * nb, lane); }
    }
}

__device__ __forceinline__ void phase_prologue(const KArgs& a, LAS unsigned char* lds, int bid, int G) {
    const int lane = threadIdx.x & 63, wave = threadIdx.x >> 6;
    LAS float* scr = (LAS float*)(lds + wave * 16384);
    unsigned char* ws = a.ws;
    const int gw = bid * NWAVES + wave, NGW = G * NWAVES;
    for (int it = gw; it < DEPTH * 512; it += NGW) { const int l = it / 512, q = it % 512, kb = q / 32, nb = q % 32;
        transpose_item(a.in[I_WKV] + (size_t)l * D * D, D, (bf16*)(ws + WS_WKV) + (size_t)l * D * D, D, 32 * nb, scr, 64 * kb, 32 * nb, lane); }
    const float* g = a.in[I_MNG]; const float* b = a.in[I_MNB];
    for (int m = gw; m < MROWS; m += NGW) {
        const f32x4* xr = (const f32x4*)(a.in[I_MEM] + (size_t)m * D) + lane;
        f32x4 v[4]; float s = 0.f;
#pragma unroll
        for (int j = 0; j < 4; ++j) { v[j] = xr[64 * j]; s += (v[j][0] + v[j][1]) + (v[j][2] + v[j][3]); }
        const float mean = wave_sum(s) * (1.f / D); float s2 = 0.f;
#pragma unroll
        for (int j = 0; j < 4; ++j) { v[j] = v[j] - mean; s2 += (v[j][0] * v[j][0] + v[j][1] * v[j][1]) + (v[j][2] * v[j][2] + v[j][3] * v[j][3]); }
        const float rstd = 1.f / sqrtf(wave_sum(s2) * (1.f / D) + LN_EPS);
        u32x2* o8 = (u32x2*)((bf16*)(ws + WS_MEMN) + (size_t)m * D) + lane;
#pragma unroll
        for (int j = 0; j < 4; ++j) { const f32x4 gg = ((const f32x4*)g)[lane + 64 * j], bb = ((const f32x4*)b)[lane + 64 * j]; const f32x4 y = v[j] * rstd * gg + bb;
            u32x2 w; w.x = cvt_pk_bf16(y[0], y[1]); w.y = cvt_pk_bf16(y[2], y[3]); o8[64 * j] = w; }
    }
    const size_t n8 = (size_t)T * D / 8;
    for (size_t i = (size_t)bid * NTHREADS + threadIdx.x; i < n8; i += (size_t)G * NTHREADS) {
        const f32x4 p0 = ((const f32x4*)a.in[I_X])[2 * i], p1 = ((const f32x4*)a.in[I_X])[2 * i + 1];
        u32x4 w; w.x = cvt_pk_bf16(p0[0], p0[1]); w.y = cvt_pk_bf16(p0[2], p0[3]); w.z = cvt_pk_bf16(p1[0], p1[1]); w.w = cvt_pk_bf16(p1[2], p1[3]);
        ((u32x4*)(ws + WS_XB))[i] = w;
    }
}

#define OPAQUE_TID() int tid = threadIdx.x; asm volatile("" : "+v"(tid)); const int lane = tid & 63, wave = __builtin_amdgcn_readfirstlane(tid >> 6); (void)lane; (void)wave
__device__ __forceinline__ void phase_mixers(const KArgs& a, int l, LAS unsigned char* lds, int bid, int G) {
    unsigned char* ws = a.ws;
    const bf16* proj = (const bf16*)(ws + U_PROJ); bf16* cat = (bf16*)(ws + U_CAT);
    const bf16* wpt = (const bf16*)(ws + W_PT);
    const bf16* Kb = (const bf16*)(ws + WS_KB) + (size_t)l * MROWS * MEM_CH; const bf16* Vt = (const bf16*)(ws + WS_VT) + (size_t)l * MROWS * MEM_CH;
    const float* pscale = a.in[I_PSCALE] + (size_t)l * POOL_CH;
    const float* dwt = (const float*)(ws + W_DWT);
    const float* cng = a.in[I_CNG] + (size_t)l * CONV_CH; const float* cnb = a.in[I_CNB] + (size_t)l * CONV_CH;
    for (int item = bid; item < T / 64; item += G) {
        const int b = item / (SEQ / 64), s0 = (item % (SEQ / 64)) * 64; const size_t t0 = (size_t)b * SEQ + s0;
        {
            OPAQUE_TID();
            LAS bf16* Ub = (LAS bf16*)lds;
            LAS bf16* Db = (LAS bf16*)(lds + 80 * 528);
#pragma unroll 1
            for (int i = tid; i < 80 * 32; i += NTHREADS) { const int r = i >> 5, c8 = i & 31; const int s = s0 - 8 + r;
                u32x4 v = (u32x4){0u, 0u, 0u, 0u}; if (s >= 0 && s < SEQ) v = *(const u32x4*)(proj + ((size_t)b * SEQ + s) * NPROJ + c8 * 8);
                *(LAS u32x4*)(Ub + r * 264 + c8 * 8) = v; }
            __syncthreads();
            { const int ch = tid & 255, half = tid >> 8, g = ch >> 6; const int w = 2 << g, lo = w >> 1, hi = w - 1 - lo;
#pragma unroll 1
                for (int r = half * 32; r < half * 32 + 32; ++r) { const int s = s0 + r; const int st = max(s - lo, 0), en = min(s + hi + 1, SEQ);
                    float sum = 0.f; for (int q = st; q < en; ++q) sum += bf2f(Ub[(q - s0 + 8) * 264 + ch]);
                    const float d = sum / (float)(en - st) - bf2f(Ub[(r + 8) * 264 + ch]);
                    Db[r * 264 + ch] = (bf16)(cvt_pk_bf16(d, 0.f) & 0xffffu); } }
            __syncthreads();
            { const int g = wave >> 1, rh = wave & 1, fr = lane & 15, fq = lane >> 4;
#pragma unroll
                for (int rt = 0; rt < 2; ++rt) {
                    bf16x8 af[2];
#pragma unroll
                    for (int ks = 0; ks < 2; ++ks) af[ks] = *(const LAS bf16x8*)(Db + (rh * 32 + rt * 16 + fr) * 264 + g * 64 + ks * 32 + 8 * fq);
#pragma unroll
                    for (int ct = 0; ct < 4; ++ct) { f32x4 c = (f32x4){0.f, 0.f, 0.f, 0.f};
#pragma unroll
                        for (int ks = 0; ks < 2; ++ks) { const bf16x8 bfv = *(const bf16x8*)(wpt + (size_t)g * 4096 + (ct * 16 + fr) * 64 + ks * 32 + 8 * fq); c = __builtin_amdgcn_mfma_f32_16x16x32_bf16(af[ks], bfv, c, 0, 0, 0); }
                        const int col = g * 64 + ct * 16 + fr; const float sc = pscale[col];
#pragma unroll
                        for (int j = 0; j < 4; ++j) cat[(t0 + rh * 32 + rt * 16 + fq * 4 + j) * D + col] = (bf16)(cvt_pk_bf16(c[j] * sc, 0.f) & 0xffffu); } } }
            __syncthreads();
        }
        {
            OPAQUE_TID();
            LAS bf16* Gb = (LAS bf16*)lds;
            LAS float* Yc = (LAS float*)(lds + 49152);
#pragma unroll 1
            for (int i = tid; i < 94 * 32; i += NTHREADS) { const int r = i >> 5, c8 = i & 31; const int s = s0 - 15 + r;
                u32x4 o = (u32x4){0u, 0u, 0u, 0u};
                if (s >= 0 && s < SEQ) { const bf16* pr = proj + ((size_t)b * SEQ + s) * NPROJ + 256 + c8 * 8; const u32x4 av = *(const u32x4*)pr, gv = *(const u32x4*)(pr + 256);
                    float y[8];
#pragma unroll
                    for (int j = 0; j < 4; ++j) { const unsigned aw = av[j], gw2 = gv[j];
                        y[2 * j] = bf2f(aw & 0xffffu) * fast_sigmoid(bf2f(gw2 & 0xffffu)); y[2 * j + 1] = bf2f(aw >> 16) * fast_sigmoid(bf2f(gw2 >> 16)); }
                    o.x = cvt_pk_bf16(y[0], y[1]); o.y = cvt_pk_bf16(y[2], y[3]); o.z = cvt_pk_bf16(y[4], y[5]); o.w = cvt_pk_bf16(y[6], y[7]); }
                *(LAS u32x4*)(Gb + r * 256 + c8 * 8) = o; }
            __syncthreads();
            { const int ch = tid & 255, half = tid >> 8; float wv[32];
#pragma unroll
                for (int j = 0; j < 8; ++j) { const f32x4 w4 = ((const f32x4*)(dwt + ch * 32))[j]; wv[4 * j] = w4[0]; wv[4 * j + 1] = w4[1]; wv[4 * j + 2] = w4[2]; wv[4 * j + 3] = w4[3]; }
                const float bias = wv[31];
#pragma unroll 1
                for (int rb = 0; rb < 8; ++rb) { const int r0 = half * 32 + rb * 4; float gv[34];
#pragma unroll
                    for (int j = 0; j < 34; ++j) gv[j] = bf2f(Gb[(r0 + j) * 256 + ch]);
#pragma unroll
                    for (int q = 0; q < 4; ++q) { float y = bias;
#pragma unroll
                        for (int j = 0; j < 31; ++j) y += gv[q + j] * wv[j];
                        Yc[(r0 + q) * 256 + ch] = y; } } }
            __syncthreads();
#pragma unroll 1
            for (int r = wave; r < 64; r += NWAVES) { const f32x4 v = *(const LAS f32x4*)(Yc + r * 256 + lane * 4);
                const float mean = wave_sum((v[0] + v[1]) + (v[2] + v[3])) * (1.f / 256.f); const f32x4 d = v - mean;
                const float rstd = 1.f / sqrtf(wave_sum((d[0] * d[0] + d[1] * d[1]) + (d[2] * d[2] + d[3] * d[3])) * (1.f / 256.f) + LN_EPS);
                const f32x4 gg = ((const f32x4*)cng)[lane], bb = ((const f32x4*)cnb)[lane]; const f32x4 y = d * rstd * gg + bb;
                u32x2 w; w.x = cvt_pk_bf16(fast_silu(y[0]), fast_silu(y[1])); w.y = cvt_pk_bf16(fast_silu(y[2]), fast_silu(y[3]));
                *(u32x2*)(cat + (t0 + r) * D + 256 + lane * 4) = w; }
            __syncthreads();
        }
        {
            OPAQUE_TID();
            const int hh = wave >> 1, rbase = (wave & 1) * 32, fr = lane & 15, fq = lane >> 4;
            LAS bf16* Pw = (LAS bf16*)(lds + wave * 8448);
            constexpr float SC = 0.08838834764831845f * 1.4426950408889634f;
            const __amdgpu_buffer_rsrc_t kR = __builtin_amdgcn_make_buffer_rsrc((void*)(Kb + (size_t)b * MEMT * MEM_CH + hh * HD), (short)0, MEMT * MEM_CH * 2, RSRC_W3);
            const __amdgpu_buffer_rsrc_t vR = __builtin_amdgcn_make_buffer_rsrc((void*)(Vt + (size_t)hh * HD * MROWS + b * MEMT), (short)0, HD * MROWS * 2, RSRC_W3);
            const unsigned klane = (unsigned)(fr * MEM_CH + 8 * fq) * 2u, vlane = (unsigned)(fr * MROWS + 8 * fq) * 2u;
            const unsigned qlane = (unsigned)(fr * NPROJ + 8 * fq) * 2u, olane = (unsigned)(fq * 4 * D + fr) * 2u;
#pragma unroll 1
            for (int rt = 0; rt < 2; ++rt) {
                const size_t trow = t0 + rbase + rt * 16;
                const char* qU = (const char*)(proj + trow * NPROJ + 768 + hh * HD);
                char* oU = (char*)(cat + trow * D + 512 + hh * HD);
                bf16x8 aq[4];
#pragma unroll
                for (int ks = 0; ks < 4; ++ks) aq[ks] = *(const bf16x8*)(qU + ks * 64 + qlane);
                f32x4 s[16];
#pragma unroll
                for (int ct = 0; ct < 16; ++ct) { s[ct] = (f32x4){0.f, 0.f, 0.f, 0.f};
#pragma unroll
                    for (int ks = 0; ks < 4; ++ks) { const bf16x8 kf = bufld8(kR, klane, (unsigned)(ct * 16 * MEM_CH + ks * 32) * 2u);
                        s[ct] = __builtin_amdgcn_mfma_f32_16x16x32_bf16(aq[ks], kf, s[ct], 0, 0, 0); }
                    if ((ct & 3) == 3) asm volatile("" ::: "memory"); }
                float inv[4];
#pragma unroll
                for (int j = 0; j < 4; ++j) { float m = s[0][j];
#pragma unroll
                    for (int ct = 1; ct < 16; ++ct) m = fmaxf(m, s[ct][j]);
                    m = fmaxf(m, __shfl_xor(m, 1)); m = fmaxf(m, __shfl_xor(m, 2)); m = fmaxf(m, __shfl_xor(m, 4)); m = fmaxf(m, __shfl_xor(m, 8));
                    float sum = 0.f;
#pragma unroll
                    for (int ct = 0; ct < 16; ++ct) { const float p = __builtin_amdgcn_exp2f((s[ct][j] - m) * SC); sum += p; Pw[(fq * 4 + j) * 264 + ct * 16 + fr] = (bf16)(cvt_pk_bf16(p, 0.f) & 0xffffu); }
                    sum += __shfl_xor(sum, 1); sum += __shfl_xor(sum, 2); sum += __shfl_xor(sum, 4); sum += __shfl_xor(sum, 8);
                    inv[j] = 1.f / sum; }
                LDS_WAIT(); asm volatile("" ::: "memory");
                f32x4 o[8];
#pragma unroll
                for (int dt = 0; dt < 8; ++dt) o[dt] = (f32x4){0.f, 0.f, 0.f, 0.f};
#pragma unroll
                for (int ks = 0; ks < 8; ++ks) { const bf16x8 p0 = *(const LAS bf16x8*)(Pw + fr * 264 + ks * 32 + 8 * fq);
#pragma unroll
                    for (int dt = 0; dt < 8; ++dt) { const bf16x8 vf = bufld8(vR, vlane, (unsigned)(dt * 16 * MROWS + ks * 32) * 2u);
                        o[dt] = __builtin_amdgcn_mfma_f32_16x16x32_bf16(p0, vf, o[dt], 0, 0, 0); }
                    if (ks & 1) asm volatile("" ::: "memory"); }
#pragma unroll
                for (int dt = 0; dt < 8; ++dt)
#pragma unroll
                    for (int j = 0; j < 4; ++j) *(bf16*)(oU + (size_t)(j * D + dt * 16) * 2 + olane) = (bf16)(cvt_pk_bf16(o[dt][j] * inv[j], 0.f) & 0xffffu);
                LDS_WAIT(); asm volatile("" ::: "memory");
            }
            __syncthreads();
        }
    }
}

__device__ __forceinline__ void phase_ln1_router(const KArgs& a, int l, LAS unsigned char* lds, int bid, int G) {
    const int tid = threadIdx.x, lane = tid & 63, wave = tid >> 6, fr = lane & 15, fq = lane >> 4;
    unsigned char* ws = a.ws;
    float* dout = a.out; bf16* xb = (bf16*)(ws + WS_XB);
    const float* g = a.in[I_LN1G] + (size_t)l * D; const float* bta = a.in[I_LN1B] + (size_t)l * D;
    const float* rbias = a.in[I_RB] + (size_t)l * NE;
    const bf16* wrt = (const bf16*)(ws + W_RT);
    int* tok_e = (int*)(ws + TOK_E); float* tok_g = (float*)(ws + TOK_G); int* tok_r = (int*)(ws + TOK_R); int* hist = (int*)(ws + TAB_HIST);
    int* row_tok = (int*)(ws + ROW_TOK);
    for (int i = bid * NTHREADS + tid; i < NCH * CH_SLOTS; i += G * NTHREADS) row_tok[i] = 0;
    LAS bf16* Xh = (LAS bf16*)lds;
    LAS float* Lg = (LAS float*)(lds + 32 * 2064);
    LAS int* hl = (LAS int*)(lds + 32 * 2064 + 8192);
    for (int tb = bid; tb < NTB; tb += G) {
        if (tid < 64) hl[tid] = 0;
        __syncthreads();
        for (int st = 0; st < 8; ++st) {
            for (int rr = 0; rr < 4; ++rr) { const int lr = wave * 4 + rr; const size_t t = (size_t)tb * TBLK + st * 32 + lr;
                f32x4* xr = (f32x4*)(dout + t * D) + lane; f32x4 v[4]; float s = 0.f;
#pragma unroll
                for (int j = 0; j < 4; ++j) { v[j] = xr[64 * j]; s += (v[j][0] + v[j][1]) + (v[j][2] + v[j][3]); }
                const float mean = wave_sum(s) * (1.f / D); float s2 = 0.f;
#pragma unroll
                for (int j = 0; j < 4; ++j) { v[j] = v[j] - mean; s2 += (v[j][0] * v[j][0] + v[j][1] * v[j][1]) + (v[j][2] * v[j][2] + v[j][3] * v[j][3]); }
                const float rstd = 1.f / sqrtf(wave_sum(s2) * (1.f / D) + LN_EPS);
                u32x2* o8 = (u32x2*)(xb + t * D) + lane;
#pragma unroll
                for (int j = 0; j < 4; ++j) { const f32x4 gg = ((const f32x4*)g)[lane + 64 * j], bb = ((const f32x4*)bta)[lane + 64 * j]; const f32x4 y = v[j] * rstd * gg + bb;
                    xr[64 * j] = y; u32x2 w; w.x = cvt_pk_bf16(y[0], y[1]); w.y = cvt_pk_bf16(y[2], y[3]); o8[64 * j] = w;
                    *(LAS u32x2*)(Xh + lr * 1032 + 4 * lane + 256 * j) = w; }
            }
            __syncthreads();
            { const int rt = wave >> 2, ct = wave & 3; f32x4 c = (f32x4){0.f, 0.f, 0.f, 0.f};
#pragma unroll 8
                for (int ks = 0; ks < 32; ++ks) { const bf16x8 af = *(const LAS bf16x8*)(Xh + (rt * 16 + fr) * 1032 + ks * 32 + 8 * fq); const bf16x8 bfv = *(const bf16x8*)(wrt + (size_t)(ct * 16 + fr) * D + ks * 32 + 8 * fq);
                    c = __builtin_amdgcn_mfma_f32_16x16x32_bf16(af, bfv, c, 0, 0, 0); }
#pragma unroll
                for (int j = 0; j < 4; ++j) Lg[(rt * 16 + fq * 4 + j) * 64 + ct * 16 + fr] = c[j]; }
            __syncthreads();
            for (int rr = 0; rr < 4; ++rr) { const int lr = wave * 4 + rr; const size_t t = (size_t)tb * TBLK + st * 32 + lr;
                const float sc = fast_sigmoid(Lg[lr * 64 + lane]); float sel = sc + rbias[lane];
                int my_e = 0; float my_s = 0.f, ssum = 0.f;
#pragma unroll
                for (int k = 0; k < TOPK; ++k) { const float m = wave_max(sel); const unsigned long long mask = __ballot(sel == m); const int idx = __ffsll((long long)mask) - 1;
                    const float sk = __shfl(sc, idx); ssum += sk; if (lane == idx) sel = -3.0e38f; if (lane == k) { my_e = idx; my_s = sk; } }
                if (lane < TOPK) { const int rank = __hip_atomic_fetch_add(&hl[my_e], 1, __ATOMIC_RELAXED, __HIP_MEMORY_SCOPE_WORKGROUP);
                    tok_e[t * TOPK + lane] = my_e; tok_g[t * TOPK + lane] = my_s / ssum * ROUTED_SCALE; tok_r[t * TOPK + lane] = rank; }
            }
            __syncthreads();
        }
        if (tid < 64) hist[tb * 64 + tid] = hl[tid];
        __syncthreads();
    }
}

__device__ __forceinline__ void phase_scatter(const KArgs& a, LAS unsigned char* lds, int bid, int G) {
    const int tid = threadIdx.x, lane = tid & 63;
    unsigned char* ws = a.ws;
    const int* tok_e = (const int*)(ws + TOK_E); const float* tok_g = (const float*)(ws + TOK_G); const int* tok_r = (const int*)(ws + TOK_R); int* slot_of = (int*)(ws + TOK_SLOT);
    const int* hist = (const int*)(ws + TAB_HIST); int* ntiles = (int*)(ws + TAB_NT); int* tile_e = (int*)(ws + TAB_TE);
    int* row_tok = (int*)(ws + ROW_TOK); float* row_gate = (float*)(ws + ROW_GATE);
    LAS int* ptot = (LAS int*)lds; LAS int* pbef = ptot + 512; LAS int* base = pbef + 512;
    for (int tb = bid; tb < NTB; tb += G) {
        const int ch = tb / TB_PER_CH;
        { const int e = tid & 63, part = tid >> 6; int tot = 0, bef = 0;
            for (int j = 0; j < 8; ++j) { const int blk = ch * TB_PER_CH + part * 8 + j; const int v = hist[blk * 64 + e]; tot += v; if (blk < tb) bef += v; }
            ptot[part * 64 + e] = tot; pbef[part * 64 + e] = bef; }
        __syncthreads();
        if (tid < 64) { int tot = 0, bef = 0;
#pragma unroll
            for (int p = 0; p < 8; ++p) { tot += ptot[p * 64 + tid]; bef += pbef[p * 64 + tid]; }
            const int padded = (tot + 255) & ~255; int inc = padded;
#pragma unroll
            for (int o = 1; o < 64; o <<= 1) { const int v = __shfl_up(inc, o); if (lane >= o) inc += v; }
            const int ebase = inc - padded;
            base[tid] = ebase + bef;
            if (tb % TB_PER_CH == 0) { if (tid == 63) ntiles[ch] = inc >> 8; for (int j = 0; j < (padded >> 8); ++j) tile_e[ch * CH_TILES_MAX + (ebase >> 8) + j] = tid; }
        }
        __syncthreads();
        for (int q = tid; q < TBLK * TOPK; q += NTHREADS) { const size_t i = (size_t)tb * TBLK * TOPK + q; const int e = tok_e[i]; const int slot = ch * CH_SLOTS + base[e] + tok_r[i];
            row_tok[slot] = (int)(i >> 3); row_gate[slot] = tok_g[i]; slot_of[i] = slot; }
        __syncthreads();
    }
}

__device__ __forceinline__ void phase_combine_ln2(const KArgs& a, int l, int ch, int bid, int G) {
    const int lane = threadIdx.x & 63, wave = threadIdx.x >> 6;
    unsigned char* ws = a.ws;
    float* dout = a.out; bf16* xb = (bf16*)(ws + WS_XB); const bf16* Y = (const bf16*)(ws + WS_Y); const int* slot_of = (const int*)(ws + TOK_SLOT);
    const float* g = a.in[I_LN2G] + (size_t)l * D; const float* bta = a.in[I_LN2B] + (size_t)l * D;
    for (int q = bid * NWAVES + wave; q < CH_TOK; q += G * NWAVES) { const size_t t = (size_t)ch * CH_TOK + q;
        f32x4* xr = (f32x4*)(dout + t * D) + lane; f32x4 v[4];
#pragma unroll
        for (int j = 0; j < 4; ++j) v[j] = xr[64 * j];
#pragma unroll
        for (int k = 0; k < TOPK; ++k) { const int slot = __builtin_amdgcn_readfirstlane(slot_of[t * TOPK + k]) - ch * CH_SLOTS; const u32x2* yr = (const u32x2*)(Y + (size_t)slot * D) + lane;
#pragma unroll
            for (int j = 0; j < 4; ++j) { const u32x2 w = yr[64 * j]; v[j][0] += bf2f(w.x & 0xffffu); v[j][1] += bf2f(w.x >> 16); v[j][2] += bf2f(w.y & 0xffffu); v[j][3] += bf2f(w.y >> 16); } }
        float s = 0.f;
#pragma unroll
        for (int j = 0; j < 4; ++j) s += (v[j][0] + v[j][1]) + (v[j][2] + v[j][3]);
        const float mean = wave_sum(s) * (1.f / D); float s2 = 0.f;
#pragma unroll
        for (int j = 0; j < 4; ++j) { v[j] = v[j] - mean; s2 += (v[j][0] * v[j][0] + v[j][1] * v[j][1]) + (v[j][2] * v[j][2] + v[j][3] * v[j][3]); }
        const float rstd = 1.f / sqrtf(wave_sum(s2) * (1.f / D) + LN_EPS);
        u32x2* o8 = (u32x2*)(xb + t * D) + lane;
#pragma unroll
        for (int j = 0; j < 4; ++j) { const f32x4 gg = ((const f32x4*)g)[lane + 64 * j], bb = ((const f32x4*)bta)[lane + 64 * j]; const f32x4 y = v[j] * rstd * gg + bb;
            xr[64 * j] = y; u32x2 w; w.x = cvt_pk_bf16(y[0], y[1]); w.y = cvt_pk_bf16(y[2], y[3]); o8[64 * j] = w; }
    }
}

__device__ __forceinline__ void phase_gemm_kv(const KArgs& a, LAS unsigned char* lds, int bid, int G) {
    unsigned char* ws = a.ws;
    ge::SchedKV S{(const char*)(ws + WS_MEMN), (const char*)(ws + WS_WKV), (char*)(ws + WS_KB), (char*)(ws + WS_VT), G, bid};
    ge::EpiBf16 E;
    ge::gemm_phase<D, false, ge::EpiBf16, ge::SchedKV>(lds, (const LAS int*)(lds + LDS_TBL), S, E);
}
__device__ __forceinline__ void phase_gemm_in(const KArgs& a, LAS unsigned char* lds, int bid, int G) {
    unsigned char* ws = a.ws;
    ge::SchedDense<D> S{(const char*)(ws + WS_XB), (const char*)(ws + WS_WIN), (char*)(ws + U_PROJ), NPROJ, T / 256, NPROJ / 256, G, bid};
    ge::EpiBf16 E;
    ge::gemm_phase<D, false, ge::EpiBf16, ge::SchedDense<D>>(lds, (const LAS int*)(lds + LDS_TBL), S, E);
}
__device__ __forceinline__ void phase_gemm_out(const KArgs& a, int l, LAS unsigned char* lds, int bid, int G) {
    unsigned char* ws = a.ws;
    ge::SchedDense<D> S{(const char*)(ws + U_CAT), (const char*)(ws + WS_WOUT), (char*)a.out, D, T / 256, D / 256, G, bid};
    ge::EpiResF32 E{l == 0 ? a.in[I_X] : a.out, a.out};
    ge::gemm_phase<D, false, ge::EpiResF32, ge::SchedDense<D>>(lds, (const LAS int*)(lds + LDS_TBL), S, E);
}
__device__ __forceinline__ void phase_gemm_gu(const KArgs& a, LAS unsigned char* lds, int bid, int G) {
    unsigned char* ws = a.ws;
    ge::SchedGU S{(const char*)(ws + WS_XB), (const char*)(ws + WS_WGU), (const char*)(ws + WS_WSGU), (char*)(ws + U_H), (const int*)(ws + TAB_NT), (const int*)(ws + TAB_TE), G, bid, 0, 0, 0, 0};
    S.init();
    LAS int* tbl = (LAS int*)(lds + LDS_TBL);
    const int* row_tok = (const int*)(ws + ROW_TOK);
    { ge::Unit u; for (int i = 0; i < MAXU && S.next(i, u); ++i) { const int r = threadIdx.x; if (r < 256) tbl[i * 256 + r] = (u.aux >= 0) ? (u.aux + r) : row_tok[u.row0 + r]; } }
    __syncthreads();
    ge::EpiSwiGLU E;
    ge::gemm_phase<D, true, ge::EpiSwiGLU, ge::SchedGU>(lds, tbl, S, E);
}
__device__ __forceinline__ void phase_gemm_dn(const KArgs& a, int ch, LAS unsigned char* lds, int bid, int G) {
    unsigned char* ws = a.ws;
    ge::SchedDN S{(const char*)(ws + U_H), (const char*)(ws + WS_WD), (const char*)(ws + WS_WSD), (char*)(ws + WS_Y), (char*)a.out, (const int*)(ws + TAB_TE), ch, ((const int*)(ws + TAB_NT))[ch], G, bid};
    ge::EpiDown E{(const float*)(ws + ROW_GATE)};
    ge::gemm_phase<EH, false, ge::EpiDown, ge::SchedDN>(lds, (const LAS int*)(lds + LDS_TBL), S, E);
}

#define KERNEL_HEAD extern __shared__ __attribute__((aligned(16))) unsigned char lds_raw[]; LAS unsigned char* lds = (LAS unsigned char*)lds_raw; const int bid = blockIdx.x, G = gridDim.x;
__global__ void __launch_bounds__(NTHREADS, 2) k_prologue(KArgs a) { KERNEL_HEAD phase_prologue(a, lds, bid, G); }
__global__ void __launch_bounds__(NTHREADS, 2) k_convert(KArgs a) { KERNEL_HEAD phase_convert_layer(a, a.layer, lds, bid, G); }
__global__ void __launch_bounds__(NTHREADS, 2) k_gemm_kv(KArgs a) { KERNEL_HEAD phase_gemm_kv(a, lds, bid, G); }
__global__ void __launch_bounds__(NTHREADS, 2) k_gemm_in(KArgs a) { KERNEL_HEAD phase_gemm_in(a, lds, bid, G); }
__global__ void __launch_bounds__(NTHREADS, 2) k_mixers(KArgs a) { KERNEL_HEAD phase_mixers(a, a.layer, lds, bid, G); }
__global__ void __launch_bounds__(NTHREADS, 2) k_gemm_out(KArgs a) { KERNEL_HEAD phase_gemm_out(a, a.layer, lds, bid, G); }
__global__ void __launch_bounds__(NTHREADS, 2) k_ln1_router(KArgs a) { KERNEL_HEAD phase_ln1_router(a, a.layer, lds, bid, G); }
__global__ void __launch_bounds__(NTHREADS, 2) k_scatter(KArgs a) { KERNEL_HEAD phase_scatter(a, lds, bid, G); }
__global__ void __launch_bounds__(NTHREADS, 2) k_gemm_gu(KArgs a) { KERNEL_HEAD phase_gemm_gu(a, lds, bid, G); }
__global__ void __launch_bounds__(NTHREADS, 2) k_gemm_dn(KArgs a) { KERNEL_HEAD phase_gemm_dn(a, a.chunk, lds, bid, G); }
__global__ void __launch_bounds__(NTHREADS, 2) k_combine(KArgs a) { KERNEL_HEAD (void)lds; phase_combine_ln2(a, a.layer, a.chunk, bid, G); }

extern "C" void kernel_launch(void* const* d_in, const int* in_sizes, int n_in, void* d_out, int out_size, void* d_ws, size_t ws_size, hipStream_t stream) {
    static int grid = 0;
    if (!grid) {
        if (n_in != 25 || out_size != T * D || ws_size < WS_END) { fprintf(stderr, "kernel_launch: unexpected shapes (n_in %d out %d ws %zu need %zu)\n", n_in, out_size, ws_size, (size_t)WS_END); grid = -1; return; }
        int dev = 0, cus = 0; hipGetDevice(&dev); hipDeviceGetAttribute(&cus, hipDeviceAttributeMultiprocessorCount, dev);
        const void* ks[] = {(const void*)k_prologue, (const void*)k_convert, (const void*)k_gemm_kv, (const void*)k_gemm_in, (const void*)k_mixers, (const void*)k_gemm_out, (const void*)k_ln1_router,
                            (const void*)k_scatter, (const void*)k_gemm_gu, (const void*)k_gemm_dn, (const void*)k_combine};
        for (const void* k : ks) if (hipFuncSetAttribute(k, hipFuncAttributeMaxDynamicSharedMemorySize, LDS_BYTES) != hipSuccess) { fprintf(stderr, "kernel_launch: hipFuncSetAttribute failed\n"); grid = -1; return; }
        grid = cus > 0 ? cus : 256; if (grid > 256) grid = 256;
    }
    if (grid < 0) return;
    KArgs a{};
    for (int i = 0; i < 25; ++i) a.in[i] = (const float*)d_in[i];
    a.out = (float*)d_out; a.ws = (unsigned char*)d_ws; a.layer = 0; a.chunk = 0;
    const dim3 g(grid), b(NTHREADS);
    hipLaunchKernelGGL(k_prologue, g, b, LDS_BYTES, stream, a);
    hipLaunchKernelGGL(k_gemm_kv, g, b, LDS_BYTES, stream, a);
    for (int l = 0; l < DEPTH; ++l) {
        a.layer = l; a.chunk = 0;
        hipLaunchKernelGGL(k_convert, g, b, LDS_BYTES, stream, a);
        hipLaunchKernelGGL(k_gemm_in, g, b, LDS_BYTES, stream, a);
        hipLaunchKernelGGL(k_mixers, g, b, LDS_BYTES, stream, a);
        hipLaunchKernelGGL(k_gemm_out, g, b, LDS_BYTES, stream, a);
        hipLaunchKernelGGL(k_ln1_router, g, b, LDS_BYTES, stream, a);
        hipLaunchKernelGGL(k_scatter, g, b, LDS_BYTES, stream, a);
        hipLaunchKernelGGL(k_gemm_gu, g, b, LDS_BYTES, stream, a);
        for (int c = 0; c < NCH; ++c) { a.chunk = c;
            hipLaunchKernelGGL(k_gemm_dn, g, b, LDS_BYTES, stream, a);
            hipLaunchKernelGGL(k_combine, g, b, LDS_BYTES, stream, a); }
    }
}
```

```cpp
#include <hip/hip_runtime.h>
#include <cstdio>
#include <cstdint>

#ifndef MK_ONE_LAUNCH
#define MK_ONE_LAUNCH 1
#endif

#define LAS __attribute__((address_space(3)))
typedef unsigned short bf16;
typedef short bf16x8 __attribute__((ext_vector_type(8)));
typedef float f32x4 __attribute__((ext_vector_type(4)));
typedef float f32x2 __attribute__((ext_vector_type(2)));
typedef unsigned u32x4 __attribute__((ext_vector_type(4)));
typedef unsigned u32x2 __attribute__((ext_vector_type(2)));

constexpr int D = 1024, NBATCH = 16, SEQ = 4096, T = NBATCH * SEQ, DEPTH = 4;
constexpr int MEMT = 256, MROWS = NBATCH * MEMT;
constexpr int NPROJ = 1280, POOL_CH = 256, CONV_CH = 256, MEM_CH = 512, HEADS = 4, HD = 128;
constexpr int NE = 64, TOPK = 8, EH = 256;
constexpr int NCH = 4, CH_TOK = T / NCH, CH_SLOTS = CH_TOK * TOPK + NE * 256, CH_TILES_MAX = CH_SLOTS / 256;
constexpr int TBLK = 256, NTB = T / TBLK, TB_PER_CH = NTB / NCH;
constexpr int SH_ROW0 = NCH * CH_SLOTS;
constexpr float LN_EPS = 1e-5f;
constexpr float ALPHA = 1.6817928305074290f;
constexpr float ROUTED_SCALE = 2.5f;

constexpr size_t MiB = 1u << 20;
constexpr size_t WS_CTL = 0;
constexpr size_t CTL_BYTES = 1 * MiB;
constexpr size_t WS_TAB = WS_CTL + CTL_BYTES;
constexpr size_t TAB_HIST = WS_TAB, TAB_NT = WS_TAB + 65536, TAB_TE = WS_TAB + 65536 + 256;
constexpr size_t WS_TOK = WS_TAB + 1 * MiB;
constexpr size_t TOK_E = WS_TOK, TOK_G = WS_TOK + 2 * MiB, TOK_R = WS_TOK + 4 * MiB, TOK_SLOT = WS_TOK + 6 * MiB;
constexpr size_t WS_ROW = WS_TOK + 8 * MiB;
constexpr size_t ROW_TOK = WS_ROW, ROW_GATE = WS_ROW + 2560 * 1024;
constexpr size_t WS_SMALLW = WS_ROW + 5 * MiB;
constexpr size_t W_RT = WS_SMALLW, W_PT = WS_SMALLW + 131072, W_DWT = WS_SMALLW + 196608;
constexpr size_t WS_WIN = WS_SMALLW + 1 * MiB;
constexpr size_t WS_WOUT = WS_WIN + (size_t)NPROJ * D * 2;
constexpr size_t WS_WGU = WS_WOUT + (size_t)D * D * 2;
constexpr size_t WS_WD = WS_WGU + (size_t)NE * 512 * D * 2;
constexpr size_t WS_WSGU = WS_WD + (size_t)NE * D * EH * 2;
constexpr size_t WS_WSD = WS_WSGU + (size_t)512 * D * 2;
constexpr size_t WS_WKV = WS_WSD + (size_t)D * EH * 2;
constexpr size_t WS_MEMN = WS_WKV + (size_t)DEPTH * D * D * 2;
constexpr size_t WS_KB = WS_MEMN + (size_t)MROWS * D * 2;
constexpr size_t WS_VT = WS_KB + (size_t)DEPTH * MROWS * MEM_CH * 2;
constexpr size_t WS_XB = WS_VT + (size_t)DEPTH * MROWS * MEM_CH * 2;
constexpr size_t WS_U = WS_XB + (size_t)T * D * 2;
constexpr size_t U_PROJ = WS_U, U_CAT = WS_U + (size_t)T * NPROJ * 2, U_H = WS_U;
constexpr size_t U_BYTES = (size_t)(NCH * CH_SLOTS + T) * EH * 2;
static_assert(U_BYTES >= (size_t)T * NPROJ * 2 + (size_t)T * D * 2, "union region");
constexpr size_t WS_Y = WS_U + U_BYTES;
constexpr size_t WS_END = WS_Y + (size_t)CH_SLOTS * D * 2;

constexpr int LDS_STAGE = 0, STAGE_BYTES = 131072;
constexpr int MAXU = 24;
constexpr int LDS_TBL = STAGE_BYTES, LDS_CTLW = LDS_TBL + MAXU * 1024, LDS_BYTES = LDS_CTLW + 1024;
constexpr int NTHREADS = 512, NWAVES = 8;

__device__ __forceinline__ unsigned cvt_pk_bf16(float lo, float hi) { unsigned r; asm volatile("v_cvt_pk_bf16_f32 %0, %1, %2" : "=v"(r) : "v"(lo), "v"(hi)); return r; }
__device__ __forceinline__ float bf2f(unsigned h) { return __uint_as_float(h << 16); }
template <int M> __device__ __forceinline__ float swz_xor(float v) { return __int_as_float(__builtin_amdgcn_ds_swizzle(__float_as_int(v), (M << 10) | 0x1f)); }
__device__ __forceinline__ float bperm_f(int srclane, float v) { return __int_as_float(__builtin_amdgcn_ds_bpermute(srclane << 2, __float_as_int(v))); }
__device__ __forceinline__ int bperm_i(int srclane, int v) { return __builtin_amdgcn_ds_bpermute(srclane << 2, v); }
__device__ __forceinline__ float wave_sum(float v, int lane) {
    v += swz_xor<1>(v); v += swz_xor<2>(v); v += swz_xor<4>(v); v += swz_xor<8>(v); v += swz_xor<16>(v); v += bperm_f(lane ^ 32, v);
    return v;
}
__device__ __forceinline__ float wave_max(float v, int lane) {
    v = fmaxf(v, swz_xor<1>(v)); v = fmaxf(v, swz_xor<2>(v)); v = fmaxf(v, swz_xor<4>(v)); v = fmaxf(v, swz_xor<8>(v)); v = fmaxf(v, swz_xor<16>(v)); v = fmaxf(v, bperm_f(lane ^ 32, v));
    return v;
}
__device__ __forceinline__ float fast_sigmoid(float x) { return __builtin_amdgcn_rcpf(1.0f + __builtin_amdgcn_exp2f(-1.4426950408889634f * x)); }
__device__ __forceinline__ float fast_silu(float x) { return x * fast_sigmoid(x); }
#define LDS_WAIT() asm volatile("s_waitcnt lgkmcnt(0)" ::: "memory")
#define RSRC_W3 0x00020000
__device__ __forceinline__ bf16x8 bufld8(__amdgpu_buffer_rsrc_t rs, unsigned voff, unsigned soff) { const u32x4 v = __builtin_amdgcn_raw_buffer_load_b128(rs, (int)voff, (int)soff, 0); return __builtin_bit_cast(bf16x8, v); }

#define XB_TMO      128
#define XB_XCNT(j)  (256  + 64 * (j))
#define XB_XSUB(j)  (1280 + 64 * (j))
#define XB_XGEN(j)  (2304 + 64 * (j))
#define XB_TOP      3328
#define XB_TOPGEN   3392
#define XCD_BAR_WORDS 3456
#define XB_SPIN_CAP (1u << 18)
__device__ __forceinline__ unsigned xb_ld(unsigned* p)              { return __hip_atomic_load(p, __ATOMIC_RELAXED, __HIP_MEMORY_SCOPE_AGENT); }
__device__ __forceinline__ unsigned xb_add(unsigned* p, unsigned v) { return __hip_atomic_fetch_add(p, v, __ATOMIC_RELAXED, __HIP_MEMORY_SCOPE_AGENT); }
__device__ __forceinline__ unsigned xb_xcc_id() { return (unsigned)__builtin_amdgcn_s_getreg((3 << 11) | 20) & 0xFu; }
#define XB_SPIN(cond, bar) do { unsigned _sp = 0; while (cond) { __builtin_amdgcn_s_sleep(1); \
    if ((++_sp & 255u) == 0u) { if (xb_ld(&(bar)[XB_TMO])) break; if (_sp > XB_SPIN_CAP) { atomicAdd(&(bar)[XB_TMO], 1u); break; } } } } while (0)
struct XcdBarrier { unsigned* bar; unsigned x; volatile LAS unsigned* st; };
__device__ __forceinline__ XcdBarrier xcd_barrier_post(unsigned* bar, volatile LAS unsigned* st, int tid) {
    XcdBarrier b; b.bar = bar; b.x = xb_xcc_id(); b.st = st;
    if (tid == 0) (void)xb_add(&bar[XB_XCNT(b.x)], 1u);
    return b;
}
__device__ __forceinline__ void xcd_barrier_complete(unsigned* bar, unsigned x, unsigned& nloc, unsigned& nx) {
    const unsigned G = gridDim.x * gridDim.y * gridDim.z;
    unsigned sum, cnt, mine, sp = 0u;
    for (;;) {
        sum = 0u; cnt = 0u; mine = 0u;
#pragma unroll
        for (unsigned j = 0; j < 16; ++j) { const unsigned c = xb_ld(&bar[XB_XCNT(j)]); sum += c; cnt += (c > 0u) ? 1u : 0u; mine = (j == x) ? c : mine; }
        if (sum == G) break;
        __builtin_amdgcn_s_sleep(1);
        if ((++sp & 255u) == 0u) { if (xb_ld(&bar[XB_TMO])) break; if (sp > XB_SPIN_CAP) { atomicAdd(&bar[XB_TMO], 1u); break; } }
    }
    nloc = mine > 0u ? mine : 1u; nx = cnt > 0u ? cnt : 1u;
}
__device__ __forceinline__ void xcd_barrier(const XcdBarrier& b, int tid) {
    asm volatile("s_waitcnt vmcnt(0)" ::: "memory");
    __syncthreads();
    if (tid == 0) {
        unsigned* bar = b.bar;
        __builtin_amdgcn_s_waitcnt(0);
        unsigned nloc = b.st[0], nx = b.st[1];
        if (nloc == 0u) { xcd_barrier_complete(bar, b.x, nloc, nx); b.st[0] = nloc; b.st[1] = nx; }
        const unsigned old = xb_add(&bar[XB_XSUB(b.x)], 1u);
        const unsigned gen = old / nloc;
        if (old + 1u == (gen + 1u) * nloc) {
            __builtin_amdgcn_fence(__ATOMIC_RELEASE, "agent");
            asm volatile("s_waitcnt vmcnt(0)" ::: "memory");
            const unsigned og = xb_add(&bar[XB_TOP], 1u);
            const unsigned tg = og / nx;
            if (og + 1u == (tg + 1u) * nx) xb_add(&bar[XB_TOPGEN], 1u);
            else XB_SPIN(xb_ld(&bar[XB_TOPGEN]) == tg, bar);
            __builtin_amdgcn_fence(__ATOMIC_ACQUIRE, "agent");
            xb_add(&bar[XB_XGEN(b.x)], 1u);
            asm volatile("s_waitcnt vmcnt(0)" ::: "memory");
        } else {
            XB_SPIN(xb_ld(&bar[XB_XGEN(b.x)]) == gen, bar);
            __builtin_amdgcn_fence(__ATOMIC_ACQUIRE, "agent");
            asm volatile("s_waitcnt vmcnt(0)" ::: "memory");
        }
    }
    __syncthreads();
}

__device__ __forceinline__ void grid_bar(const XcdBarrier& b0, int wave_s) {
    unsigned* bp = b0.bar; unsigned x = b0.x; unsigned st = (unsigned)(uintptr_t)b0.st;
    asm volatile("" : "+s"(bp), "+s"(x), "+s"(st));
    XcdBarrier b; b.bar = bp; b.x = x; b.st = (volatile LAS unsigned*)(uintptr_t)st;
    int z = 0; asm volatile("" : "+v"(z)); const int tid = (wave_s << 6) | (int)__builtin_amdgcn_mbcnt_hi(~0u, __builtin_amdgcn_mbcnt_lo(~0u, (unsigned)z));
    xcd_barrier(b, tid);
}

namespace ge {
constexpr int BM = 256, BK = 64, HALF = 128, HTB = HALF * BK * 2, NXCD = 8, WGM = 8;
__device__ __forceinline__ int lds_byte(int r, int c) { const int st = (r >> 4) * 2 + (c >> 5), rr = r & 15, cc = c & 31, ob = rr * 64 + cc * 2; return st * 1024 + (ob ^ (((ob >> 9) & 1) << 5)); }
__device__ __forceinline__ void stage_rc(int b, int& R, int& C) { const int st = b / 1024, sb = b % 1024, swz = sb ^ (((sb >> 9) & 1) << 5); R = (st >> 1) * 16 + swz / 64; C = (st & 1) * 32 + (swz % 64) / 2; }
__device__ __forceinline__ int perm32(int rho) { const int n = rho >> 4, i = rho & 15; return 8 * (i >> 2) + 4 * n + (i & 3); }
__device__ __forceinline__ int xcd_remap(int L, int n) { const int q = n / NXCD, r = n % NXCD, xcd = L % NXCD, off = L / NXCD; return (xcd < r ? xcd * (q + 1) : r * (q + 1) + (xcd - r) * q) + off; }

struct Unit {
    const char* A;
    const char* B;
    char* O;
    int ldc, row0, col0, aux, tbl;
};

template <int K, bool GATHER, class Epi, class Sched>
__device__ __forceinline__ void gemm_phase(const int tid, LAS unsigned char* lds, const LAS int* tbl, const Sched& S, const Epi& E) {
    const int wid = __builtin_amdgcn_readfirstlane(tid >> 6), lane = tid & 63, wr = wid >> 2, wc = wid & 3, fr = lane & 15, fq = lane >> 4;
    constexpr int nt = K / BK;
    static_assert(K % 128 == 0 && K >= 256, "K");
    int Rr[2], Cc[2]; unsigned voffB[2];
#pragma unroll
    for (int i = 0; i < 2; ++i) { int R, C; stage_rc(tid * 16 + i * 8192, R, C); const int Rb = (R & ~31) + perm32(R & 31); Rr[i] = R; Cc[i] = C; voffB[i] = (unsigned)(Rb * K + C) * 2u; }
    constexpr size_t kstep = (size_t)(BK * 2);
    constexpr size_t hstep = (size_t)HALF * K * 2;
    const unsigned ldsw = (unsigned)wid * 1024u;
    const int aoff = lds_byte(wr * 64 + fr, fq * 8), boff = lds_byte(wc * 32 + fr, fq * 8);
#define GE_SA(b, h) (((b) * 2 + (h)) * HTB)
#define GE_SB(b, h) ((4 + (b) * 2 + (h)) * HTB)
#define GE_STAGE_B(bufoff, gbase) do { _Pragma("unroll") for (int _i = 0; _i < 2; ++_i) \
        __builtin_amdgcn_global_load_lds((const unsigned*)((const char*)(gbase) + voffB[_i]), (LAS unsigned*)(lds + (bufoff) + ldsw + _i * 8192), 16, 0, 0); } while (0)
#define GE_STAGE_A(bufoff, gbase, o0, o1) do { \
        __builtin_amdgcn_global_load_lds((const unsigned*)((const char*)(gbase) + (o0)), (LAS unsigned*)(lds + (bufoff) + ldsw), 16, 0, 0); \
        __builtin_amdgcn_global_load_lds((const unsigned*)((const char*)(gbase) + (o1)), (LAS unsigned*)(lds + (bufoff) + ldsw + 8192), 16, 0, 0); } while (0)
#define GE_LDA(dst, b, h) do { _Pragma("unroll") for (int m = 0; m < 4; ++m) _Pragma("unroll") for (int k = 0; k < 2; ++k) dst[m][k] = *(const LAS bf16x8*)(lds + GE_SA(b, h) + aoff + m * 2048 + k * 1024); } while (0)
#define GE_LDB(dst, b, h) do { _Pragma("unroll") for (int n = 0; n < 2; ++n) _Pragma("unroll") for (int k = 0; k < 2; ++k) dst[n][k] = *(const LAS bf16x8*)(lds + GE_SB(b, h) + boff + n * 2048 + k * 1024); } while (0)
#define GE_MMA(ai, bj, At, Bt) do { __builtin_amdgcn_s_setprio(1); _Pragma("unroll") for (int m = 0; m < 4; ++m) _Pragma("unroll") for (int n = 0; n < 2; ++n) _Pragma("unroll") for (int k = 0; k < 2; ++k) \
        acc[ai][bj][m][n] = __builtin_amdgcn_mfma_f32_16x16x32_bf16(Bt[n][k], At[m][k], acc[ai][bj][m][n], 0, 0, 0); __builtin_amdgcn_s_setprio(0); } while (0)
#define GE_WAIT_V(n) asm volatile("s_waitcnt vmcnt(" #n ")" ::: "memory")
#define GE_WAIT_L(n) asm volatile("s_waitcnt lgkmcnt(" #n ")" ::: "memory")
#define GE_BAR __builtin_amdgcn_s_barrier()
#define GE_SCHED __builtin_amdgcn_sched_barrier(0)
#define GE_LOAD_VA(dst, u) do { _Pragma("unroll") for (int _h = 0; _h < 2; ++_h) _Pragma("unroll") for (int _i = 0; _i < 2; ++_i) { \
        if constexpr (GATHER) dst[_h][_i] = (unsigned)tbl[(u).tbl * 256 + _h * 128 + Rr[_i]] * (unsigned)(K * 2) + (unsigned)(Cc[_i] * 2); \
        else dst[_h][_i] = (unsigned)((_h * 128 + Rr[_i]) * K + Cc[_i]) * 2u; } } while (0)
    Unit cur, nxt; int ui = 0;
    if (!S.next(0, cur)) return;
    f32x4 acc[2][2][4][2];
#pragma unroll
    for (int a = 0; a < 2; ++a)
#pragma unroll
        for (int b = 0; b < 2; ++b)
#pragma unroll
            for (int m = 0; m < 4; ++m)
#pragma unroll
                for (int n = 0; n < 2; ++n) acc[a][b][m][n] = (f32x4){0.f, 0.f, 0.f, 0.f};
    bf16x8 At[4][2], B0[2][2], B1[2][2];
    unsigned va[2][2], vn[2][2];
    GE_LOAD_VA(va, cur);
#pragma unroll
    for (int h = 0; h < 2; ++h)
#pragma unroll
        for (int i = 0; i < 2; ++i) vn[h][i] = va[h][i];
    const char* cA = cur.A; const char* cB = cur.B;
    GE_STAGE_B(GE_SB(0, 0), cB); GE_STAGE_B(GE_SB(0, 1), cB + hstep); GE_STAGE_A(GE_SA(0, 0), cA, va[0][0], va[0][1]); GE_STAGE_A(GE_SA(0, 1), cA, va[1][0], va[1][1]);
    if (wr == 1) GE_BAR;
    GE_WAIT_V(2); GE_BAR;
    GE_STAGE_B(GE_SB(1, 0), cB + kstep); GE_STAGE_A(GE_SA(1, 0), cA + kstep, va[0][0], va[0][1]); GE_STAGE_B(GE_SB(1, 1), cB + hstep + kstep);
    GE_WAIT_V(6); GE_BAR;
    for (;;) {
        const bool has_next = S.next(ui + 1, nxt);
        const char* nA = has_next ? nxt.A : cA; const char* nB = has_next ? nxt.B : cB;
        for (int t = 0; t < nt; t += 2) {
            const bool last = (t == nt - 2);
            if (last && has_next) { GE_LOAD_VA(vn, nxt); }
            const char* a1 = cA + (size_t)(t + 1) * kstep;
            const char* a2 = last ? nA : cA + (size_t)(t + 2) * kstep; const char* b2 = last ? nB : cB + (size_t)(t + 2) * kstep;
            const char* a3 = a2 + kstep; const char* b3 = b2 + kstep;
            const unsigned x00 = last ? vn[0][0] : va[0][0], x01 = last ? vn[0][1] : va[0][1], x10 = last ? vn[1][0] : va[1][0], x11 = last ? vn[1][1] : va[1][1];
            GE_LDB(B0, 0, 0); GE_LDB(B1, 0, 1); GE_SCHED; GE_LDA(At, 0, 0); GE_STAGE_A(GE_SA(1, 1), a1, va[1][0], va[1][1]);
            GE_WAIT_V(8); GE_WAIT_L(0); GE_BAR; GE_MMA(0, 0, At, B0); GE_MMA(0, 1, At, B1); GE_BAR; GE_SCHED;
            GE_LDA(At, 0, 1); GE_STAGE_B(GE_SB(0, 0), b2); GE_STAGE_B(GE_SB(0, 1), b2 + hstep); GE_STAGE_A(GE_SA(0, 0), a2, x00, x01);
            GE_WAIT_V(8); GE_WAIT_L(0); GE_BAR; GE_MMA(1, 0, At, B0); GE_MMA(1, 1, At, B1); GE_BAR; GE_SCHED;
            GE_LDB(B0, 1, 0); GE_LDB(B1, 1, 1); GE_SCHED; GE_LDA(At, 1, 0); GE_STAGE_A(GE_SA(0, 1), a2, x10, x11);
            GE_WAIT_V(8); GE_WAIT_L(0); GE_BAR; GE_MMA(0, 0, At, B0); GE_MMA(0, 1, At, B1); GE_BAR; GE_SCHED;
            GE_LDA(At, 1, 1); GE_STAGE_B(GE_SB(1, 0), b3); GE_STAGE_B(GE_SB(1, 1), b3 + hstep); GE_STAGE_A(GE_SA(1, 0), a3, x00, x01);
            GE_WAIT_V(8); GE_WAIT_L(0); GE_BAR; GE_MMA(1, 0, At, B0); GE_MMA(1, 1, At, B1); GE_BAR; GE_SCHED;
        }
        if (wr == 0) GE_BAR;
        E(acc, cur, wr, wc, fr, fq);
        if (!has_next) break;
#pragma unroll
        for (int a = 0; a < 2; ++a)
#pragma unroll
            for (int b = 0; b < 2; ++b)
#pragma unroll
                for (int m = 0; m < 4; ++m)
#pragma unroll
                    for (int n = 0; n < 2; ++n) acc[a][b][m][n] = (f32x4){0.f, 0.f, 0.f, 0.f};
        cur = nxt; cA = nA; cB = nB; ++ui;
#pragma unroll
        for (int h = 0; h < 2; ++h)
#pragma unroll
            for (int i = 0; i < 2; ++i) va[h][i] = vn[h][i];
        if (wr == 1) GE_BAR;
    }
    GE_WAIT_V(0);
    GE_BAR;
#undef GE_SA
#undef GE_SB
#undef GE_STAGE_A
#undef GE_STAGE_B
#undef GE_LDA
#undef GE_LDB
#undef GE_MMA
#undef GE_WAIT_V
#undef GE_WAIT_L
#undef GE_BAR
#undef GE_SCHED
#undef GE_LOAD_VA
}

struct EpiBf16 {
    __device__ __forceinline__ void operator()(const f32x4 (&acc)[2][2][4][2], const Unit& u, int wr, int wc, int fr, int fq) const {
#pragma unroll
        for (int ai = 0; ai < 2; ++ai)
#pragma unroll
            for (int m = 0; m < 4; ++m) { bf16* rowp = (bf16*)u.O + (size_t)(u.row0 + ai * HALF + wr * 64 + m * 16 + fr) * u.ldc + u.col0 + wc * 32 + 8 * fq;
#pragma unroll
                for (int bj = 0; bj < 2; ++bj) { const f32x4 v0 = acc[ai][bj][m][0], v1 = acc[ai][bj][m][1];
                    u32x4 w; w.x = cvt_pk_bf16(v0[0], v0[1]); w.y = cvt_pk_bf16(v0[2], v0[3]); w.z = cvt_pk_bf16(v1[0], v1[1]); w.w = cvt_pk_bf16(v1[2], v1[3]);
                    *(u32x4*)(rowp + bj * HALF) = w; } }
    }
};
struct EpiResF32 {
    const float* res; float* out;
    __device__ __forceinline__ void operator()(const f32x4 (&acc)[2][2][4][2], const Unit& u, int wr, int wc, int fr, int fq) const {
#pragma unroll
        for (int ai = 0; ai < 2; ++ai)
#pragma unroll
            for (int m = 0; m < 4; ++m) { const size_t off = (size_t)(u.row0 + ai * HALF + wr * 64 + m * 16 + fr) * D + u.col0 + wc * 32 + 8 * fq;
#pragma unroll
                for (int bj = 0; bj < 2; ++bj) { const f32x4 r0 = *(const f32x4*)(res + off + bj * HALF), r1 = *(const f32x4*)(res + off + bj * HALF + 4);
                    *(f32x4*)(out + off + bj * HALF) = r0 * ALPHA + acc[ai][bj][m][0]; *(f32x4*)(out + off + bj * HALF + 4) = r1 * ALPHA + acc[ai][bj][m][1]; }
                asm volatile("" ::: "memory"); }
    }
};
struct EpiSwiGLU {
    __device__ __forceinline__ void operator()(const f32x4 (&acc)[2][2][4][2], const Unit& u, int wr, int wc, int fr, int fq) const {
#pragma unroll
        for (int ai = 0; ai < 2; ++ai)
#pragma unroll
            for (int m = 0; m < 4; ++m) { bf16* rowp = (bf16*)u.O + (size_t)(u.row0 + ai * HALF + wr * 64 + m * 16 + fr) * EH + u.col0 + wc * 32 + 8 * fq;
                const f32x4 g0 = acc[ai][0][m][0], g1 = acc[ai][0][m][1], u0 = acc[ai][1][m][0], u1 = acc[ai][1][m][1];
                float v[8];
#pragma unroll
                for (int j = 0; j < 4; ++j) { v[j] = fast_silu(g0[j]) * u0[j]; v[4 + j] = fast_silu(g1[j]) * u1[j]; }
                u32x4 w; w.x = cvt_pk_bf16(v[0], v[1]); w.y = cvt_pk_bf16(v[2], v[3]); w.z = cvt_pk_bf16(v[4], v[5]); w.w = cvt_pk_bf16(v[6], v[7]);
                *(u32x4*)rowp = w; }
    }
};
struct EpiDown {
    const float* gate;
    __device__ __forceinline__ void operator()(const f32x4 (&acc)[2][2][4][2], const Unit& u, int wr, int wc, int fr, int fq) const {
        if (u.aux >= 0) {
#pragma unroll
            for (int ai = 0; ai < 2; ++ai)
#pragma unroll
                for (int m = 0; m < 4; ++m) { const int r = ai * HALF + wr * 64 + m * 16 + fr; const float g = gate[u.aux + r];
                    bf16* rowp = (bf16*)u.O + (size_t)(u.row0 + r) * D + u.col0 + wc * 32 + 8 * fq;
#pragma unroll
                    for (int bj = 0; bj < 2; ++bj) { const f32x4 v0 = acc[ai][bj][m][0] * g, v1 = acc[ai][bj][m][1] * g;
                        u32x4 w; w.x = cvt_pk_bf16(v0[0], v0[1]); w.y = cvt_pk_bf16(v0[2], v0[3]); w.z = cvt_pk_bf16(v1[0], v1[1]); w.w = cvt_pk_bf16(v1[2], v1[3]);
                        *(u32x4*)(rowp + bj * HALF) = w; } }
        } else {
            float* out = (float*)u.O;
#pragma unroll
            for (int ai = 0; ai < 2; ++ai)
#pragma unroll
                for (int m = 0; m < 4; ++m) { const size_t off = (size_t)(u.row0 + ai * HALF + wr * 64 + m * 16 + fr) * D + u.col0 + wc * 32 + 8 * fq;
#pragma unroll
                    for (int bj = 0; bj < 2; ++bj) { const f32x4 r0 = *(const f32x4*)(out + off + bj * HALF), r1 = *(const f32x4*)(out + off + bj * HALF + 4);
                        *(f32x4*)(out + off + bj * HALF) = r0 * ALPHA + acc[ai][bj][m][0]; *(f32x4*)(out + off + bj * HALF + 4) = r1 * ALPHA + acc[ai][bj][m][1]; }
                    asm volatile("" ::: "memory"); }
        }
    }
};

template <int K> struct SchedDense {
    const char* A; const char* B; char* O; int ldc, nM, nN, G, c;
    __device__ __forceinline__ bool next(int i, Unit& u) const {
        const int nwg = nM * nN; const long L = (long)i * G + c; if (L >= nwg) return false;
        const int wgid = xcd_remap((int)L, nwg);
        const int nig = WGM * nN, gid = wgid / nig, fm = gid * WGM, gsz = (nM - fm) < WGM ? (nM - fm) : WGM;
        const int pm = fm + ((wgid % nig) % gsz), pn = (wgid % nig) / gsz;
        u.A = A + (size_t)pm * (256 * K * 2); u.B = B + (size_t)pn * (256 * K * 2); u.O = O; u.ldc = ldc; u.row0 = pm * 256; u.col0 = pn * 256; u.aux = 0; u.tbl = 0; return true;
    }
};
struct SchedKV {
    const char* memn; const char* wkv; char* kb; char* vt; int G, c;
    __device__ __forceinline__ bool next(int i, Unit& u) const {
        const long L = (long)i * G + c; if (L >= 256) return false;
        const int idx = (int)L, l = idx >> 6, r = idx & 63; u.aux = 0; u.tbl = 0;
        const char* w = wkv + (size_t)l * D * D * 2;
        if (r < 32) { const int pm = r >> 1, pn = r & 1;
            u.A = memn + (size_t)pm * 256 * D * 2; u.B = w + (size_t)pn * 256 * D * 2; u.O = kb + (size_t)l * MROWS * MEM_CH * 2; u.ldc = MEM_CH; u.row0 = pm * 256; u.col0 = pn * 256; }
        else { const int q = r - 32, pm = q >> 4, pn = q & 15;
            u.A = w + (size_t)(512 + pm * 256) * D * 2; u.B = memn + (size_t)pn * 256 * D * 2; u.O = vt + (size_t)l * MROWS * MEM_CH * 2; u.ldc = MROWS; u.row0 = pm * 256; u.col0 = pn * 256; }
        return true;
    }
};
struct SchedGU {
    const char* xb; const char* wgu; const char* wsgu; char* h; const int* ntiles; const int* tile_e; int G, c;
    int n0, n1, n2, n3;
    __device__ __forceinline__ void init() { n0 = ntiles[0]; n1 = ntiles[1]; n2 = ntiles[2]; n3 = ntiles[3]; }
    __device__ __forceinline__ bool next(int i, Unit& u) const {
        const int ntot = n0 + n1 + n2 + n3 + T / 256, nun = ntot * 2; const long L = (long)i * G + c; if (L >= nun || i >= MAXU) return false;
        const int idx = xcd_remap((int)L, nun), pn = idx & 1; int rt = idx >> 1;
        u.A = xb; u.O = h; u.ldc = EH; u.col0 = pn * 128; u.tbl = i;
        int ch = -1, lt = 0;
        if (rt < n0) { ch = 0; lt = rt; } else { rt -= n0; if (rt < n1) { ch = 1; lt = rt; } else { rt -= n1; if (rt < n2) { ch = 2; lt = rt; } else { rt -= n2; if (rt < n3) { ch = 3; lt = rt; } else { rt -= n3; } } } }
        if (ch >= 0) { const int e = tile_e[ch * CH_TILES_MAX + lt]; u.B = wgu + (size_t)e * 512 * D * 2 + (size_t)pn * 256 * D * 2; u.row0 = ch * CH_SLOTS + lt * 256; u.aux = -1; }
        else { u.B = wsgu + (size_t)pn * 256 * D * 2; u.row0 = SH_ROW0 + rt * 256; u.aux = rt * 256; }
        return true;
    }
};
struct SchedDN {
    const char* h; const char* wd; const char* wsd; char* y; char* dout; const int* tile_e; int ch, nt, G, c;
    __device__ __forceinline__ bool next(int i, Unit& u) const {
        const int nun = (CH_TOK / 256 + nt) * 4; const long L = (long)i * G + c; if (L >= nun) return false;
        const int idx = xcd_remap((int)L, nun), pn = idx & 3; int rt = idx >> 2; u.tbl = 0; u.ldc = D; u.col0 = pn * 256;
        if (rt < CH_TOK / 256) { const int row = ch * CH_TOK + rt * 256; u.A = h + (size_t)(SH_ROW0 + row) * EH * 2; u.B = wsd + (size_t)pn * 256 * EH * 2; u.O = dout; u.row0 = row; u.aux = -1; }
        else { rt -= CH_TOK / 256; const int e = tile_e[ch * CH_TILES_MAX + rt]; const int slot0 = ch * CH_SLOTS + rt * 256;
            u.A = h + (size_t)slot0 * EH * 2; u.B = wd + (size_t)e * D * EH * 2 + (size_t)pn * 256 * EH * 2; u.O = y; u.row0 = rt * 256; u.aux = slot0; }
        return true;
    }
};
}

struct KArgs { const float* in[25]; float* out; unsigned char* ws; int layer; int chunk; };
typedef const __attribute__((address_space(4))) KArgs* KArgP;
#define KA_OPAQUE(p) asm volatile("" : "+s"(p))
#define PHASE_BEGIN() int z_ = 0; asm volatile("" : "+v"(z_)); int tid = (wave_s << 6) | (int)__builtin_amdgcn_mbcnt_hi(~0u, __builtin_amdgcn_mbcnt_lo(~0u, (unsigned)z_)); asm volatile("" : "+v"(tid)); asm volatile("" : "+s"(bid), "+s"(G)); KA_OPAQUE(ka)
enum { I_X = 0, I_MEM, I_WIN, I_WPOOL, I_PSCALE, I_WDW, I_BDW, I_CNG, I_CNB, I_WKV, I_WOUT, I_LN1G, I_LN1B, I_WR, I_RB, I_WG, I_WU, I_WD, I_WGS, I_WUS, I_WDS, I_LN2G, I_LN2B, I_MNG, I_MNB };

__device__ __forceinline__ void transpose_item(const float* W, int N, bf16* WT, int ldk, int row_off, LAS float* scr, int k0, int n0, int lane) {
#pragma unroll 8
    for (int i = 0; i < 32; ++i) { const int kk = 2 * i + (lane >> 5); scr[kk * 33 + (lane & 31)] = W[(size_t)(k0 + kk) * N + n0 + (lane & 31)]; }
    LDS_WAIT(); asm volatile("" ::: "memory");
    const int c = lane & 7;
#pragma unroll
    for (int j = 0; j < 4; ++j) { const int n = (lane >> 3) + 8 * j; const LAS float* s = scr + (8 * c) * 33 + n;
        u32x4 o; o.x = cvt_pk_bf16(s[0 * 33], s[1 * 33]); o.y = cvt_pk_bf16(s[2 * 33], s[3 * 33]); o.z = cvt_pk_bf16(s[4 * 33], s[5 * 33]); o.w = cvt_pk_bf16(s[6 * 33], s[7 * 33]);
        *(u32x4*)(WT + (size_t)(row_off + n) * ldk + k0 + 8 * c) = o; }
    LDS_WAIT(); asm volatile("" ::: "memory");
}

__device__ __forceinline__ void phase_convert_layer(KArgP ka, const int wave_s, int l, LAS unsigned char* lds, int bid, int G) {
    PHASE_BEGIN();
    const int lane = tid & 63, wave = __builtin_amdgcn_readfirstlane(tid >> 6);
    LAS float* scr = (LAS float*)(lds + wave * 16384);
    unsigned char* ws = ka->ws;
    constexpr int I_IN = 16 * 40, I_OUT = 16 * 32, I_GU = 64 * 128, I_DN = 64 * 128, I_SH = 128, I_R = 16 * 2, I_P = 4 * 2;
    constexpr int NIT = I_IN + I_OUT + 2 * I_GU + I_DN + 3 * I_SH + I_R + I_P;
    if (bid == 0) { float* dwt = (float*)(ws + W_DWT); const float* wdw = ka->in[I_WDW] + (size_t)l * 31 * CONV_CH; const float* bdw = ka->in[I_BDW] + (size_t)l * CONV_CH;
        for (int i = tid; i < 256 * 32; i += NTHREADS) { const int ch = i >> 5, j = i & 31; dwt[i] = (j < 31) ? wdw[j * CONV_CH + ch] : bdw[ch]; } }
    for (int it = bid * NWAVES + wave; it < NIT; it += G * NWAVES) {
        int r = it;
        if (r < I_IN) { const int kb = r / 40, nb = r % 40; transpose_item(ka->in[I_WIN] + (size_t)l * D * NPROJ, NPROJ, (bf16*)(ws + WS_WIN), D, 32 * nb, scr, 64 * kb, 32 * nb, lane); continue; } r -= I_IN;
        if (r < I_OUT) { const int kb = r / 32, nb = r % 32; transpose_item(ka->in[I_WOUT] + (size_t)l * D * D, D, (bf16*)(ws + WS_WOUT), D, 32 * nb, scr, 64 * kb, 32 * nb, lane); continue; } r -= I_OUT;
        if (r < 2 * I_GU) { const int half = r / I_GU; r %= I_GU; const int e = r / 128, q = r % 128, kb = q / 8, nb = q % 8, n0 = 32 * nb;
            const float* W = ka->in[half ? I_WU : I_WG] + ((size_t)l * NE + e) * D * EH;
            transpose_item(W, EH, (bf16*)(ws + WS_WGU) + (size_t)e * 512 * D, D, (n0 >> 7) * 256 + half * 128 + (n0 & 127), scr, 64 * kb, n0, lane); continue; } r -= 2 * I_GU;
        if (r < I_DN) { const int e = r / 128, q = r % 128, kb = q / 32, nb = q % 32;
            transpose_item(ka->in[I_WD] + ((size_t)l * NE + e) * EH * D, D, (bf16*)(ws + WS_WD) + (size_t)e * D * EH, EH, 32 * nb, scr, 64 * kb, 32 * nb, lane); continue; } r -= I_DN;
        if (r < 2 * I_SH) { const int half = r / I_SH; r %= I_SH; const int kb = r / 8, nb = r % 8, n0 = 32 * nb;
            transpose_item(ka->in[half ? I_WUS : I_WGS] + (size_t)l * D * EH, EH, (bf16*)(ws + WS_WSGU), D, (n0 >> 7) * 256 + half * 128 + (n0 & 127), scr, 64 * kb, n0, lane); continue; } r -= 2 * I_SH;
        if (r < I_SH) { const int kb = r / 32, nb = r % 32; transpose_item(ka->in[I_WDS] + (size_t)l * EH * D, D, (bf16*)(ws + WS_WSD), EH, 32 * nb, scr, 64 * kb, 32 * nb, lane); continue; } r -= I_SH;
        if (r < I_R) { const int kb = r / 2, nb = r % 2; transpose_item(ka->in[I_WR] + (size_t)l * D * NE, NE, (bf16*)(ws + W_RT), D, 32 * nb, scr, 64 * kb, 32 * nb, lane); continue; } r -= I_R;
        { const int g = r / 2, nb = r % 2; transpose_item(ka->in[I_WPOOL] + ((size_t)l * 4 + g) * 64 * 64, 64, (bf16*)(ws + W_PT) + (size_t)g * 64 * 64, 64, 32 * nb, scr, 0, 32 * nb, lane); }
    }
}

__device__ __forceinline__ void phase_prologue(KArgP ka, const int wave_s, LAS unsigned char* lds, int bid, int G) {
    PHASE_BEGIN();
    const int lane = tid & 63, wave = __builtin_amdgcn_readfirstlane(tid >> 6);
    LAS float* scr = (LAS float*)(lds + wave * 16384);
    unsigned char* ws = ka->ws;
    const int gw = bid * NWAVES + wave, NGW = G * NWAVES;
    for (int it = gw; it < DEPTH * 512; it += NGW) { const int l = it / 512, q = it % 512, kb = q / 32, nb = q % 32;
        transpose_item(ka->in[I_WKV] + (size_t)l * D * D, D, (bf16*)(ws + WS_WKV) + (size_t)l * D * D, D, 32 * nb, scr, 64 * kb, 32 * nb, lane); }
    const float* g = ka->in[I_MNG]; const float* b = ka->in[I_MNB];
    for (int m = gw; m < MROWS; m += NGW) {
        const f32x4* xr = (const f32x4*)(ka->in[I_MEM] + (size_t)m * D) + lane;
        f32x4 v[4]; float s = 0.f;
#pragma unroll
        for (int j = 0; j < 4; ++j) { v[j] = xr[64 * j]; s += (v[j][0] + v[j][1]) + (v[j][2] + v[j][3]); }
        const float mean = wave_sum(s, lane) * (1.f / D); float s2 = 0.f;
#pragma unroll
        for (int j = 0; j < 4; ++j) { v[j] = v[j] - mean; s2 += (v[j][0] * v[j][0] + v[j][1] * v[j][1]) + (v[j][2] * v[j][2] + v[j][3] * v[j][3]); }
        const float rstd = 1.f / sqrtf(wave_sum(s2, lane) * (1.f / D) + LN_EPS);
        u32x2* o8 = (u32x2*)((bf16*)(ws + WS_MEMN) + (size_t)m * D) + lane;
#pragma unroll
        for (int j = 0; j < 4; ++j) { const f32x4 gg = ((const f32x4*)g)[lane + 64 * j], bb = ((const f32x4*)b)[lane + 64 * j]; const f32x4 y = v[j] * rstd * gg + bb;
            u32x2 w; w.x = cvt_pk_bf16(y[0], y[1]); w.y = cvt_pk_bf16(y[2], y[3]); o8[64 * j] = w; }
    }
    const size_t n8 = (size_t)T * D / 8;
    for (size_t i = (size_t)bid * NTHREADS + tid; i < n8; i += (size_t)G * NTHREADS) {
        const f32x4 p0 = ((const f32x4*)ka->in[I_X])[2 * i], p1 = ((const f32x4*)ka->in[I_X])[2 * i + 1];
        u32x4 w; w.x = cvt_pk_bf16(p0[0], p0[1]); w.y = cvt_pk_bf16(p0[2], p0[3]); w.z = cvt_pk_bf16(p1[0], p1[1]); w.w = cvt_pk_bf16(p1[2], p1[3]);
        ((u32x4*)(ws + WS_XB))[i] = w;
    }
}

#define OPAQUE_TID() int z2_ = 0; asm volatile("" : "+v"(z2_)); int tid = (wave_s << 6) | (int)__builtin_amdgcn_mbcnt_hi(~0u, __builtin_amdgcn_mbcnt_lo(~0u, (unsigned)z2_)); asm volatile("" : "+v"(tid)); const int lane = tid & 63, wave = __builtin_amdgcn_readfirstlane(tid >> 6); (void)lane; (void)wave
__device__ __forceinline__ void phase_mixers(KArgP ka, const int wave_s, int l, LAS unsigned char* lds, int bid, int G) {
    PHASE_BEGIN();
    unsigned char* ws = ka->ws;
    const bf16* proj = (const bf16*)(ws + U_PROJ); bf16* cat = (bf16*)(ws + U_CAT);
    const bf16* wpt = (const bf16*)(ws + W_PT);
    const bf16* Kb = (const bf16*)(ws + WS_KB) + (size_t)l * MROWS * MEM_CH; const bf16* Vt = (const bf16*)(ws + WS_VT) + (size_t)l * MROWS * MEM_CH;
    const float* pscale = ka->in[I_PSCALE] + (size_t)l * POOL_CH;
    const float* dwt = (const float*)(ws + W_DWT);
    const float* cng = ka->in[I_CNG] + (size_t)l * CONV_CH; const float* cnb = ka->in[I_CNB] + (size_t)l * CONV_CH;
    for (int item = bid; item < T / 64; item += G) {
        const int b = item / (SEQ / 64), s0 = (item % (SEQ / 64)) * 64; const size_t t0 = (size_t)b * SEQ + s0;
        {
            OPAQUE_TID();
            LAS bf16* Ub = (LAS bf16*)lds;
            LAS bf16* Db = (LAS bf16*)(lds + 80 * 528);
#pragma unroll 1
            for (int i = tid; i < 80 * 32; i += NTHREADS) { const int r = i >> 5, c8 = i & 31; const int s = s0 - 8 + r;
                u32x4 v = (u32x4){0u, 0u, 0u, 0u}; if (s >= 0 && s < SEQ) v = *(const u32x4*)(proj + ((size_t)b * SEQ + s) * NPROJ + c8 * 8);
                *(LAS u32x4*)(Ub + r * 264 + c8 * 8) = v; }
            __syncthreads();
            { const int ch = tid & 255, half = tid >> 8, g = ch >> 6; const int w = 2 << g, lo = w >> 1, hi = w - 1 - lo;
#pragma unroll 1
                for (int r = half * 32; r < half * 32 + 32; ++r) { const int s = s0 + r; const int st = max(s - lo, 0), en = min(s + hi + 1, SEQ);
                    float sum = 0.f; for (int q = st; q < en; ++q) sum += bf2f(Ub[(q - s0 + 8) * 264 + ch]);
                    const float d = sum / (float)(en - st) - bf2f(Ub[(r + 8) * 264 + ch]);
                    Db[r * 264 + ch] = (bf16)(cvt_pk_bf16(d, 0.f) & 0xffffu); } }
            __syncthreads();
            { const int g = wave >> 1, rh = wave & 1, fr = lane & 15, fq = lane >> 4;
#pragma unroll
                for (int rt = 0; rt < 2; ++rt) {
                    bf16x8 af[2];
#pragma unroll
                    for (int ks = 0; ks < 2; ++ks) af[ks] = *(const LAS bf16x8*)(Db + (rh * 32 + rt * 16 + fr) * 264 + g * 64 + ks * 32 + 8 * fq);
#pragma unroll
                    for (int ct = 0; ct < 4; ++ct) { f32x4 c = (f32x4){0.f, 0.f, 0.f, 0.f};
#pragma unroll
                        for (int ks = 0; ks < 2; ++ks) { const bf16x8 bfv = *(const bf16x8*)(wpt + (size_t)g * 4096 + (ct * 16 + fr) * 64 + ks * 32 + 8 * fq); c = __builtin_amdgcn_mfma_f32_16x16x32_bf16(af[ks], bfv, c, 0, 0, 0); }
                        const int col = g * 64 + ct * 16 + fr; const float sc = pscale[col];
#pragma unroll
                        for (int j = 0; j < 4; ++j) cat[(t0 + rh * 32 + rt * 16 + fq * 4 + j) * D + col] = (bf16)(cvt_pk_bf16(c[j] * sc, 0.f) & 0xffffu); } } }
            __syncthreads();
        }
        {
            OPAQUE_TID();
            LAS bf16* Gb = (LAS bf16*)lds;
            LAS float* Yc = (LAS float*)(lds + 49152);
#pragma unroll 1
            for (int i = tid; i < 94 * 32; i += NTHREADS) { const int r = i >> 5, c8 = i & 31; const int s = s0 - 15 + r;
                u32x4 o = (u32x4){0u, 0u, 0u, 0u};
                if (s >= 0 && s < SEQ) { const bf16* pr = proj + ((size_t)b * SEQ + s) * NPROJ + 256 + c8 * 8; const u32x4 av = *(const u32x4*)pr, gv = *(const u32x4*)(pr + 256);
                    float y[8];
#pragma unroll
                    for (int j = 0; j < 4; ++j) { const unsigned aw = av[j], gw2 = gv[j];
                        y[2 * j] = bf2f(aw & 0xffffu) * fast_sigmoid(bf2f(gw2 & 0xffffu)); y[2 * j + 1] = bf2f(aw >> 16) * fast_sigmoid(bf2f(gw2 >> 16)); }
                    o.x = cvt_pk_bf16(y[0], y[1]); o.y = cvt_pk_bf16(y[2], y[3]); o.z = cvt_pk_bf16(y[4], y[5]); o.w = cvt_pk_bf16(y[6], y[7]); }
                *(LAS u32x4*)(Gb + r * 256 + c8 * 8) = o; }
            __syncthreads();
            { const int ch = tid & 255, half = tid >> 8; float wv[32];
#pragma unroll
                for (int j = 0; j < 8; ++j) { const f32x4 w4 = ((const f32x4*)(dwt + ch * 32))[j]; wv[4 * j] = w4[0]; wv[4 * j + 1] = w4[1]; wv[4 * j + 2] = w4[2]; wv[4 * j + 3] = w4[3]; }
                const float bias = wv[31];
#pragma unroll 1
                for (int rb = 0; rb < 8; ++rb) { const int r0 = half * 32 + rb * 4; float gv[34];
#pragma unroll
                    for (int j = 0; j < 34; ++j) gv[j] = bf2f(Gb[(r0 + j) * 256 + ch]);
#pragma unroll
                    for (int q = 0; q < 4; ++q) { float y = bias;
#pragma unroll
                        for (int j = 0; j < 31; ++j) y += gv[q + j] * wv[j];
                        Yc[(r0 + q) * 256 + ch] = y; } } }
            __syncthreads();
#pragma unroll 1
            for (int r = wave; r < 64; r += NWAVES) { const f32x4 v = *(const LAS f32x4*)(Yc + r * 256 + lane * 4);
                const float mean = wave_sum((v[0] + v[1]) + (v[2] + v[3]), lane) * (1.f / 256.f); const f32x4 d = v - mean;
                const float rstd = 1.f / sqrtf(wave_sum((d[0] * d[0] + d[1] * d[1]) + (d[2] * d[2] + d[3] * d[3]), lane) * (1.f / 256.f) + LN_EPS);
                const f32x4 gg = ((const f32x4*)cng)[lane], bb = ((const f32x4*)cnb)[lane]; const f32x4 y = d * rstd * gg + bb;
                u32x2 w; w.x = cvt_pk_bf16(fast_silu(y[0]), fast_silu(y[1])); w.y = cvt_pk_bf16(fast_silu(y[2]), fast_silu(y[3]));
                *(u32x2*)(cat + (t0 + r) * D + 256 + lane * 4) = w; }
            __syncthreads();
        }
        {
            OPAQUE_TID();
            const int hh = wave >> 1, rbase = (wave & 1) * 32, fr = lane & 15, fq = lane >> 4;
            LAS bf16* Pw = (LAS bf16*)(lds + wave * 8448);
            constexpr float SC = 0.08838834764831845f * 1.4426950408889634f;
            const __amdgpu_buffer_rsrc_t kR = __builtin_amdgcn_make_buffer_rsrc((void*)(Kb + (size_t)b * MEMT * MEM_CH + hh * HD), (short)0, MEMT * MEM_CH * 2, RSRC_W3);
            const __amdgpu_buffer_rsrc_t vR = __builtin_amdgcn_make_buffer_rsrc((void*)(Vt + (size_t)hh * HD * MROWS + b * MEMT), (short)0, HD * MROWS * 2, RSRC_W3);
            const unsigned klane = (unsigned)(fr * MEM_CH + 8 * fq) * 2u, vlane = (unsigned)(fr * MROWS + 8 * fq) * 2u;
            const unsigned qlane = (unsigned)(fr * NPROJ + 8 * fq) * 2u, olane = (unsigned)(fq * 4 * D + fr) * 2u;
#pragma unroll 1
            for (int rt = 0; rt < 2; ++rt) {
                const size_t trow = t0 + rbase + rt * 16;
                const char* qU = (const char*)(proj + trow * NPROJ + 768 + hh * HD);
                char* oU = (char*)(cat + trow * D + 512 + hh * HD);
                bf16x8 aq[4];
#pragma unroll
                for (int ks = 0; ks < 4; ++ks) aq[ks] = *(const bf16x8*)(qU + ks * 64 + qlane);
                f32x4 s[16];
#pragma unroll
                for (int ct = 0; ct < 16; ++ct) { s[ct] = (f32x4){0.f, 0.f, 0.f, 0.f};
#pragma unroll
                    for (int ks = 0; ks < 4; ++ks) { const bf16x8 kf = bufld8(kR, klane, (unsigned)(ct * 16 * MEM_CH + ks * 32) * 2u);
                        s[ct] = __builtin_amdgcn_mfma_f32_16x16x32_bf16(aq[ks], kf, s[ct], 0, 0, 0); }
                    if ((ct & 3) == 3) asm volatile("" ::: "memory"); }
                float inv[4];
#pragma unroll
                for (int j = 0; j < 4; ++j) { float m = s[0][j];
#pragma unroll
                    for (int ct = 1; ct < 16; ++ct) m = fmaxf(m, s[ct][j]);
                    m = fmaxf(m, swz_xor<1>(m)); m = fmaxf(m, swz_xor<2>(m)); m = fmaxf(m, swz_xor<4>(m)); m = fmaxf(m, swz_xor<8>(m));
                    float sum = 0.f;
#pragma unroll
                    for (int ct = 0; ct < 16; ++ct) { const float p = __builtin_amdgcn_exp2f((s[ct][j] - m) * SC); sum += p; Pw[(fq * 4 + j) * 264 + ct * 16 + fr] = (bf16)(cvt_pk_bf16(p, 0.f) & 0xffffu); }
                    sum += swz_xor<1>(sum); sum += swz_xor<2>(sum); sum += swz_xor<4>(sum); sum += swz_xor<8>(sum);
                    inv[j] = 1.f / sum; }
                LDS_WAIT(); asm volatile("" ::: "memory");
                f32x4 o[8];
#pragma unroll
                for (int dt = 0; dt < 8; ++dt) o[dt] = (f32x4){0.f, 0.f, 0.f, 0.f};
#pragma unroll
                for (int ks = 0; ks < 8; ++ks) { const bf16x8 p0 = *(const LAS bf16x8*)(Pw + fr * 264 + ks * 32 + 8 * fq);
#pragma unroll
                    for (int dt = 0; dt < 8; ++dt) { const bf16x8 vf = bufld8(vR, vlane, (unsigned)(dt * 16 * MROWS + ks * 32) * 2u);
                        o[dt] = __builtin_amdgcn_mfma_f32_16x16x32_bf16(p0, vf, o[dt], 0, 0, 0); }
                    if (ks & 1) asm volatile("" ::: "memory"); }
#pragma unroll
                for (int dt = 0; dt < 8; ++dt)
#pragma unroll
                    for (int j = 0; j < 4; ++j) *(bf16*)(oU + (size_t)(j * D + dt * 16) * 2 + olane) = (bf16)(cvt_pk_bf16(o[dt][j] * inv[j], 0.f) & 0xffffu);
                LDS_WAIT(); asm volatile("" ::: "memory");
            }
            __syncthreads();
        }
    }
}

__device__ __forceinline__ void phase_ln1_router(KArgP ka, const int wave_s, int l, LAS unsigned char* lds, int bid, int G) {
    PHASE_BEGIN();
    const int lane = tid & 63, wave = __builtin_amdgcn_readfirstlane(tid >> 6), fr = lane & 15, fq = lane >> 4;
    unsigned char* ws = ka->ws;
    float* dout = ka->out; bf16* xb = (bf16*)(ws + WS_XB);
    const float* g = ka->in[I_LN1G] + (size_t)l * D; const float* bta = ka->in[I_LN1B] + (size_t)l * D;
    const float* rbias = ka->in[I_RB] + (size_t)l * NE;
    const bf16* wrt = (const bf16*)(ws + W_RT);
    int* tok_e = (int*)(ws + TOK_E); float* tok_g = (float*)(ws + TOK_G); int* tok_r = (int*)(ws + TOK_R); int* hist = (int*)(ws + TAB_HIST);
    int* row_tok = (int*)(ws + ROW_TOK);
    for (int i = bid * NTHREADS + tid; i < NCH * CH_SLOTS; i += G * NTHREADS) row_tok[i] = 0;
    LAS bf16* Xh = (LAS bf16*)lds;
    LAS float* Lg = (LAS float*)(lds + 32 * 2064);
    LAS int* hl = (LAS int*)(lds + 32 * 2064 + 8192);
    for (int tb = bid; tb < NTB; tb += G) {
        if (tid < 64) hl[tid] = 0;
        __syncthreads();
        for (int st = 0; st < 8; ++st) {
            for (int rr = 0; rr < 4; ++rr) { const int lr = wave * 4 + rr; const size_t t = (size_t)tb * TBLK + st * 32 + lr;
                f32x4* xr = (f32x4*)(dout + t * D) + lane; f32x4 v[4]; float s = 0.f;
#pragma unroll
                for (int j = 0; j < 4; ++j) { v[j] = xr[64 * j]; s += (v[j][0] + v[j][1]) + (v[j][2] + v[j][3]); }
                const float mean = wave_sum(s, lane) * (1.f / D); float s2 = 0.f;
#pragma unroll
                for (int j = 0; j < 4; ++j) { v[j] = v[j] - mean; s2 += (v[j][0] * v[j][0] + v[j][1] * v[j][1]) + (v[j][2] * v[j][2] + v[j][3] * v[j][3]); }
                const float rstd = 1.f / sqrtf(wave_sum(s2, lane) * (1.f / D) + LN_EPS);
                u32x2* o8 = (u32x2*)(xb + t * D) + lane;
#pragma unroll
                for (int j = 0; j < 4; ++j) { const f32x4 gg = ((const f32x4*)g)[lane + 64 * j], bb = ((const f32x4*)bta)[lane + 64 * j]; const f32x4 y = v[j] * rstd * gg + bb;
                    xr[64 * j] = y; u32x2 w; w.x = cvt_pk_bf16(y[0], y[1]); w.y = cvt_pk_bf16(y[2], y[3]); o8[64 * j] = w;
                    *(LAS u32x2*)(Xh + lr * 1032 + 4 * lane + 256 * j) = w; }
            }
            __syncthreads();
            { const int rt = wave >> 2, ct = wave & 3; f32x4 c = (f32x4){0.f, 0.f, 0.f, 0.f};
#pragma unroll 8
                for (int ks = 0; ks < 32; ++ks) { const bf16x8 af = *(const LAS bf16x8*)(Xh + (rt * 16 + fr) * 1032 + ks * 32 + 8 * fq); const bf16x8 bfv = *(const bf16x8*)(wrt + (size_t)(ct * 16 + fr) * D + ks * 32 + 8 * fq);
                    c = __builtin_amdgcn_mfma_f32_16x16x32_bf16(af, bfv, c, 0, 0, 0); }
#pragma unroll
                for (int j = 0; j < 4; ++j) Lg[(rt * 16 + fq * 4 + j) * 64 + ct * 16 + fr] = c[j]; }
            __syncthreads();
            for (int rr = 0; rr < 4; ++rr) { const int lr = wave * 4 + rr; const size_t t = (size_t)tb * TBLK + st * 32 + lr;
                const float sc = fast_sigmoid(Lg[lr * 64 + lane]); float sel = sc + rbias[lane];
                int my_e = 0; float my_s = 0.f, ssum = 0.f;
#pragma unroll
                for (int k = 0; k < TOPK; ++k) { const float m = wave_max(sel, lane); const unsigned long long mask = __ballot(sel == m); const int idx = __ffsll((long long)mask) - 1;
                    const float sk = __int_as_float(__builtin_amdgcn_readlane(__float_as_int(sc), idx)); ssum += sk; if (lane == idx) sel = -3.0e38f; if (lane == k) { my_e = idx; my_s = sk; } }
                if (lane < TOPK) { const int rank = __hip_atomic_fetch_add(&hl[my_e], 1, __ATOMIC_RELAXED, __HIP_MEMORY_SCOPE_WORKGROUP);
                    tok_e[t * TOPK + lane] = my_e; tok_g[t * TOPK + lane] = my_s / ssum * ROUTED_SCALE; tok_r[t * TOPK + lane] = rank; }
            }
            __syncthreads();
        }
        if (tid < 64) hist[tb * 64 + tid] = hl[tid];
        __syncthreads();
    }
}

__device__ __forceinline__ void phase_scatter(KArgP ka, const int wave_s, LAS unsigned char* lds, int bid, int G) {
    PHASE_BEGIN();
    const int lane = tid & 63;
    unsigned char* ws = ka->ws;
    const int* tok_e = (const int*)(ws + TOK_E); const float* tok_g = (const float*)(ws + TOK_G); const int* tok_r = (const int*)(ws + TOK_R); int* slot_of = (int*)(ws + TOK_SLOT);
    const int* hist = (const int*)(ws + TAB_HIST); int* ntiles = (int*)(ws + TAB_NT); int* tile_e = (int*)(ws + TAB_TE);
    int* row_tok = (int*)(ws + ROW_TOK); float* row_gate = (float*)(ws + ROW_GATE);
    LAS int* ptot = (LAS int*)lds; LAS int* pbef = ptot + 512; LAS int* base = pbef + 512;
    for (int tb = bid; tb < NTB; tb += G) {
        const int ch = tb / TB_PER_CH;
        { const int e = tid & 63, part = tid >> 6; int tot = 0, bef = 0;
            for (int j = 0; j < 8; ++j) { const int blk = ch * TB_PER_CH + part * 8 + j; const int v = hist[blk * 64 + e]; tot += v; if (blk < tb) bef += v; }
            ptot[part * 64 + e] = tot; pbef[part * 64 + e] = bef; }
        __syncthreads();
        if (tid < 64) { int tot = 0, bef = 0;
#pragma unroll
            for (int p = 0; p < 8; ++p) { tot += ptot[p * 64 + tid]; bef += pbef[p * 64 + tid]; }
            const int padded = (tot + 255) & ~255; int inc = padded;
#pragma unroll
            for (int o = 1; o < 64; o <<= 1) { const int v = bperm_i((lane - o) & 63, inc); if (lane >= o) inc += v; }
            const int ebase = inc - padded;
            base[tid] = ebase + bef;
            if (tb % TB_PER_CH == 0) { if (tid == 63) ntiles[ch] = inc >> 8; for (int j = 0; j < (padded >> 8); ++j) tile_e[ch * CH_TILES_MAX + (ebase >> 8) + j] = tid; }
        }
        __syncthreads();
        for (int q = tid; q < TBLK * TOPK; q += NTHREADS) { const size_t i = (size_t)tb * TBLK * TOPK + q; const int e = tok_e[i]; const int slot = ch * CH_SLOTS + base[e] + tok_r[i];
            row_tok[slot] = (int)(i >> 3); row_gate[slot] = tok_g[i]; slot_of[i] = slot; }
        __syncthreads();
    }
}

__device__ __forceinline__ void phase_combine_ln2(KArgP ka, const int wave_s, int l, int ch, int bid, int G) {
    PHASE_BEGIN();
    const int lane = tid & 63, wave = __builtin_amdgcn_readfirstlane(tid >> 6);
    unsigned char* ws = ka->ws;
    float* dout = ka->out; bf16* xb = (bf16*)(ws + WS_XB); const bf16* Y = (const bf16*)(ws + WS_Y); const int* slot_of = (const int*)(ws + TOK_SLOT);
    const float* g = ka->in[I_LN2G] + (size_t)l * D; const float* bta = ka->in[I_LN2B] + (size_t)l * D;
    for (int q = bid * NWAVES + wave; q < CH_TOK; q += G * NWAVES) { const size_t t = (size_t)ch * CH_TOK + q;
        f32x4* xr = (f32x4*)(dout + t * D) + lane; f32x4 v[4];
#pragma unroll
        for (int j = 0; j < 4; ++j) v[j] = xr[64 * j];
#pragma unroll
        for (int k = 0; k < TOPK; ++k) { const int slot = __builtin_amdgcn_readfirstlane(slot_of[t * TOPK + k]) - ch * CH_SLOTS; const u32x2* yr = (const u32x2*)(Y + (size_t)slot * D) + lane;
#pragma unroll
            for (int j = 0; j < 4; ++j) { const u32x2 w = yr[64 * j]; v[j][0] += bf2f(w.x & 0xffffu); v[j][1] += bf2f(w.x >> 16); v[j][2] += bf2f(w.y & 0xffffu); v[j][3] += bf2f(w.y >> 16); } }
        float s = 0.f;
#pragma unroll
        for (int j = 0; j < 4; ++j) s += (v[j][0] + v[j][1]) + (v[j][2] + v[j][3]);
        const float mean = wave_sum(s, lane) * (1.f / D); float s2 = 0.f;
#pragma unroll
        for (int j = 0; j < 4; ++j) { v[j] = v[j] - mean; s2 += (v[j][0] * v[j][0] + v[j][1] * v[j][1]) + (v[j][2] * v[j][2] + v[j][3] * v[j][3]); }
        const float rstd = 1.f / sqrtf(wave_sum(s2, lane) * (1.f / D) + LN_EPS);
        u32x2* o8 = (u32x2*)(xb + t * D) + lane;
#pragma unroll
        for (int j = 0; j < 4; ++j) { const f32x4 gg = ((const f32x4*)g)[lane + 64 * j], bb = ((const f32x4*)bta)[lane + 64 * j]; const f32x4 y = v[j] * rstd * gg + bb;
            xr[64 * j] = y; u32x2 w; w.x = cvt_pk_bf16(y[0], y[1]); w.y = cvt_pk_bf16(y[2], y[3]); o8[64 * j] = w; }
    }
}

__device__ __forceinline__ void phase_gemm_kv(KArgP ka, const int wave_s, LAS unsigned char* lds, int bid, int G) {
    PHASE_BEGIN();
    unsigned char* ws = ka->ws;
    ge::SchedKV S{(const char*)(ws + WS_MEMN), (const char*)(ws + WS_WKV), (char*)(ws + WS_KB), (char*)(ws + WS_VT), G, bid};
    ge::EpiBf16 E;
    ge::gemm_phase<D, false, ge::EpiBf16, ge::SchedKV>(tid, lds, (const LAS int*)(lds + LDS_TBL), S, E);
}
__device__ __forceinline__ void phase_gemm_in(KArgP ka, const int wave_s, LAS unsigned char* lds, int bid, int G) {
    PHASE_BEGIN();
    unsigned char* ws = ka->ws;
    ge::SchedDense<D> S{(const char*)(ws + WS_XB), (const char*)(ws + WS_WIN), (char*)(ws + U_PROJ), NPROJ, T / 256, NPROJ / 256, G, bid};
    ge::EpiBf16 E;
    ge::gemm_phase<D, false, ge::EpiBf16, ge::SchedDense<D>>(tid, lds, (const LAS int*)(lds + LDS_TBL), S, E);
}
__device__ __forceinline__ void phase_gemm_out(KArgP ka, const int wave_s, int l, LAS unsigned char* lds, int bid, int G) {
    PHASE_BEGIN();
    unsigned char* ws = ka->ws;
    ge::SchedDense<D> S{(const char*)(ws + U_CAT), (const char*)(ws + WS_WOUT), (char*)ka->out, D, T / 256, D / 256, G, bid};
    ge::EpiResF32 E{l == 0 ? ka->in[I_X] : ka->out, ka->out};
    ge::gemm_phase<D, false, ge::EpiResF32, ge::SchedDense<D>>(tid, lds, (const LAS int*)(lds + LDS_TBL), S, E);
}
__device__ __forceinline__ void phase_gemm_gu(KArgP ka, const int wave_s, LAS unsigned char* lds, int bid, int G) {
    PHASE_BEGIN();
    unsigned char* ws = ka->ws;
    ge::SchedGU S{(const char*)(ws + WS_XB), (const char*)(ws + WS_WGU), (const char*)(ws + WS_WSGU), (char*)(ws + U_H), (const int*)(ws + TAB_NT), (const int*)(ws + TAB_TE), G, bid, 0, 0, 0, 0};
    S.init();
    LAS int* tbl = (LAS int*)(lds + LDS_TBL);
    const int* row_tok = (const int*)(ws + ROW_TOK);
    { ge::Unit u; for (int i = 0; i < MAXU && S.next(i, u); ++i) { const int r = tid; if (r < 256) tbl[i * 256 + r] = (u.aux >= 0) ? (u.aux + r) : row_tok[u.row0 + r]; } }
    __syncthreads();
    ge::EpiSwiGLU E;
    ge::gemm_phase<D, true, ge::EpiSwiGLU, ge::SchedGU>(tid, lds, tbl, S, E);
}
__device__ __forceinline__ void phase_gemm_dn(KArgP ka, const int wave_s, int ch, LAS unsigned char* lds, int bid, int G) {
    PHASE_BEGIN();
    unsigned char* ws = ka->ws;
    ge::SchedDN S{(const char*)(ws + U_H), (const char*)(ws + WS_WD), (const char*)(ws + WS_WSD), (char*)(ws + WS_Y), (char*)ka->out, (const int*)(ws + TAB_TE), ch, ((const int*)(ws + TAB_NT))[ch], G, bid};
    ge::EpiDown E{(const float*)(ws + ROW_GATE)};
    ge::gemm_phase<EH, false, ge::EpiDown, ge::SchedDN>(tid, lds, (const LAS int*)(lds + LDS_TBL), S, E);
}

#define KERNEL_HEAD extern __shared__ __attribute__((aligned(16))) unsigned char lds_raw[]; LAS unsigned char* lds = (LAS unsigned char*)lds_raw; const int bid = blockIdx.x, G = gridDim.x; KArgP ka = (KArgP)__builtin_amdgcn_kernarg_segment_ptr(); (void)a; const int wave_s = __builtin_amdgcn_readfirstlane((int)(threadIdx.x >> 6));
#if MK_ONE_LAUNCH
__global__ void __launch_bounds__(NTHREADS, 2) k_mega(KArgs a) {
    KERNEL_HEAD
    volatile LAS unsigned* misc = (volatile LAS unsigned*)(lds + LDS_CTLW);
    if (threadIdx.x < 64) misc[threadIdx.x] = 0u;
    __syncthreads();
    const XcdBarrier bar = xcd_barrier_post((unsigned*)(ka->ws + WS_CTL), misc + 8, (int)threadIdx.x);
    KA_OPAQUE(ka); phase_prologue(ka, wave_s, lds, bid, G);
    KA_OPAQUE(ka); phase_convert_layer(ka, wave_s, 0, lds, bid, G);
    grid_bar(bar, wave_s);
    KA_OPAQUE(ka); phase_gemm_kv(ka, wave_s, lds, bid, G);
#pragma unroll 1
    for (int l = 0; l < DEPTH; ++l) {
        KA_OPAQUE(ka); phase_gemm_in(ka, wave_s, lds, bid, G);
        grid_bar(bar, wave_s);
        KA_OPAQUE(ka); phase_mixers(ka, wave_s, l, lds, bid, G);
        grid_bar(bar, wave_s);
        KA_OPAQUE(ka); phase_gemm_out(ka, wave_s, l, lds, bid, G);
        grid_bar(bar, wave_s);
        KA_OPAQUE(ka); phase_ln1_router(ka, wave_s, l, lds, bid, G);
        grid_bar(bar, wave_s);
        KA_OPAQUE(ka); phase_scatter(ka, wave_s, lds, bid, G);
        grid_bar(bar, wave_s);
        KA_OPAQUE(ka); phase_gemm_gu(ka, wave_s, lds, bid, G);
        grid_bar(bar, wave_s);
#pragma unroll 1
        for (int c = 0; c < NCH; ++c) {
            KA_OPAQUE(ka); phase_gemm_dn(ka, wave_s, c, lds, bid, G);
            grid_bar(bar, wave_s);
            KA_OPAQUE(ka); phase_combine_ln2(ka, wave_s, l, c, bid, G);
            if (c == NCH - 1) { if (l == DEPTH - 1) break; KA_OPAQUE(ka); phase_convert_layer(ka, wave_s, l + 1, lds, bid, G); }
            grid_bar(bar, wave_s);
        }
    }
}
#else
__global__ void __launch_bounds__(NTHREADS, 2) k_prologue(KArgs a) { KERNEL_HEAD phase_prologue(ka, wave_s, lds, bid, G); }
__global__ void __launch_bounds__(NTHREADS, 2) k_convert(KArgs a) { KERNEL_HEAD phase_convert_layer(ka, wave_s, ka->layer, lds, bid, G); }
__global__ void __launch_bounds__(NTHREADS, 2) k_gemm_kv(KArgs a) { KERNEL_HEAD phase_gemm_kv(ka, wave_s, lds, bid, G); }
__global__ void __launch_bounds__(NTHREADS, 2) k_gemm_in(KArgs a) { KERNEL_HEAD phase_gemm_in(ka, wave_s, lds, bid, G); }
__global__ void __launch_bounds__(NTHREADS, 2) k_mixers(KArgs a) { KERNEL_HEAD phase_mixers(ka, wave_s, ka->layer, lds, bid, G); }
__global__ void __launch_bounds__(NTHREADS, 2) k_gemm_out(KArgs a) { KERNEL_HEAD phase_gemm_out(ka, wave_s, ka->layer, lds, bid, G); }
__global__ void __launch_bounds__(NTHREADS, 2) k_ln1_router(KArgs a) { KERNEL_HEAD phase_ln1_router(ka, wave_s, ka->layer, lds, bid, G); }
__global__ void __launch_bounds__(NTHREADS, 2) k_scatter(KArgs a) { KERNEL_HEAD phase_scatter(ka, wave_s, lds, bid, G); }
__global__ void __launch_bounds__(NTHREADS, 2) k_gemm_gu(KArgs a) { KERNEL_HEAD phase_gemm_gu(ka, wave_s, lds, bid, G); }
__global__ void __launch_bounds__(NTHREADS, 2) k_gemm_dn(KArgs a) { KERNEL_HEAD phase_gemm_dn(ka, wave_s, ka->chunk, lds, bid, G); }
__global__ void __launch_bounds__(NTHREADS, 2) k_combine(KArgs a) { KERNEL_HEAD (void)lds; phase_combine_ln2(ka, wave_s, ka->layer, ka->chunk, bid, G); }
#endif

extern "C" void kernel_launch(void* const* d_in, const int* in_sizes, int n_in, void* d_out, int out_size, void* d_ws, size_t ws_size, hipStream_t stream) {
    static int grid = 0;
    if (!grid) {
        if (n_in != 25 || out_size != T * D || ws_size < WS_END) { fprintf(stderr, "kernel_launch: unexpected shapes (n_in %d out %d ws %zu need %zu)\n", n_in, out_size, ws_size, (size_t)WS_END); grid = -1; return; }
        int dev = 0, cus = 0; (void)hipGetDevice(&dev); (void)hipDeviceGetAttribute(&cus, hipDeviceAttributeMultiprocessorCount, dev);
#if MK_ONE_LAUNCH
        const void* ks[] = {(const void*)k_mega};
#else
        const void* ks[] = {(const void*)k_prologue, (const void*)k_convert, (const void*)k_gemm_kv, (const void*)k_gemm_in, (const void*)k_mixers, (const void*)k_gemm_out, (const void*)k_ln1_router,
                            (const void*)k_scatter, (const void*)k_gemm_gu, (const void*)k_gemm_dn, (const void*)k_combine};
#endif
        for (const void* k : ks) if (hipFuncSetAttribute(k, hipFuncAttributeMaxDynamicSharedMemorySize, LDS_BYTES) != hipSuccess) { fprintf(stderr, "kernel_launch: hipFuncSetAttribute failed\n"); grid = -1; return; }
        grid = cus > 0 ? cus : 256; if (grid > 256) grid = 256;
#if MK_ONE_LAUNCH
        int per_cu = 0;
        if (hipOccupancyMaxActiveBlocksPerMultiprocessor(&per_cu, (const void*)k_mega, NTHREADS, LDS_BYTES) != hipSuccess || per_cu < 1) { fprintf(stderr, "kernel_launch: occupancy query says %d blocks per CU\n", per_cu); grid = -1; return; }
#endif
    }
    if (grid < 0) return;
    KArgs a{};
    for (int i = 0; i < 25; ++i) a.in[i] = (const float*)d_in[i];
    a.out = (float*)d_out; a.ws = (unsigned char*)d_ws; a.layer = 0; a.chunk = 0;
    const dim3 g(grid), b(NTHREADS);
#if MK_ONE_LAUNCH
    (void)hipMemsetAsync((char*)d_ws + WS_CTL, 0, 65536, stream);
    hipLaunchKernelGGL(k_mega, g, b, LDS_BYTES, stream, a);
#else
    hipLaunchKernelGGL(k_prologue, g, b, LDS_BYTES, stream, a);
    hipLaunchKernelGGL(k_gemm_kv, g, b, LDS_BYTES, stream, a);
    for (int l = 0; l < DEPTH; ++l) {
        a.layer = l; a.chunk = 0;
        hipLaunchKernelGGL(k_convert, g, b, LDS_BYTES, stream, a);
        hipLaunchKernelGGL(k_gemm_in, g, b, LDS_BYTES, stream, a);
        hipLaunchKernelGGL(k_mixers, g, b, LDS_BYTES, stream, a);
        hipLaunchKernelGGL(k_gemm_out, g, b, LDS_BYTES, stream, a);
        hipLaunchKernelGGL(k_ln1_router, g, b, LDS_BYTES, stream, a);
        hipLaunchKernelGGL(k_scatter, g, b, LDS_BYTES, stream, a);
        hipLaunchKernelGGL(k_gemm_gu, g, b, LDS_BYTES, stream, a);
        for (int c = 0; c < NCH; ++c) { a.chunk = c;
            hipLaunchKernelGGL(k_gemm_dn, g, b, LDS_BYTES, stream, a);
            hipLaunchKernelGGL(k_combine, g, b, LDS_BYTES, stream, a); }
    }
#endif
}
```

```cpp
#include <hip/hip_runtime.h>
#include <cstdio>
#include <cstdint>

#ifndef MK_ONE_LAUNCH
#define MK_ONE_LAUNCH 1
#endif
#ifndef PROBE_SUB
#define PROBE_SUB 0
#endif
#ifndef PROBE_DUP
#define PROBE_DUP 0
#endif

#define LAS __attribute__((address_space(3)))
typedef unsigned short bf16;
typedef short bf16x8 __attribute__((ext_vector_type(8)));
typedef float f32x4 __attribute__((ext_vector_type(4)));
typedef float f32x2 __attribute__((ext_vector_type(2)));
typedef unsigned u32x4 __attribute__((ext_vector_type(4)));
typedef unsigned u32x2 __attribute__((ext_vector_type(2)));

constexpr int D = 1024, NBATCH = 16, SEQ = 4096, T = NBATCH * SEQ, DEPTH = 4;
constexpr int MEMT = 256, MROWS = NBATCH * MEMT;
constexpr int NPROJ = 1280, POOL_CH = 256, CONV_CH = 256, MEM_CH = 512, HEADS = 4, HD = 128;
constexpr int NE = 64, TOPK = 8, EH = 256;
constexpr int NCH = 4, CH_TOK = T / NCH, CH_SLOTS = CH_TOK * TOPK + NE * 256, CH_TILES_MAX = CH_SLOTS / 256;
constexpr int TBLK = 256, NTB = T / TBLK, TB_PER_CH = NTB / NCH;
constexpr int SH_ROW0 = NCH * CH_SLOTS;
constexpr float LN_EPS = 1e-5f;
constexpr float ALPHA = 1.6817928305074290f;
constexpr float ROUTED_SCALE = 2.5f;

constexpr size_t MiB = 1u << 20;
constexpr size_t WS_CTL = 0;
constexpr size_t CTL_BYTES = 1 * MiB;
constexpr size_t WS_TAB = WS_CTL + CTL_BYTES;
constexpr size_t TAB_HIST = WS_TAB, TAB_NT = WS_TAB + 65536, TAB_TE = WS_TAB + 65536 + 256;
constexpr size_t WS_TOK = WS_TAB + 1 * MiB;
constexpr size_t TOK_E = WS_TOK, TOK_G = WS_TOK + 2 * MiB, TOK_R = WS_TOK + 4 * MiB, TOK_SLOT = WS_TOK + 6 * MiB;
constexpr size_t WS_ROW = WS_TOK + 8 * MiB;
constexpr size_t ROW_TOK = WS_ROW, ROW_GATE = WS_ROW + 2560 * 1024;
constexpr size_t WS_SMALLW = WS_ROW + 5 * MiB;
constexpr size_t W_RT = WS_SMALLW, W_PT = WS_SMALLW + 131072, W_DWT = WS_SMALLW + 196608, W_RTL = WS_SMALLW + 262144;
constexpr size_t WS_WIN = WS_SMALLW + 1 * MiB;
constexpr size_t WS_WOUT = WS_WIN + (size_t)NPROJ * D * 2;
constexpr size_t WS_WGU = WS_WOUT + (size_t)D * D * 2;
constexpr size_t WS_WD = WS_WGU + (size_t)NE * 512 * D * 2;
constexpr size_t WS_WSGU = WS_WD + (size_t)NE * D * EH * 2;
constexpr size_t WS_WSD = WS_WSGU + (size_t)512 * D * 2;
constexpr size_t WS_WKV = WS_WSD + (size_t)D * EH * 2;
constexpr size_t WS_MEMN = WS_WKV + (size_t)DEPTH * D * D * 2;
constexpr size_t WS_MEMP = WS_MEMN + (size_t)MROWS * D * 2;
constexpr size_t WS_KB = WS_MEMP + (size_t)MROWS * D * 2;
constexpr size_t WS_VT = WS_KB + (size_t)DEPTH * MROWS * MEM_CH * 2;
constexpr size_t WS_XB = WS_VT + (size_t)DEPTH * MROWS * MEM_CH * 2;
constexpr size_t WS_ZB = WS_XB + (size_t)T * D * 2;
constexpr size_t WS_U = WS_ZB + (size_t)T * D * 2;
constexpr size_t U_PROJ = WS_U, U_CAT = WS_U + (size_t)T * NPROJ * 2, U_H = WS_U;
constexpr size_t U_BYTES = (size_t)(NCH * CH_SLOTS + T) * EH * 2;
static_assert(U_BYTES >= (size_t)T * NPROJ * 2 + (size_t)T * D * 2, "union region");
constexpr size_t WS_Y = WS_U + U_BYTES;
constexpr size_t WS_END = WS_Y + (size_t)CH_SLOTS * D * 2;

constexpr int LDS_STAGE = 0, STAGE_BYTES = 131072;
constexpr int MAXU = 24;
constexpr int LDS_TBL = STAGE_BYTES, LDS_CTLW = LDS_TBL + MAXU * 1024, LDS_BYTES = LDS_CTLW + 1024;
constexpr int NTHREADS = 512, NWAVES = 8;

__device__ __forceinline__ unsigned cvt_pk_bf16(float lo, float hi) { unsigned r; asm volatile("v_cvt_pk_bf16_f32 %0, %1, %2" : "=v"(r) : "v"(lo), "v"(hi)); return r; }
__device__ __forceinline__ float bf2f(unsigned h) { return __uint_as_float(h << 16); }
template <int M> __device__ __forceinline__ float swz_xor(float v) { return __int_as_float(__builtin_amdgcn_ds_swizzle(__float_as_int(v), (M << 10) | 0x1f)); }
__device__ __forceinline__ float bperm_f(int srclane, float v) { return __int_as_float(__builtin_amdgcn_ds_bpermute(srclane << 2, __float_as_int(v))); }
__device__ __forceinline__ int bperm_i(int srclane, int v) { return __builtin_amdgcn_ds_bpermute(srclane << 2, v); }
__device__ __forceinline__ float dpp_f(float v, const int ctrl_sel) {
    const int x = __float_as_int(v);
    int r;
    if (ctrl_sel == 0) r = __builtin_amdgcn_update_dpp(x, x, 0xB1, 0xf, 0xf, false);
    else if (ctrl_sel == 1) r = __builtin_amdgcn_update_dpp(x, x, 0x4E, 0xf, 0xf, false);
    else if (ctrl_sel == 2) r = __builtin_amdgcn_update_dpp(x, x, 0x141, 0xf, 0xf, false);
    else r = __builtin_amdgcn_update_dpp(x, x, 0x140, 0xf, 0xf, false);
    return __int_as_float(r);
}
__device__ __forceinline__ float rl_f(float v, int l) { return __int_as_float(__builtin_amdgcn_readlane(__float_as_int(v), l)); }
__device__ __forceinline__ float wave_sum(float v, int lane) {
    (void)lane;
    v += dpp_f(v, 0); v += dpp_f(v, 1); v += dpp_f(v, 2); v += dpp_f(v, 3);
    return (rl_f(v, 0) + rl_f(v, 16)) + (rl_f(v, 32) + rl_f(v, 48));
}
__device__ __forceinline__ float wave_max(float v, int lane) {
    (void)lane;
    v = fmaxf(v, dpp_f(v, 0)); v = fmaxf(v, dpp_f(v, 1)); v = fmaxf(v, dpp_f(v, 2)); v = fmaxf(v, dpp_f(v, 3));
    return fmaxf(fmaxf(rl_f(v, 0), rl_f(v, 16)), fmaxf(rl_f(v, 32), rl_f(v, 48)));
}
__device__ __forceinline__ float fast_sigmoid(float x) { return __builtin_amdgcn_rcpf(1.0f + __builtin_amdgcn_exp2f(-1.4426950408889634f * x)); }
__device__ __forceinline__ float fast_silu(float x) { return x * fast_sigmoid(x); }
#define LDS_WAIT() asm volatile("s_waitcnt lgkmcnt(0)" ::: "memory")
__device__ __forceinline__ void unpack8(const u32x4 w, float* f) { f[0] = bf2f(w.x & 0xffffu); f[1] = bf2f(w.x >> 16); f[2] = bf2f(w.y & 0xffffu); f[3] = bf2f(w.y >> 16); f[4] = bf2f(w.z & 0xffffu); f[5] = bf2f(w.z >> 16); f[6] = bf2f(w.w & 0xffffu); f[7] = bf2f(w.w >> 16); }
__device__ __forceinline__ void addpack8(const u32x4 w, float* f) { f[0] += bf2f(w.x & 0xffffu); f[1] += bf2f(w.x >> 16); f[2] += bf2f(w.y & 0xffffu); f[3] += bf2f(w.y >> 16); f[4] += bf2f(w.z & 0xffffu); f[5] += bf2f(w.z >> 16); f[6] += bf2f(w.w & 0xffffu); f[7] += bf2f(w.w >> 16); }
__device__ __forceinline__ u32x4 pack8(const float* f) { u32x4 w; w.x = cvt_pk_bf16(f[0], f[1]); w.y = cvt_pk_bf16(f[2], f[3]); w.z = cvt_pk_bf16(f[4], f[5]); w.w = cvt_pk_bf16(f[6], f[7]); return w; }
__device__ __forceinline__ void ln_row16(float* v, const float* g, const float* b, int lane) {
    float s = 0.f;
#pragma unroll
    for (int i = 0; i < 16; ++i) s += v[i];
    const float mean = wave_sum(s, lane) * (1.f / D); float s2 = 0.f;
#pragma unroll
    for (int i = 0; i < 16; ++i) { v[i] -= mean; s2 += v[i] * v[i]; }
    const float rstd = 1.f / sqrtf(wave_sum(s2, lane) * (1.f / D) + LN_EPS);
#pragma unroll
    for (int j = 0; j < 2; ++j) { const f32x4 g0 = *(const f32x4*)(g + 8 * lane + 512 * j), g1 = *(const f32x4*)(g + 8 * lane + 512 * j + 4), b0 = *(const f32x4*)(b + 8 * lane + 512 * j), b1 = *(const f32x4*)(b + 8 * lane + 512 * j + 4);
#pragma unroll
        for (int i = 0; i < 4; ++i) { v[8 * j + i] = v[8 * j + i] * rstd * g0[i] + b0[i]; v[8 * j + 4 + i] = v[8 * j + 4 + i] * rstd * g1[i] + b1[i]; } }
}
#define RSRC_W3 0x00020000
__device__ __forceinline__ bf16x8 bufld8(__amdgpu_buffer_rsrc_t rs, unsigned voff, unsigned soff) { const u32x4 v = __builtin_amdgcn_raw_buffer_load_b128(rs, (int)voff, (int)soff, 0); return __builtin_bit_cast(bf16x8, v); }

#define XB_TMO      128
#define XB_XCNT(j)  (256  + 64 * (j))
#define XB_XSUB(j)  (1280 + 64 * (j))
#define XB_XGEN(j)  (2304 + 64 * (j))
#define XB_TOP      3328
#define XB_TOPGEN   3392
#define XCD_BAR_WORDS 3456
#define XB_SPIN_CAP (1u << 18)
__device__ __forceinline__ unsigned xb_ld(unsigned* p)              { return __hip_atomic_load(p, __ATOMIC_RELAXED, __HIP_MEMORY_SCOPE_AGENT); }
__device__ __forceinline__ unsigned xb_add(unsigned* p, unsigned v) { return __hip_atomic_fetch_add(p, v, __ATOMIC_RELAXED, __HIP_MEMORY_SCOPE_AGENT); }
__device__ __forceinline__ unsigned xb_xcc_id() { return (unsigned)__builtin_amdgcn_s_getreg((3 << 11) | 20) & 0xFu; }
#define XB_SPIN(cond, bar) do { unsigned _sp = 0; while (cond) { __builtin_amdgcn_s_sleep(1); \
    if ((++_sp & 255u) == 0u) { if (xb_ld(&(bar)[XB_TMO])) break; if (_sp > XB_SPIN_CAP) { atomicAdd(&(bar)[XB_TMO], 1u); break; } } } } while (0)
struct XcdBarrier { unsigned* bar; unsigned x; volatile LAS unsigned* st; };
__device__ __forceinline__ XcdBarrier xcd_barrier_post(unsigned* bar, volatile LAS unsigned* st, int tid) {
    XcdBarrier b; b.bar = bar; b.x = xb_xcc_id(); b.st = st;
    if (tid == 0) (void)xb_add(&bar[XB_XCNT(b.x)], 1u);
    return b;
}
__device__ __forceinline__ void xcd_barrier_complete(unsigned* bar, unsigned x, unsigned& nloc, unsigned& nx) {
    const unsigned G = gridDim.x * gridDim.y * gridDim.z;
    unsigned sum, cnt, mine, sp = 0u;
    for (;;) {
        sum = 0u; cnt = 0u; mine = 0u;
#pragma unroll
        for (unsigned j = 0; j < 16; ++j) { const unsigned c = xb_ld(&bar[XB_XCNT(j)]); sum += c; cnt += (c > 0u) ? 1u : 0u; mine = (j == x) ? c : mine; }
        if (sum == G) break;
        __builtin_amdgcn_s_sleep(1);
        if ((++sp & 255u) == 0u) { if (xb_ld(&bar[XB_TMO])) break; if (sp > XB_SPIN_CAP) { atomicAdd(&bar[XB_TMO], 1u); break; } }
    }
    nloc = mine > 0u ? mine : 1u; nx = cnt > 0u ? cnt : 1u;
}
__device__ __forceinline__ void xcd_barrier(const XcdBarrier& b, int tid) {
    asm volatile("s_waitcnt vmcnt(0)" ::: "memory");
    __syncthreads();
    if (tid == 0) {
        unsigned* bar = b.bar;
        __builtin_amdgcn_s_waitcnt(0);
        unsigned nloc = b.st[0], nx = b.st[1];
        if (nloc == 0u) { xcd_barrier_complete(bar, b.x, nloc, nx); b.st[0] = nloc; b.st[1] = nx; }
        const unsigned old = xb_add(&bar[XB_XSUB(b.x)], 1u);
        const unsigned gen = old / nloc;
        if (old + 1u == (gen + 1u) * nloc) {
            __builtin_amdgcn_fence(__ATOMIC_RELEASE, "agent");
            asm volatile("s_waitcnt vmcnt(0)" ::: "memory");
            const unsigned og = xb_add(&bar[XB_TOP], 1u);
            const unsigned tg = og / nx;
            if (og + 1u == (tg + 1u) * nx) xb_add(&bar[XB_TOPGEN], 1u);
            else XB_SPIN(xb_ld(&bar[XB_TOPGEN]) == tg, bar);
            __builtin_amdgcn_fence(__ATOMIC_ACQUIRE, "agent");
            xb_add(&bar[XB_XGEN(b.x)], 1u);
            asm volatile("s_waitcnt vmcnt(0)" ::: "memory");
        } else {
            XB_SPIN(xb_ld(&bar[XB_XGEN(b.x)]) == gen, bar);
            __builtin_amdgcn_fence(__ATOMIC_ACQUIRE, "agent");
            asm volatile("s_waitcnt vmcnt(0)" ::: "memory");
        }
    }
    __syncthreads();
}

__device__ __forceinline__ void grid_bar(const XcdBarrier& b0, int wave_s) {
    unsigned* bp = b0.bar; unsigned x = b0.x; unsigned st = (unsigned)(uintptr_t)b0.st;
    asm volatile("" : "+s"(bp), "+s"(x), "+s"(st));
    XcdBarrier b; b.bar = bp; b.x = x; b.st = (volatile LAS unsigned*)(uintptr_t)st;
    int z = 0; asm volatile("" : "+v"(z)); const int tid = (wave_s << 6) | (int)__builtin_amdgcn_mbcnt_hi(~0u, __builtin_amdgcn_mbcnt_lo(~0u, (unsigned)z));
    xcd_barrier(b, tid);
}

namespace ge {
constexpr int BM = 256, BK = 64, HALF = 128, HTB = HALF * BK * 2, NXCD = 8, WGM = 8;
__device__ __forceinline__ int lds_byte(int r, int c) { const int st = (r >> 4) * 2 + (c >> 5), rr = r & 15, cc = c & 31, ob = rr * 64 + cc * 2; return st * 1024 + (ob ^ (((ob >> 9) & 1) << 5)); }
__device__ __forceinline__ void stage_rc(int b, int& R, int& C) { const int st = b / 1024, sb = b % 1024, swz = sb ^ (((sb >> 9) & 1) << 5); R = (st >> 1) * 16 + swz / 64; C = (st & 1) * 32 + (swz % 64) / 2; }
__device__ __forceinline__ int perm32(int rho) { const int n = rho >> 4, i = rho & 15; return 8 * (i >> 2) + 4 * n + (i & 3); }
__device__ __forceinline__ int xcd_remap(int L, int n) { const int q = n / NXCD, r = n % NXCD, xcd = L % NXCD, off = L / NXCD; return (xcd < r ? xcd * (q + 1) : r * (q + 1) + (xcd - r) * q) + off; }

struct Unit {
    const char* A;
    const char* B;
    char* O;
    int ldc, row0, col0, aux, tbl;
};

template <int K, bool GATHER, class Epi, class Sched>
__device__ __forceinline__ void gemm_phase(const int tid, LAS unsigned char* lds, const LAS int* tbl, const Sched& S, const Epi& E) {
    const int wid = __builtin_amdgcn_readfirstlane(tid >> 6), lane = tid & 63, wr = wid >> 2, wc = wid & 3, fr = lane & 15, fq = lane >> 4;
    constexpr int nt = K / BK;
    static_assert(K % 128 == 0 && K >= 256, "K");
    int Rr[2], Cc[2]; unsigned voffB[2];
#pragma unroll
    for (int i = 0; i < 2; ++i) { int R, C; stage_rc(tid * 16 + i * 8192, R, C); const int Rb = (R & ~31) + perm32(R & 31); Rr[i] = R; Cc[i] = C; voffB[i] = (unsigned)(Rb * K + C) * 2u; }
    constexpr size_t kstep = (size_t)(BK * 2);
    constexpr size_t hstep = (size_t)HALF * K * 2;
    const unsigned ldsw = (unsigned)wid * 1024u;
    const int aoff = lds_byte(wr * 64 + fr, fq * 8), boff = lds_byte(wc * 32 + fr, fq * 8);
#define GE_SA(b, h) (((b) * 2 + (h)) * HTB)
#define GE_SB(b, h) ((4 + (b) * 2 + (h)) * HTB)
#define GE_STAGE_B(bufoff, gbase) do { _Pragma("unroll") for (int _i = 0; _i < 2; ++_i) \
        __builtin_amdgcn_global_load_lds((const unsigned*)((const char*)(gbase) + voffB[_i]), (LAS unsigned*)(lds + (bufoff) + ldsw + _i * 8192), 16, 0, 0); } while (0)
#define GE_STAGE_A(bufoff, gbase, o0, o1) do { \
        __builtin_amdgcn_global_load_lds((const unsigned*)((const char*)(gbase) + (o0)), (LAS unsigned*)(lds + (bufoff) + ldsw), 16, 0, 0); \
        __builtin_amdgcn_global_load_lds((const unsigned*)((const char*)(gbase) + (o1)), (LAS unsigned*)(lds + (bufoff) + ldsw + 8192), 16, 0, 0); } while (0)
#define GE_LDA(dst, b, h) do { _Pragma("unroll") for (int m = 0; m < 4; ++m) _Pragma("unroll") for (int k = 0; k < 2; ++k) dst[m][k] = *(const LAS bf16x8*)(lds + GE_SA(b, h) + aoff + m * 2048 + k * 1024); } while (0)
#define GE_LDB(dst, b, h) do { _Pragma("unroll") for (int n = 0; n < 2; ++n) _Pragma("unroll") for (int k = 0; k < 2; ++k) dst[n][k] = *(const LAS bf16x8*)(lds + GE_SB(b, h) + boff + n * 2048 + k * 1024); } while (0)
#define GE_MMA(ai, bj, At, Bt) do { __builtin_amdgcn_s_setprio(1); _Pragma("unroll") for (int m = 0; m < 4; ++m) _Pragma("unroll") for (int n = 0; n < 2; ++n) _Pragma("unroll") for (int k = 0; k < 2; ++k) \
        acc[ai][bj][m][n] = __builtin_amdgcn_mfma_f32_16x16x32_bf16(Bt[n][k], At[m][k], acc[ai][bj][m][n], 0, 0, 0); __builtin_amdgcn_s_setprio(0); } while (0)
#define GE_WAIT_V(n) asm volatile("s_waitcnt vmcnt(" #n ")" ::: "memory")
#define GE_WAIT_L(n) asm volatile("s_waitcnt lgkmcnt(" #n ")" ::: "memory")
#define GE_BAR __builtin_amdgcn_s_barrier()
#define GE_SCHED __builtin_amdgcn_sched_barrier(0)
#define GE_LOAD_VA(dst, u) do { _Pragma("unroll") for (int _h = 0; _h < 2; ++_h) _Pragma("unroll") for (int _i = 0; _i < 2; ++_i) { \
        if constexpr (GATHER) dst[_h][_i] = (unsigned)tbl[(u).tbl * 256 + _h * 128 + Rr[_i]] * (unsigned)(K * 2) + (unsigned)(Cc[_i] * 2); \
        else dst[_h][_i] = (unsigned)((_h * 128 + Rr[_i]) * K + Cc[_i]) * 2u; } } while (0)
    Unit cur, nxt; int ui = 0;
    if (!S.next(0, cur)) return;
    f32x4 acc[2][2][4][2];
#pragma unroll
    for (int a = 0; a < 2; ++a)
#pragma unroll
        for (int b = 0; b < 2; ++b)
#pragma unroll
            for (int m = 0; m < 4; ++m)
#pragma unroll
                for (int n = 0; n < 2; ++n) acc[a][b][m][n] = (f32x4){0.f, 0.f, 0.f, 0.f};
    bf16x8 At[4][2], B0[2][2], B1[2][2];
    unsigned va[2][2], vn[2][2];
    GE_LOAD_VA(va, cur);
#pragma unroll
    for (int h = 0; h < 2; ++h)
#pragma unroll
        for (int i = 0; i < 2; ++i) vn[h][i] = va[h][i];
    const char* cA = cur.A; const char* cB = cur.B;
    GE_STAGE_B(GE_SB(0, 0), cB); GE_STAGE_B(GE_SB(0, 1), cB + hstep); GE_STAGE_A(GE_SA(0, 0), cA, va[0][0], va[0][1]); GE_STAGE_A(GE_SA(0, 1), cA, va[1][0], va[1][1]);
    if (wr == 1) GE_BAR;
    GE_WAIT_V(2); GE_BAR;
    GE_STAGE_B(GE_SB(1, 0), cB + kstep); GE_STAGE_A(GE_SA(1, 0), cA + kstep, va[0][0], va[0][1]); GE_STAGE_B(GE_SB(1, 1), cB + hstep + kstep);
    GE_WAIT_V(6); GE_BAR;
    for (;;) {
        const bool has_next = S.next(ui + 1, nxt);
        const char* nA = has_next ? nxt.A : cA; const char* nB = has_next ? nxt.B : cB;
        for (int t = 0; t < nt; t += 2) {
            const bool last = (t == nt - 2);
            if (last && has_next) { GE_LOAD_VA(vn, nxt); }
            const char* a1 = cA + (size_t)(t + 1) * kstep;
            const char* a2 = last ? nA : cA + (size_t)(t + 2) * kstep; const char* b2 = last ? nB : cB + (size_t)(t + 2) * kstep;
            const char* a3 = a2 + kstep; const char* b3 = b2 + kstep;
            const unsigned x00 = last ? vn[0][0] : va[0][0], x01 = last ? vn[0][1] : va[0][1], x10 = last ? vn[1][0] : va[1][0], x11 = last ? vn[1][1] : va[1][1];
            GE_LDB(B0, 0, 0); GE_LDB(B1, 0, 1); GE_SCHED; GE_LDA(At, 0, 0); GE_STAGE_A(GE_SA(1, 1), a1, va[1][0], va[1][1]);
            GE_WAIT_V(8); GE_WAIT_L(0); GE_BAR; GE_MMA(0, 0, At, B0); GE_MMA(0, 1, At, B1); GE_BAR; GE_SCHED;
            GE_LDA(At, 0, 1); GE_STAGE_B(GE_SB(0, 0), b2); GE_STAGE_B(GE_SB(0, 1), b2 + hstep); GE_STAGE_A(GE_SA(0, 0), a2, x00, x01);
            GE_WAIT_V(8); GE_WAIT_L(0); GE_BAR; GE_MMA(1, 0, At, B0); GE_MMA(1, 1, At, B1); GE_BAR; GE_SCHED;
            GE_LDB(B0, 1, 0); GE_LDB(B1, 1, 1); GE_SCHED; GE_LDA(At, 1, 0); GE_STAGE_A(GE_SA(0, 1), a2, x10, x11);
            GE_WAIT_V(8); GE_WAIT_L(0); GE_BAR; GE_MMA(0, 0, At, B0); GE_MMA(0, 1, At, B1); GE_BAR; GE_SCHED;
            GE_LDA(At, 1, 1); GE_STAGE_B(GE_SB(1, 0), b3); GE_STAGE_B(GE_SB(1, 1), b3 + hstep); GE_STAGE_A(GE_SA(1, 0), a3, x00, x01);
            GE_WAIT_V(8); GE_WAIT_L(0); GE_BAR; GE_MMA(1, 0, At, B0); GE_MMA(1, 1, At, B1); GE_BAR; GE_SCHED;
        }
        if (wr == 0) GE_BAR;
        E(acc, cur, wr, wc, fr, fq);
        if (!has_next) break;
#pragma unroll
        for (int a = 0; a < 2; ++a)
#pragma unroll
            for (int b = 0; b < 2; ++b)
#pragma unroll
                for (int m = 0; m < 4; ++m)
#pragma unroll
                    for (int n = 0; n < 2; ++n) acc[a][b][m][n] = (f32x4){0.f, 0.f, 0.f, 0.f};
        cur = nxt; cA = nA; cB = nB; ++ui;
#pragma unroll
        for (int h = 0; h < 2; ++h)
#pragma unroll
            for (int i = 0; i < 2; ++i) va[h][i] = vn[h][i];
        if (wr == 1) GE_BAR;
    }
    GE_WAIT_V(0);
    GE_BAR;
#undef GE_SA
#undef GE_SB
#undef GE_STAGE_A
#undef GE_STAGE_B
#undef GE_LDA
#undef GE_LDB
#undef GE_MMA
#undef GE_WAIT_V
#undef GE_WAIT_L
#undef GE_BAR
#undef GE_SCHED
#undef GE_LOAD_VA
}

struct EpiBf16 {
    __device__ __forceinline__ void operator()(const f32x4 (&acc)[2][2][4][2], const Unit& u, int wr, int wc, int fr, int fq) const {
        asm volatile("" : "+v"(fr), "+v"(fq));
#pragma unroll
        for (int ai = 0; ai < 2; ++ai)
#pragma unroll
            for (int m = 0; m < 4; ++m) { bf16* rowp = (bf16*)u.O + (size_t)(u.row0 + ai * HALF + wr * 64 + m * 16 + fr) * u.ldc + u.col0 + wc * 32 + 8 * fq;
#pragma unroll
                for (int bj = 0; bj < 2; ++bj) { const f32x4 v0 = acc[ai][bj][m][0], v1 = acc[ai][bj][m][1];
                    u32x4 w; w.x = cvt_pk_bf16(v0[0], v0[1]); w.y = cvt_pk_bf16(v0[2], v0[3]); w.z = cvt_pk_bf16(v1[0], v1[1]); w.w = cvt_pk_bf16(v1[2], v1[3]);
                    *(u32x4*)(rowp + bj * HALF) = w; } }
    }
};
__device__ __forceinline__ u32x4 res_pack(const u32x4 r, const f32x4 a0, const f32x4 a1) {
    u32x4 w;
    w.x = cvt_pk_bf16(bf2f(r.x & 0xffffu) * ALPHA + a0[0], bf2f(r.x >> 16) * ALPHA + a0[1]); w.y = cvt_pk_bf16(bf2f(r.y & 0xffffu) * ALPHA + a0[2], bf2f(r.y >> 16) * ALPHA + a0[3]);
    w.z = cvt_pk_bf16(bf2f(r.z & 0xffffu) * ALPHA + a1[0], bf2f(r.z >> 16) * ALPHA + a1[1]); w.w = cvt_pk_bf16(bf2f(r.w & 0xffffu) * ALPHA + a1[2], bf2f(r.w >> 16) * ALPHA + a1[3]);
    return w;
}
struct EpiResBf16 {
    const bf16* res; bf16* out;
    __device__ __forceinline__ void operator()(const f32x4 (&acc)[2][2][4][2], const Unit& u, int wr, int wc, int fr, int fq) const {
        asm volatile("" : "+v"(fr), "+v"(fq));
#pragma unroll
        for (int ai = 0; ai < 2; ++ai) {
            u32x4 r[4][2];
#pragma unroll
            for (int m = 0; m < 4; ++m)
#pragma unroll
                for (int bj = 0; bj < 2; ++bj) r[m][bj] = *(const u32x4*)(res + (size_t)(u.row0 + ai * HALF + wr * 64 + m * 16 + fr) * D + u.col0 + wc * 32 + 8 * fq + bj * HALF);
#pragma unroll
            for (int m = 0; m < 4; ++m)
#pragma unroll
                for (int bj = 0; bj < 2; ++bj) *(u32x4*)(out + (size_t)(u.row0 + ai * HALF + wr * 64 + m * 16 + fr) * D + u.col0 + wc * 32 + 8 * fq + bj * HALF) = res_pack(r[m][bj], acc[ai][bj][m][0], acc[ai][bj][m][1]);
            asm volatile("" ::: "memory"); }
    }
};
struct EpiSwiGLU {
    __device__ __forceinline__ void operator()(const f32x4 (&acc)[2][2][4][2], const Unit& u, int wr, int wc, int fr, int fq) const {
        asm volatile("" : "+v"(fr), "+v"(fq));
#pragma unroll
        for (int ai = 0; ai < 2; ++ai)
#pragma unroll
            for (int m = 0; m < 4; ++m) { bf16* rowp = (bf16*)u.O + (size_t)(u.row0 + ai * HALF + wr * 64 + m * 16 + fr) * EH + u.col0 + wc * 32 + 8 * fq;
                const f32x4 g0 = acc[ai][0][m][0], g1 = acc[ai][0][m][1], u0 = acc[ai][1][m][0], u1 = acc[ai][1][m][1];
                float v[8];
#pragma unroll
                for (int j = 0; j < 4; ++j) { v[j] = fast_silu(g0[j]) * u0[j]; v[4 + j] = fast_silu(g1[j]) * u1[j]; }
                u32x4 w; w.x = cvt_pk_bf16(v[0], v[1]); w.y = cvt_pk_bf16(v[2], v[3]); w.z = cvt_pk_bf16(v[4], v[5]); w.w = cvt_pk_bf16(v[6], v[7]);
                *(u32x4*)rowp = w; }
    }
};
struct EpiDown {
    const float* gate; const bf16* res;
    __device__ __forceinline__ void operator()(const f32x4 (&acc)[2][2][4][2], const Unit& u, int wr, int wc, int fr, int fq) const {
        asm volatile("" : "+v"(fr), "+v"(fq));
        if (u.aux >= 0) {
            const __amdgpu_buffer_rsrc_t gr = __builtin_amdgcn_make_buffer_rsrc((void*)(gate + u.aux), (short)0, 256 * 4, RSRC_W3);
#pragma unroll
            for (int ai = 0; ai < 2; ++ai)
#pragma unroll
                for (int m = 0; m < 4; ++m) { const int r = ai * HALF + wr * 64 + m * 16 + fr; const float g = __builtin_bit_cast(float, __builtin_amdgcn_raw_buffer_load_b32(gr, r * 4, 0, 0));
                    bf16* rowp = (bf16*)u.O + (size_t)(u.row0 + r) * D + u.col0 + wc * 32 + 8 * fq;
#pragma unroll
                    for (int bj = 0; bj < 2; ++bj) { const f32x4 v0 = acc[ai][bj][m][0] * g, v1 = acc[ai][bj][m][1] * g;
                        u32x4 w; w.x = cvt_pk_bf16(v0[0], v0[1]); w.y = cvt_pk_bf16(v0[2], v0[3]); w.z = cvt_pk_bf16(v1[0], v1[1]); w.w = cvt_pk_bf16(v1[2], v1[3]);
                        *(u32x4*)(rowp + bj * HALF) = w; } }
        } else {
            bf16* out = (bf16*)u.O;
#pragma unroll
            for (int ai = 0; ai < 2; ++ai) {
                u32x4 r[4][2];
#pragma unroll
                for (int m = 0; m < 4; ++m)
#pragma unroll
                    for (int bj = 0; bj < 2; ++bj) r[m][bj] = *(const u32x4*)(res + (size_t)(u.row0 + ai * HALF + wr * 64 + m * 16 + fr) * D + u.col0 + wc * 32 + 8 * fq + bj * HALF);
#pragma unroll
                for (int m = 0; m < 4; ++m)
#pragma unroll
                    for (int bj = 0; bj < 2; ++bj) *(u32x4*)(out + (size_t)(u.row0 + ai * HALF + wr * 64 + m * 16 + fr) * D + u.col0 + wc * 32 + 8 * fq + bj * HALF) = res_pack(r[m][bj], acc[ai][bj][m][0], acc[ai][bj][m][1]);
                asm volatile("" ::: "memory"); }
        }
    }
};

template <int K> struct SchedDense {
    const char* A; const char* B; char* O; int ldc, nM, nN, G, c;
    __device__ __forceinline__ bool next(int i, Unit& u) const {
        const int nwg = nM * nN; const long L = (long)i * G + c; if (L >= nwg) return false;
        const int wgid = xcd_remap((int)L, nwg);
        const int nig = WGM * nN, gid = wgid / nig, fm = gid * WGM, gsz = (nM - fm) < WGM ? (nM - fm) : WGM;
        const int pm = fm + ((wgid % nig) % gsz), pn = (wgid % nig) / gsz;
        u.A = A + (size_t)pm * (256 * K * 2); u.B = B + (size_t)pn * (256 * K * 2); u.O = O; u.ldc = ldc; u.row0 = pm * 256; u.col0 = pn * 256; u.aux = 0; u.tbl = 0; return true;
    }
};
struct SchedKV {
    const char* memn; const char* memp; const char* wkv; char* kb; char* vt; int G, c;
    __device__ __forceinline__ bool next(int i, Unit& u) const {
        const long L = (long)i * G + c; if (L >= 256) return false;
        const int idx = (int)L, l = idx >> 6, r = idx & 63; u.aux = 0; u.tbl = 0;
        const char* w = wkv + (size_t)l * D * D * 2;
        if (r < 32) { const int pm = r >> 1, pn = r & 1;
            u.A = memn + (size_t)pm * 256 * D * 2; u.B = w + (size_t)pn * 256 * D * 2; u.O = kb + (size_t)l * MROWS * MEM_CH * 2; u.ldc = MEM_CH; u.row0 = pm * 256; u.col0 = pn * 256; }
        else { const int q = r - 32, pm = q >> 4, pn = q & 15;
            u.A = w + (size_t)(512 + pm * 256) * D * 2; u.B = memp + (size_t)pn * 256 * D * 2; u.O = vt + (size_t)l * MROWS * MEM_CH * 2; u.ldc = MROWS; u.row0 = pm * 256; u.col0 = pn * 256; }
        return true;
    }
};
struct SchedGU {
    const char* xb; const char* wgu; const char* wsgu; char* h; const int* ntiles; const int* tile_e; int G, c;
    int n0, n1, n2, n3;
    __device__ __forceinline__ void init() { n0 = ntiles[0]; n1 = ntiles[1]; n2 = ntiles[2]; n3 = ntiles[3]; }
    __device__ __forceinline__ bool next(int i, Unit& u) const {
        const int ntot = n0 + n1 + n2 + n3 + T / 256, nun = ntot * 2; const long L = (long)i * G + c; if (L >= nun || i >= MAXU) return false;
        const int idx = xcd_remap((int)L, nun), pn = idx & 1; int rt = idx >> 1;
        u.A = xb; u.O = h; u.ldc = EH; u.col0 = pn * 128; u.tbl = i;
        int ch = -1, lt = 0;
        if (rt < n0) { ch = 0; lt = rt; } else { rt -= n0; if (rt < n1) { ch = 1; lt = rt; } else { rt -= n1; if (rt < n2) { ch = 2; lt = rt; } else { rt -= n2; if (rt < n3) { ch = 3; lt = rt; } else { rt -= n3; } } } }
        if (ch >= 0) { const int e = tile_e[ch * CH_TILES_MAX + lt]; u.B = wgu + (size_t)e * 512 * D * 2 + (size_t)pn * 256 * D * 2; u.row0 = ch * CH_SLOTS + lt * 256; u.aux = -1; }
        else { u.B = wsgu + (size_t)pn * 256 * D * 2; u.row0 = SH_ROW0 + rt * 256; u.aux = rt * 256; }
        return true;
    }
};
struct SchedDN {
    const char* h; const char* wd; const char* wsd; char* y; char* dout; const int* tile_e; int ch, nt, G, c;
    __device__ __forceinline__ bool next(int i, Unit& u) const {
        const int nun = (CH_TOK / 256 + nt) * 4; const long L = (long)i * G + c; if (L >= nun) return false;
        const int idx = xcd_remap((int)L, nun), pn = idx & 3; int rt = idx >> 2; u.tbl = 0; u.ldc = D; u.col0 = pn * 256;
        if (rt < CH_TOK / 256) { const int row = ch * CH_TOK + rt * 256; u.A = h + (size_t)(SH_ROW0 + row) * EH * 2; u.B = wsd + (size_t)pn * 256 * EH * 2; u.O = dout; u.row0 = row; u.aux = -1; }
        else { rt -= CH_TOK / 256; const int e = tile_e[ch * CH_TILES_MAX + rt]; const int slot0 = ch * CH_SLOTS + rt * 256;
            u.A = h + (size_t)slot0 * EH * 2; u.B = wd + (size_t)e * D * EH * 2 + (size_t)pn * 256 * EH * 2; u.O = y; u.row0 = rt * 256; u.aux = slot0; }
        return true;
    }
};
}

struct KArgs { const float* in[25]; float* out; unsigned char* ws; int layer; int chunk; };
typedef const __attribute__((address_space(4))) KArgs* KArgP;
#define KA_OPAQUE(p) asm volatile("" : "+s"(p))
#define PHASE_BEGIN() int z_ = 0; asm volatile("" : "+v"(z_)); int tid = (wave_s << 6) | (int)__builtin_amdgcn_mbcnt_hi(~0u, __builtin_amdgcn_mbcnt_lo(~0u, (unsigned)z_)); asm volatile("" : "+v"(tid)); asm volatile("" : "+s"(bid), "+s"(G)); KA_OPAQUE(ka)
enum { I_X = 0, I_MEM, I_WIN, I_WPOOL, I_PSCALE, I_WDW, I_BDW, I_CNG, I_CNB, I_WKV, I_WOUT, I_LN1G, I_LN1B, I_WR, I_RB, I_WG, I_WU, I_WD, I_WGS, I_WUS, I_WDS, I_LN2G, I_LN2B, I_MNG, I_MNB };

__device__ __forceinline__ void transpose_item(const float* W, int N, bf16* WT, int ldk, int row_off, LAS float* scr, int k0, int n0, int lane, bf16* WTlo = nullptr) {
#pragma unroll 8
    for (int i = 0; i < 32; ++i) { const int kk = 2 * i + (lane >> 5); scr[kk * 33 + (lane & 31)] = W[(size_t)(k0 + kk) * N + n0 + (lane & 31)]; }
    LDS_WAIT(); asm volatile("" ::: "memory");
    const int c = lane & 7;
#pragma unroll
    for (int j = 0; j < 4; ++j) { const int n = (lane >> 3) + 8 * j; const LAS float* s = scr + (8 * c) * 33 + n;
        float f[8];
#pragma unroll
        for (int i = 0; i < 8; ++i) f[i] = s[i * 33];
        const u32x4 o = pack8(f);
        *(u32x4*)(WT + (size_t)(row_off + n) * ldk + k0 + 8 * c) = o;
        if (WTlo) { float h[8]; unpack8(o, h);
#pragma unroll
            for (int i = 0; i < 8; ++i) f[i] -= h[i];
            *(u32x4*)(WTlo + (size_t)(row_off + n) * ldk + k0 + 8 * c) = pack8(f); } }
    LDS_WAIT(); asm volatile("" ::: "memory");
}

__device__ __forceinline__ void phase_convert_layer(KArgP ka, const int wave_s, int l, LAS unsigned char* lds, int bid, int G) {
    PHASE_BEGIN();
    const int lane = tid & 63, wave = __builtin_amdgcn_readfirstlane(tid >> 6);
    LAS float* scr = (LAS float*)(lds + wave * 16384);
    unsigned char* ws = ka->ws;
    constexpr int I_IN = 16 * 40, I_OUT = 16 * 32, I_GU = 64 * 128, I_DN = 64 * 128, I_SH = 128, I_R = 16 * 2, I_P = 4 * 2;
    constexpr int NIT = I_IN + I_OUT + 2 * I_GU + I_DN + 3 * I_SH + I_R + I_P;
    { float* dwt = (float*)(ws + W_DWT); const float* wdw = ka->in[I_WDW] + (size_t)l * 31 * CONV_CH; const float* bdw = ka->in[I_BDW] + (size_t)l * CONV_CH;
        for (int i = bid * NTHREADS + tid; i < 256 * 32; i += G * NTHREADS) { const int j = i >> 8, ch = i & 255; dwt[ch * 32 + j] = (j < 31) ? wdw[j * CONV_CH + ch] : bdw[ch]; } }
    for (int it = bid * NWAVES + wave; it < NIT; it += G * NWAVES) {
        int r = it;
        if (r < I_IN) { const int kb = r / 40, nb = r % 40; transpose_item(ka->in[I_WIN] + (size_t)l * D * NPROJ, NPROJ, (bf16*)(ws + WS_WIN), D, 32 * nb, scr, 64 * kb, 32 * nb, lane); continue; } r -= I_IN;
        if (r < I_OUT) { const int kb = r / 32, nb = r % 32; transpose_item(ka->in[I_WOUT] + (size_t)l * D * D, D, (bf16*)(ws + WS_WOUT), D, 32 * nb, scr, 64 * kb, 32 * nb, lane); continue; } r -= I_OUT;
        if (r < 2 * I_GU) { const int half = r / I_GU; r %= I_GU; const int e = r / 128, q = r % 128, kb = q / 8, nb = q % 8, n0 = 32 * nb;
            const float* W = ka->in[half ? I_WU : I_WG] + ((size_t)l * NE + e) * D * EH;
            transpose_item(W, EH, (bf16*)(ws + WS_WGU) + (size_t)e * 512 * D, D, (n0 >> 7) * 256 + half * 128 + (n0 & 127), scr, 64 * kb, n0, lane); continue; } r -= 2 * I_GU;
        if (r < I_DN) { const int e = r / 128, q = r % 128, kb = q / 32, nb = q % 32;
            transpose_item(ka->in[I_WD] + ((size_t)l * NE + e) * EH * D, D, (bf16*)(ws + WS_WD) + (size_t)e * D * EH, EH, 32 * nb, scr, 64 * kb, 32 * nb, lane); continue; } r -= I_DN;
        if (r < 2 * I_SH) { const int half = r / I_SH; r %= I_SH; const int kb = r / 8, nb = r % 8, n0 = 32 * nb;
            transpose_item(ka->in[half ? I_WUS : I_WGS] + (size_t)l * D * EH, EH, (bf16*)(ws + WS_WSGU), D, (n0 >> 7) * 256 + half * 128 + (n0 & 127), scr, 64 * kb, n0, lane); continue; } r -= 2 * I_SH;
        if (r < I_SH) { const int kb = r / 32, nb = r % 32; transpose_item(ka->in[I_WDS] + (size_t)l * EH * D, D, (bf16*)(ws + WS_WSD), EH, 32 * nb, scr, 64 * kb, 32 * nb, lane); continue; } r -= I_SH;
        if (r < I_R) { const int kb = r / 2, nb = r % 2; transpose_item(ka->in[I_WR] + (size_t)l * D * NE, NE, (bf16*)(ws + W_RT), D, 32 * nb, scr, 64 * kb, 32 * nb, lane, (bf16*)(ws + W_RTL)); continue; } r -= I_R;
        { const int g = r / 2, nb = r % 2; transpose_item(ka->in[I_WPOOL] + ((size_t)l * 4 + g) * 64 * 64, 64, (bf16*)(ws + W_PT) + (size_t)g * 64 * 64, 64, 32 * nb, scr, 0, 32 * nb, lane); }
    }
}

__device__ __forceinline__ void phase_prologue(KArgP ka, const int wave_s, LAS unsigned char* lds, int bid, int G) {
    PHASE_BEGIN();
    const int lane = tid & 63, wave = __builtin_amdgcn_readfirstlane(tid >> 6);
    LAS float* scr = (LAS float*)(lds + wave * 16384);
    unsigned char* ws = ka->ws;
    const int gw = bid * NWAVES + wave, NGW = G * NWAVES;
    for (int it = gw; it < DEPTH * 512; it += NGW) { const int l = it / 512, q = it % 512, kb = q / 32, nb = q % 32;
        transpose_item(ka->in[I_WKV] + (size_t)l * D * D, D, (bf16*)(ws + WS_WKV) + (size_t)l * D * D, D, 32 * nb, scr, 64 * kb, 32 * nb, lane); }
    const float* g = ka->in[I_MNG]; const float* b = ka->in[I_MNB];
    for (int m = gw; m < MROWS; m += NGW) {
        const f32x4* xr = (const f32x4*)(ka->in[I_MEM] + (size_t)m * D) + lane;
        f32x4 v[4]; float s = 0.f;
#pragma unroll
        for (int j = 0; j < 4; ++j) { v[j] = xr[64 * j]; s += (v[j][0] + v[j][1]) + (v[j][2] + v[j][3]); }
        const float mean = wave_sum(s, lane) * (1.f / D); float s2 = 0.f;
#pragma unroll
        for (int j = 0; j < 4; ++j) { v[j] = v[j] - mean; s2 += (v[j][0] * v[j][0] + v[j][1] * v[j][1]) + (v[j][2] * v[j][2] + v[j][3] * v[j][3]); }
        const float rstd = 1.f / sqrtf(wave_sum(s2, lane) * (1.f / D) + LN_EPS);
        u32x2* o8 = (u32x2*)((bf16*)(ws + WS_MEMN) + (size_t)m * D) + lane;
        const int ml = m & 31, mp = (m & ~31) + 8 * ((ml >> 2) & 3) + 4 * (ml >> 4) + (ml & 3);
        u32x2* p8 = (u32x2*)((bf16*)(ws + WS_MEMP) + (size_t)mp * D) + lane;
#pragma unroll
        for (int j = 0; j < 4; ++j) { const f32x4 gg = ((const f32x4*)g)[lane + 64 * j], bb = ((const f32x4*)b)[lane + 64 * j]; const f32x4 y = v[j] * rstd * gg + bb;
            u32x2 w; w.x = cvt_pk_bf16(y[0], y[1]); w.y = cvt_pk_bf16(y[2], y[3]); o8[64 * j] = w; p8[64 * j] = w; }
    }
    const size_t n8 = (size_t)T * D / 8;
    for (size_t i = (size_t)bid * NTHREADS + tid; i < n8; i += (size_t)G * NTHREADS) {
        const f32x4 p0 = ((const f32x4*)ka->in[I_X])[2 * i], p1 = ((const f32x4*)ka->in[I_X])[2 * i + 1];
        u32x4 w; w.x = cvt_pk_bf16(p0[0], p0[1]); w.y = cvt_pk_bf16(p0[2], p0[3]); w.z = cvt_pk_bf16(p1[0], p1[1]); w.w = cvt_pk_bf16(p1[2], p1[3]);
        ((u32x4*)(ws + WS_XB))[i] = w;
    }
}

#define OPAQUE_TID() int z2_ = 0; asm volatile("" : "+v"(z2_)); int tid = (wave_s << 6) | (int)__builtin_amdgcn_mbcnt_hi(~0u, __builtin_amdgcn_mbcnt_lo(~0u, (unsigned)z2_)); asm volatile("" : "+v"(tid)); const int lane = tid & 63, wave = __builtin_amdgcn_readfirstlane(tid >> 6); (void)lane; (void)wave
__device__ __forceinline__ void phase_mixers(KArgP ka, const int wave_s, int l, LAS unsigned char* lds, int bid, int G) {
    PHASE_BEGIN();
    unsigned char* ws = ka->ws;
    const bf16* proj = (const bf16*)(ws + U_PROJ); bf16* cat = (bf16*)(ws + U_CAT);
    const bf16* wpt = (const bf16*)(ws + W_PT);
    const bf16* Kb = (const bf16*)(ws + WS_KB) + (size_t)l * MROWS * MEM_CH; const bf16* Vt = (const bf16*)(ws + WS_VT) + (size_t)l * MROWS * MEM_CH;
    const float* pscale = ka->in[I_PSCALE] + (size_t)l * POOL_CH;
    const float* dwt = (const float*)(ws + W_DWT);
    const float* cng = ka->in[I_CNG] + (size_t)l * CONV_CH; const float* cnb = ka->in[I_CNB] + (size_t)l * CONV_CH;
    for (int item = bid; item < T / 64; item += G) {
        const int b = item / (SEQ / 64), s0 = (item % (SEQ / 64)) * 64; const size_t t0 = (size_t)b * SEQ + s0;
        for (int rep = 0; rep < 1 + (PROBE_SUB & 1); ++rep) {
            OPAQUE_TID();
            LAS bf16* Ub = (LAS bf16*)lds;
            LAS bf16* Db = (LAS bf16*)(lds + 80 * 528);
#pragma unroll 1
            for (int i = tid; i < 80 * 32; i += NTHREADS) { const int r = i >> 5, c8 = i & 31; const int s = s0 - 8 + r;
                u32x4 v = (u32x4){0u, 0u, 0u, 0u}; if (s >= 0 && s < SEQ) v = *(const u32x4*)(proj + ((size_t)b * SEQ + s) * NPROJ + c8 * 8);
                *(LAS u32x4*)(Ub + r * 264 + c8 * 8) = v; }
            __syncthreads();
            { const int ch = tid & 255, half = tid >> 8, g = ch >> 6; const int w = 2 << g, lo = w >> 1, hi = w - 1 - lo;
#pragma unroll 1
                for (int r = half * 32; r < half * 32 + 32; ++r) { const int s = s0 + r; const int st = max(s - lo, 0), en = min(s + hi + 1, SEQ);
                    float sum = 0.f; for (int q = st; q < en; ++q) sum += bf2f(Ub[(q - s0 + 8) * 264 + ch]);
                    const float d = sum / (float)(en - st) - bf2f(Ub[(r + 8) * 264 + ch]);
                    Db[r * 264 + ch] = (bf16)(cvt_pk_bf16(d, 0.f) & 0xffffu); } }
            __syncthreads();
            { const int g = wave >> 1, rh = wave & 1, fr = lane & 15, fq = lane >> 4;
#pragma unroll
                for (int rt = 0; rt < 2; ++rt) {
                    bf16x8 af[2];
#pragma unroll
                    for (int ks = 0; ks < 2; ++ks) af[ks] = *(const LAS bf16x8*)(Db + (rh * 32 + rt * 16 + fr) * 264 + g * 64 + ks * 32 + 8 * fq);
#pragma unroll
                    for (int ct = 0; ct < 4; ++ct) { f32x4 c = (f32x4){0.f, 0.f, 0.f, 0.f};
#pragma unroll
                        for (int ks = 0; ks < 2; ++ks) { const bf16x8 bfv = *(const bf16x8*)(wpt + (size_t)g * 4096 + (ct * 16 + fr) * 64 + ks * 32 + 8 * fq); c = __builtin_amdgcn_mfma_f32_16x16x32_bf16(af[ks], bfv, c, 0, 0, 0); }
                        const int col = g * 64 + ct * 16 + fr; const float sc = pscale[col];
#pragma unroll
                        for (int j = 0; j < 4; ++j) cat[(t0 + rh * 32 + rt * 16 + fq * 4 + j) * D + col] = (bf16)(cvt_pk_bf16(c[j] * sc, 0.f) & 0xffffu); } } }
            __syncthreads();
        }
        for (int rep = 0; rep < 1 + ((PROBE_SUB >> 1) & 1); ++rep) {
            OPAQUE_TID();
            LAS bf16* Gb = (LAS bf16*)lds;
            LAS float* Yc = (LAS float*)(lds + 49152);
#pragma unroll 1
            for (int i = tid; i < 94 * 32; i += NTHREADS) { const int r = i >> 5, c8 = i & 31; const int s = s0 - 15 + r;
                u32x4 o = (u32x4){0u, 0u, 0u, 0u};
                if (s >= 0 && s < SEQ) { const bf16* pr = proj + ((size_t)b * SEQ + s) * NPROJ + 256 + c8 * 8; const u32x4 av = *(const u32x4*)pr, gv = *(const u32x4*)(pr + 256);
                    float y[8];
#pragma unroll
                    for (int j = 0; j < 4; ++j) { const unsigned aw = av[j], gw2 = gv[j];
                        y[2 * j] = bf2f(aw & 0xffffu) * fast_sigmoid(bf2f(gw2 & 0xffffu)); y[2 * j + 1] = bf2f(aw >> 16) * fast_sigmoid(bf2f(gw2 >> 16)); }
                    o.x = cvt_pk_bf16(y[0], y[1]); o.y = cvt_pk_bf16(y[2], y[3]); o.z = cvt_pk_bf16(y[4], y[5]); o.w = cvt_pk_bf16(y[6], y[7]); }
                *(LAS u32x4*)(Gb + r * 256 + c8 * 8) = o; }
            __syncthreads();
            { const int ch = tid & 255, half = tid >> 8; float wv[32];
#pragma unroll
                for (int j = 0; j < 8; ++j) { const f32x4 w4 = ((const f32x4*)(dwt + ch * 32))[j]; wv[4 * j] = w4[0]; wv[4 * j + 1] = w4[1]; wv[4 * j + 2] = w4[2]; wv[4 * j + 3] = w4[3]; }
                const float bias = wv[31];
#pragma unroll 1
                for (int rb = 0; rb < 8; ++rb) { const int r0 = half * 32 + rb * 4; float gv[34];
#pragma unroll
                    for (int j = 0; j < 34; ++j) gv[j] = bf2f(Gb[(r0 + j) * 256 + ch]);
#pragma unroll
                    for (int q = 0; q < 4; ++q) { float y = bias;
#pragma unroll
                        for (int j = 0; j < 31; ++j) y += gv[q + j] * wv[j];
                        Yc[(r0 + q) * 256 + ch] = y; } } }
            __syncthreads();
#pragma unroll 1
            for (int r = wave; r < 64; r += NWAVES) { const f32x4 v = *(const LAS f32x4*)(Yc + r * 256 + lane * 4);
                const float mean = wave_sum((v[0] + v[1]) + (v[2] + v[3]), lane) * (1.f / 256.f); const f32x4 d = v - mean;
                const float rstd = 1.f / sqrtf(wave_sum((d[0] * d[0] + d[1] * d[1]) + (d[2] * d[2] + d[3] * d[3]), lane) * (1.f / 256.f) + LN_EPS);
                const f32x4 gg = ((const f32x4*)cng)[lane], bb = ((const f32x4*)cnb)[lane]; const f32x4 y = d * rstd * gg + bb;
                u32x2 w; w.x = cvt_pk_bf16(fast_silu(y[0]), fast_silu(y[1])); w.y = cvt_pk_bf16(fast_silu(y[2]), fast_silu(y[3]));
                *(u32x2*)(cat + (t0 + r) * D + 256 + lane * 4) = w; }
            __syncthreads();
        }
        for (int rep = 0; rep < 1 + ((PROBE_SUB >> 2) & 1); ++rep) {
            OPAQUE_TID();
            const int hh = wave >> 1, rbase = (wave & 1) * 32, fr = lane & 15, fq = lane >> 4;
            constexpr float SC = 0.08838834764831845f * 1.4426950408889634f;
            const __amdgpu_buffer_rsrc_t kR = __builtin_amdgcn_make_buffer_rsrc((void*)(Kb + (size_t)b * MEMT * MEM_CH + hh * HD), (short)0, MEMT * MEM_CH * 2, RSRC_W3);
            const __amdgpu_buffer_rsrc_t vR = __builtin_amdgcn_make_buffer_rsrc((void*)(Vt + (size_t)hh * HD * MROWS + b * MEMT), (short)0, HD * MROWS * 2, RSRC_W3);
            const __amdgpu_buffer_rsrc_t qR = __builtin_amdgcn_make_buffer_rsrc((void*)(proj + (t0 + rbase) * NPROJ + 768 + hh * HD), (short)0, 32 * NPROJ * 2, RSRC_W3);
            const unsigned klane = (unsigned)(fr * MEM_CH + 8 * fq) * 2u, vlane = (unsigned)(fr * MROWS + 8 * fq) * 2u, qlane = (unsigned)(fr * NPROJ + 8 * fq) * 2u;
            bf16x8 bq[2][4];
#pragma unroll
            for (int qt = 0; qt < 2; ++qt)
#pragma unroll
                for (int ks = 0; ks < 4; ++ks) bq[qt][ks] = bufld8(qR, qlane, (unsigned)(qt * 16 * NPROJ + ks * 32) * 2u);
            f32x4 s[2][16];
#pragma unroll
            for (int ct = 0; ct < 16; ++ct) { s[0][ct] = (f32x4){0.f, 0.f, 0.f, 0.f}; s[1][ct] = (f32x4){0.f, 0.f, 0.f, 0.f};
#pragma unroll
                for (int ks = 0; ks < 4; ++ks) { const bf16x8 kf = bufld8(kR, klane, (unsigned)(ct * 16 * MEM_CH + ks * 32) * 2u);
                    s[0][ct] = __builtin_amdgcn_mfma_f32_16x16x32_bf16(kf, bq[0][ks], s[0][ct], 0, 0, 0); s[1][ct] = __builtin_amdgcn_mfma_f32_16x16x32_bf16(kf, bq[1][ks], s[1][ct], 0, 0, 0); }
                if ((ct & 3) == 3) asm volatile("" ::: "memory"); }
            float inv[2];
            bf16x8 pb[2][8];
#pragma unroll
            for (int qt = 0; qt < 2; ++qt) { float m = s[qt][0][0];
#pragma unroll
                for (int ct = 0; ct < 16; ++ct)
#pragma unroll
                    for (int j = 0; j < 4; ++j) m = fmaxf(m, s[qt][ct][j]);
                m = fmaxf(m, swz_xor<16>(m)); m = fmaxf(m, bperm_f(lane ^ 32, m));
                float sum = 0.f;
#pragma unroll
                for (int ks = 0; ks < 8; ++ks) { float p[8];
#pragma unroll
                    for (int j = 0; j < 4; ++j) { p[j] = __builtin_amdgcn_exp2f((s[qt][2 * ks][j] - m) * SC); p[4 + j] = __builtin_amdgcn_exp2f((s[qt][2 * ks + 1][j] - m) * SC); }
#pragma unroll
                    for (int j = 0; j < 8; ++j) sum += p[j];
                    pb[qt][ks] = __builtin_bit_cast(bf16x8, pack8(p)); }
                sum += swz_xor<16>(sum); sum += bperm_f(lane ^ 32, sum);
                inv[qt] = 1.f / sum; }
            f32x4 o[2][8];
#pragma unroll
            for (int dt = 0; dt < 8; ++dt) { o[0][dt] = (f32x4){0.f, 0.f, 0.f, 0.f}; o[1][dt] = (f32x4){0.f, 0.f, 0.f, 0.f}; }
#pragma unroll
            for (int ks = 0; ks < 8; ++ks) {
#pragma unroll
                for (int dt = 0; dt < 8; ++dt) { const bf16x8 vf = bufld8(vR, vlane, (unsigned)(dt * 16 * MROWS + ks * 32) * 2u);
                    o[0][dt] = __builtin_amdgcn_mfma_f32_16x16x32_bf16(vf, pb[0][ks], o[0][dt], 0, 0, 0); o[1][dt] = __builtin_amdgcn_mfma_f32_16x16x32_bf16(vf, pb[1][ks], o[1][dt], 0, 0, 0); }
                if (ks & 1) asm volatile("" ::: "memory"); }
#pragma unroll
            for (int qt = 0; qt < 2; ++qt) { bf16* orow = cat + (t0 + rbase + qt * 16 + fr) * D + 512 + hh * HD + 4 * fq;
#pragma unroll
                for (int dt = 0; dt < 8; ++dt) { u32x2 w; w.x = cvt_pk_bf16(o[qt][dt][0] * inv[qt], o[qt][dt][1] * inv[qt]); w.y = cvt_pk_bf16(o[qt][dt][2] * inv[qt], o[qt][dt][3] * inv[qt]); *(u32x2*)(orow + dt * 16) = w; } }
        }
    }
}

__device__ __forceinline__ void phase_ln1_router(KArgP ka, const int wave_s, int l, LAS unsigned char* lds, int bid, int G) {
    PHASE_BEGIN();
    const int lane = tid & 63, wave = __builtin_amdgcn_readfirstlane(tid >> 6), fr = lane & 15, fq = lane >> 4;
    unsigned char* ws = ka->ws;
    const bf16* zb = (const bf16*)(ws + WS_ZB); bf16* xb = (bf16*)(ws + WS_XB);
    const float* g = ka->in[I_LN1G] + (size_t)l * D; const float* bta = ka->in[I_LN1B] + (size_t)l * D;
    const float* rbias = ka->in[I_RB] + (size_t)l * NE;
    int* tok_e = (int*)(ws + TOK_E); float* tok_g = (float*)(ws + TOK_G); int* tok_r = (int*)(ws + TOK_R); int* hist = (int*)(ws + TAB_HIST);
    int* row_tok = (int*)(ws + ROW_TOK);
    for (int i = bid * NTHREADS + tid; i < NCH * CH_SLOTS; i += G * NTHREADS) row_tok[i] = 0;
    LAS bf16* Xh = (LAS bf16*)lds;
    LAS bf16* Xl = (LAS bf16*)(lds + 32 * 2064);
    LAS float* Lg = (LAS float*)(lds + 64 * 2064);
    LAS int* hl = (LAS int*)(lds + 64 * 2064 + 16384);
    const int ct = wave & 3, part = wave >> 2;
    bf16x8 wf[32];
    { const bf16* wsrc = (const bf16*)(ws + (part ? W_RTL : W_RT)) + (size_t)(ct * 16 + fr) * D + 8 * fq;
#pragma unroll
        for (int ks = 0; ks < 32; ++ks) wf[ks] = *(const bf16x8*)(wsrc + ks * 32); }
    const float rb = rbias[lane];
#pragma unroll 1
    for (int tb = bid; tb < NTB; tb += G) {
        if (tid < 64) hl[tid] = 0;
        __syncthreads();
#pragma unroll 1
        for (int st = 0; st < 8; ++st) {
            { u32x4 zv[4][2];
#pragma unroll
                for (int rr = 0; rr < 4; ++rr) { const size_t t = (size_t)tb * TBLK + st * 32 + wave * 4 + rr;
#pragma unroll
                    for (int j = 0; j < 2; ++j) zv[rr][j] = *(const u32x4*)(zb + t * D + 8 * lane + 512 * j); }
#pragma unroll
                for (int rr = 0; rr < 4; ++rr) { const int lr = wave * 4 + rr; const size_t t = (size_t)tb * TBLK + st * 32 + lr;
                    float v[16]; unpack8(zv[rr][0], v); unpack8(zv[rr][1], v + 8);
                    ln_row16(v, g, bta, lane);
#pragma unroll
                    for (int j = 0; j < 2; ++j) { const u32x4 w = pack8(v + 8 * j); *(u32x4*)(xb + t * D + 8 * lane + 512 * j) = w; *(LAS u32x4*)(Xh + lr * 1032 + 8 * lane + 512 * j) = w;
                        float lo[8]; float hf[8]; unpack8(w, hf);
#pragma unroll
                        for (int i = 0; i < 8; ++i) lo[i] = v[8 * j + i] - hf[i];
                        *(LAS u32x4*)(Xl + lr * 1032 + 8 * lane + 512 * j) = pack8(lo); } } }
            __syncthreads();
            { f32x4 c0 = (f32x4){0.f, 0.f, 0.f, 0.f}, c1 = (f32x4){0.f, 0.f, 0.f, 0.f};
#pragma unroll
                for (int ks = 0; ks < 32; ++ks) { const bf16x8 a0 = *(const LAS bf16x8*)(Xh + fr * 1032 + ks * 32 + 8 * fq), a1 = *(const LAS bf16x8*)(Xh + (16 + fr) * 1032 + ks * 32 + 8 * fq);
                    c0 = __builtin_amdgcn_mfma_f32_16x16x32_bf16(a0, wf[ks], c0, 0, 0, 0); c1 = __builtin_amdgcn_mfma_f32_16x16x32_bf16(a1, wf[ks], c1, 0, 0, 0);
                    if (part == 0) { const bf16x8 l0 = *(const LAS bf16x8*)(Xl + fr * 1032 + ks * 32 + 8 * fq), l1 = *(const LAS bf16x8*)(Xl + (16 + fr) * 1032 + ks * 32 + 8 * fq);
                        c0 = __builtin_amdgcn_mfma_f32_16x16x32_bf16(l0, wf[ks], c0, 0, 0, 0); c1 = __builtin_amdgcn_mfma_f32_16x16x32_bf16(l1, wf[ks], c1, 0, 0, 0); } }
#pragma unroll
                for (int j = 0; j < 4; ++j) { Lg[(part * 32 + fq * 4 + j) * 64 + ct * 16 + fr] = c0[j]; Lg[(part * 32 + 16 + fq * 4 + j) * 64 + ct * 16 + fr] = c1[j]; } }
            __syncthreads();
#pragma unroll 1
            for (int rr = 0; rr < 4; ++rr) { const int lr = wave * 4 + rr; const size_t t = (size_t)tb * TBLK + st * 32 + lr;
                const float sc = fast_sigmoid(Lg[lr * 64 + lane] + Lg[(32 + lr) * 64 + lane]); float sel = sc + rb;
                int my_e = 0; float my_s = 0.f, ssum = 0.f;
#pragma unroll
                for (int k = 0; k < TOPK; ++k) { const float m = wave_max(sel, lane); const unsigned long long mask = __ballot(sel == m); const int idx = __ffsll((long long)mask) - 1;
                    const float sk = rl_f(sc, idx); ssum += sk; if (lane == idx) sel = -3.0e38f; if (lane == k) { my_e = idx; my_s = sk; } }
                if (lane < TOPK) { const int rank = __hip_atomic_fetch_add(&hl[my_e], 1, __ATOMIC_RELAXED, __HIP_MEMORY_SCOPE_WORKGROUP);
                    tok_e[t * TOPK + lane] = my_e; tok_g[t * TOPK + lane] = my_s / ssum * ROUTED_SCALE; tok_r[t * TOPK + lane] = rank; }
            }
            __syncthreads();
        }
        if (tid < 64) hist[tb * 64 + tid] = hl[tid];
        __syncthreads();
    }
}

__device__ __forceinline__ void phase_scatter(KArgP ka, const int wave_s, LAS unsigned char* lds, int bid, int G) {
    PHASE_BEGIN();
    const int lane = tid & 63;
    unsigned char* ws = ka->ws;
    const int* tok_e = (const int*)(ws + TOK_E); const float* tok_g = (const float*)(ws + TOK_G); const int* tok_r = (const int*)(ws + TOK_R); int* slot_of = (int*)(ws + TOK_SLOT);
    const int* hist = (const int*)(ws + TAB_HIST); int* ntiles = (int*)(ws + TAB_NT); int* tile_e = (int*)(ws + TAB_TE);
    int* row_tok = (int*)(ws + ROW_TOK); float* row_gate = (float*)(ws + ROW_GATE);
    LAS int* ptot = (LAS int*)lds; LAS int* pbef = ptot + 512; LAS int* base = pbef + 512;
    for (int tb = bid; tb < NTB; tb += G) {
        const int ch = tb / TB_PER_CH;
        { const int e = tid & 63, part = tid >> 6; int tot = 0, bef = 0;
            for (int j = 0; j < 8; ++j) { const int blk = ch * TB_PER_CH + part * 8 + j; const int v = hist[blk * 64 + e]; tot += v; if (blk < tb) bef += v; }
            ptot[part * 64 + e] = tot; pbef[part * 64 + e] = bef; }
        __syncthreads();
        if (tid < 64) { int tot = 0, bef = 0;
#pragma unroll
            for (int p = 0; p < 8; ++p) { tot += ptot[p * 64 + tid]; bef += pbef[p * 64 + tid]; }
            const int padded = (tot + 255) & ~255; int inc = padded;
#pragma unroll
            for (int o = 1; o < 64; o <<= 1) { const int v = bperm_i((lane - o) & 63, inc); if (lane >= o) inc += v; }
            const int ebase = inc - padded;
            base[tid] = ebase + bef;
            if (tb % TB_PER_CH == 0) { if (tid == 63) ntiles[ch] = inc >> 8; for (int j = 0; j < (padded >> 8); ++j) tile_e[ch * CH_TILES_MAX + (ebase >> 8) + j] = tid; }
        }
        __syncthreads();
        for (int q = tid; q < TBLK * TOPK; q += NTHREADS) { const size_t i = (size_t)tb * TBLK * TOPK + q; const int e = tok_e[i]; const int slot = ch * CH_SLOTS + base[e] + tok_r[i];
            row_tok[slot] = (int)(i >> 3); row_gate[slot] = tok_g[i]; slot_of[i] = slot; }
        __syncthreads();
    }
}

__device__ __forceinline__ void phase_combine_ln2(KArgP ka, const int wave_s, int l, int ch, int bid, int G) {
    PHASE_BEGIN();
    const int lane = tid & 63, wave = __builtin_amdgcn_readfirstlane(tid >> 6);
    unsigned char* ws = ka->ws;
    float* dout = ka->out; bf16* xb = (bf16*)(ws + WS_XB); const bf16* zb = (const bf16*)(ws + WS_ZB); const bf16* Y = (const bf16*)(ws + WS_Y); const int* slot_of = (const int*)(ws + TOK_SLOT);
    const float* g = ka->in[I_LN2G] + (size_t)l * D; const float* bta = ka->in[I_LN2B] + (size_t)l * D;
    const bool last = (l == DEPTH - 1);
#pragma unroll 1
    for (int q = bid * NWAVES + wave; q < CH_TOK; q += G * NWAVES) { const size_t t = (size_t)ch * CH_TOK + q;
        int sl[TOPK];
#pragma unroll
        for (int k = 0; k < TOPK; ++k) sl[k] = __builtin_amdgcn_readfirstlane(slot_of[t * TOPK + k]) - ch * CH_SLOTS;
        u32x4 zv[2], yv[TOPK][2];
#pragma unroll
        for (int j = 0; j < 2; ++j) zv[j] = *(const u32x4*)(zb + t * D + 8 * lane + 512 * j);
#pragma unroll
        for (int k = 0; k < TOPK; ++k)
#pragma unroll
            for (int j = 0; j < 2; ++j) yv[k][j] = *(const u32x4*)(Y + (size_t)sl[k] * D + 8 * lane + 512 * j);
        float v[16]; unpack8(zv[0], v); unpack8(zv[1], v + 8);
#pragma unroll
        for (int k = 0; k < TOPK; ++k) { addpack8(yv[k][0], v); addpack8(yv[k][1], v + 8); }
        ln_row16(v, g, bta, lane);
#pragma unroll
        for (int j = 0; j < 2; ++j) *(u32x4*)(xb + t * D + 8 * lane + 512 * j) = pack8(v + 8 * j);
        if (last) {
#pragma unroll
            for (int j = 0; j < 2; ++j) { *(f32x4*)(dout + t * D + 8 * lane + 512 * j) = (f32x4){v[8 * j], v[8 * j + 1], v[8 * j + 2], v[8 * j + 3]}; *(f32x4*)(dout + t * D + 8 * lane + 512 * j + 4) = (f32x4){v[8 * j + 4], v[8 * j + 5], v[8 * j + 6], v[8 * j + 7]}; } }
    }
}

__device__ __forceinline__ void phase_gemm_kv(KArgP ka, const int wave_s, LAS unsigned char* lds, int bid, int G) {
    PHASE_BEGIN();
    unsigned char* ws = ka->ws;
    ge::SchedKV S{(const char*)(ws + WS_MEMN), (const char*)(ws + WS_MEMP), (const char*)(ws + WS_WKV), (char*)(ws + WS_KB), (char*)(ws + WS_VT), G, bid};
    ge::EpiBf16 E;
    ge::gemm_phase<D, false, ge::EpiBf16, ge::SchedKV>(tid, lds, (const LAS int*)(lds + LDS_TBL), S, E);
}
__device__ __forceinline__ void phase_gemm_in(KArgP ka, const int wave_s, LAS unsigned char* lds, int bid, int G) {
    PHASE_BEGIN();
    unsigned char* ws = ka->ws;
    ge::SchedDense<D> S{(const char*)(ws + WS_XB), (const char*)(ws + WS_WIN), (char*)(ws + U_PROJ), NPROJ, T / 256, NPROJ / 256, G, bid};
    ge::EpiBf16 E;
    ge::gemm_phase<D, false, ge::EpiBf16, ge::SchedDense<D>>(tid, lds, (const LAS int*)(lds + LDS_TBL), S, E);
}
__device__ __forceinline__ void phase_gemm_out(KArgP ka, const int wave_s, int l, LAS unsigned char* lds, int bid, int G) {
    PHASE_BEGIN();
    unsigned char* ws = ka->ws;
    ge::SchedDense<D> S{(const char*)(ws + U_CAT), (const char*)(ws + WS_WOUT), (char*)(ws + WS_ZB), D, T / 256, D / 256, G, bid};
    ge::EpiResBf16 E{(const bf16*)(ws + WS_XB), (bf16*)(ws + WS_ZB)};
    ge::gemm_phase<D, false, ge::EpiResBf16, ge::SchedDense<D>>(tid, lds, (const LAS int*)(lds + LDS_TBL), S, E);
}
__device__ __forceinline__ void phase_gemm_gu(KArgP ka, const int wave_s, LAS unsigned char* lds, int bid, int G) {
    PHASE_BEGIN();
    unsigned char* ws = ka->ws;
    ge::SchedGU S{(const char*)(ws + WS_XB), (const char*)(ws + WS_WGU), (const char*)(ws + WS_WSGU), (char*)(ws + U_H), (const int*)(ws + TAB_NT), (const int*)(ws + TAB_TE), G, bid, 0, 0, 0, 0};
    S.init();
    LAS int* tbl = (LAS int*)(lds + LDS_TBL);
    const int* row_tok = (const int*)(ws + ROW_TOK);
    { ge::Unit u; for (int i = 0; i < MAXU && S.next(i, u); ++i) { const int r = tid; if (r < 256) tbl[i * 256 + r] = (u.aux >= 0) ? (u.aux + r) : row_tok[u.row0 + r]; } }
    __syncthreads();
    ge::EpiSwiGLU E;
    ge::gemm_phase<D, true, ge::EpiSwiGLU, ge::SchedGU>(tid, lds, tbl, S, E);
}
__device__ __forceinline__ void phase_gemm_dn(KArgP ka, const int wave_s, int ch, LAS unsigned char* lds, int bid, int G) {
    PHASE_BEGIN();
    unsigned char* ws = ka->ws;
    ge::SchedDN S{(const char*)(ws + U_H), (const char*)(ws + WS_WD), (const char*)(ws + WS_WSD), (char*)(ws + WS_Y), (char*)(ws + WS_ZB), (const int*)(ws + TAB_TE), ch, ((const int*)(ws + TAB_NT))[ch], G, bid};
    ge::EpiDown E{(const float*)(ws + ROW_GATE), (const bf16*)(ws + WS_XB)};
    ge::gemm_phase<EH, false, ge::EpiDown, ge::SchedDN>(tid, lds, (const LAS int*)(lds + LDS_TBL), S, E);
}

#define KERNEL_HEAD extern __shared__ __attribute__((aligned(16))) unsigned char lds_raw[]; LAS unsigned char* lds = (LAS unsigned char*)lds_raw; const int bid = blockIdx.x, G = gridDim.x; KArgP ka = (KArgP)__builtin_amdgcn_kernarg_segment_ptr(); (void)a; const int wave_s = __builtin_amdgcn_readfirstlane((int)(threadIdx.x >> 6));
#if MK_ONE_LAUNCH
#define RUN(id, call) do { KA_OPAQUE(ka); call; if ((PROBE_DUP >> (id)) & 1) { grid_bar(bar, wave_s); KA_OPAQUE(ka); call; } } while (0)
__global__ void __launch_bounds__(NTHREADS, 2) k_mega(KArgs a) {
    KERNEL_HEAD
    volatile LAS unsigned* misc = (volatile LAS unsigned*)(lds + LDS_CTLW);
    if (threadIdx.x < 64) misc[threadIdx.x] = 0u;
    __syncthreads();
    const XcdBarrier bar = xcd_barrier_post((unsigned*)(ka->ws + WS_CTL), misc + 8, (int)threadIdx.x);
    RUN(1, phase_prologue(ka, wave_s, lds, bid, G));
    RUN(2, phase_convert_layer(ka, wave_s, 0, lds, bid, G));
    grid_bar(bar, wave_s);
    RUN(3, phase_gemm_kv(ka, wave_s, lds, bid, G));
#pragma unroll 1
    for (int l = 0; l < DEPTH; ++l) {
        RUN(4, phase_gemm_in(ka, wave_s, lds, bid, G));
        grid_bar(bar, wave_s);
        RUN(5, phase_mixers(ka, wave_s, l, lds, bid, G));
        grid_bar(bar, wave_s);
        RUN(6, phase_gemm_out(ka, wave_s, l, lds, bid, G));
        grid_bar(bar, wave_s);
        RUN(7, phase_ln1_router(ka, wave_s, l, lds, bid, G));
        grid_bar(bar, wave_s);
        RUN(8, phase_scatter(ka, wave_s, lds, bid, G));
        grid_bar(bar, wave_s);
        RUN(9, phase_gemm_gu(ka, wave_s, lds, bid, G));
        grid_bar(bar, wave_s);
#pragma unroll 1
        for (int c = 0; c < NCH; ++c) {
            RUN(10, phase_gemm_dn(ka, wave_s, c, lds, bid, G));
            grid_bar(bar, wave_s);
            RUN(11, phase_combine_ln2(ka, wave_s, l, c, bid, G));
            if (c == NCH - 1) { if (l == DEPTH - 1) break; RUN(2, phase_convert_layer(ka, wave_s, l + 1, lds, bid, G)); }
            grid_bar(bar, wave_s);
        }
    }
}
#else
__global__ void __launch_bounds__(NTHREADS, 2) k_prologue(KArgs a) { KERNEL_HEAD phase_prologue(ka, wave_s, lds, bid, G); }
__global__ void __launch_bounds__(NTHREADS, 2) k_convert(KArgs a) { KERNEL_HEAD phase_convert_layer(ka, wave_s, ka->layer, lds, bid, G); }
__global__ void __launch_bounds__(NTHREADS, 2) k_gemm_kv(KArgs a) { KERNEL_HEAD phase_gemm_kv(ka, wave_s, lds, bid, G); }
__global__ void __launch_bounds__(NTHREADS, 2) k_gemm_in(KArgs a) { KERNEL_HEAD phase_gemm_in(ka, wave_s, lds, bid, G); }
__global__ void __launch_bounds__(NTHREADS, 2) k_mixers(KArgs a) { KERNEL_HEAD phase_mixers(ka, wave_s, ka->layer, lds, bid, G); }
__global__ void __launch_bounds__(NTHREADS, 2) k_gemm_out(KArgs a) { KERNEL_HEAD phase_gemm_out(ka, wave_s, ka->layer, lds, bid, G); }
__global__ void __launch_bounds__(NTHREADS, 2) k_ln1_router(KArgs a) { KERNEL_HEAD phase_ln1_router(ka, wave_s, ka->layer, lds, bid, G); }
__global__ void __launch_bounds__(NTHREADS, 2) k_scatter(KArgs a) { KERNEL_HEAD phase_scatter(ka, wave_s, lds, bid, G); }
__global__ void __launch_bounds__(NTHREADS, 2) k_gemm_gu(KArgs a) { KERNEL_HEAD phase_gemm_gu(ka, wave_s, lds, bid, G); }
__global__ void __launch_bounds__(NTHREADS, 2) k_gemm_dn(KArgs a) { KERNEL_HEAD phase_gemm_dn(ka, wave_s, ka->chunk, lds, bid, G); }
__global__ void __launch_bounds__(NTHREADS, 2) k_combine(KArgs a) { KERNEL_HEAD (void)lds; phase_combine_ln2(ka, wave_s, ka->layer, ka->chunk, bid, G); }
#endif

extern "C" void kernel_launch(void* const* d_in, const int* in_sizes, int n_in, void* d_out, int out_size, void* d_ws, size_t ws_size, hipStream_t stream) {
    static int grid = 0;
    if (!grid) {
        if (n_in != 25 || out_size != T * D || ws_size < WS_END) { fprintf(stderr, "kernel_launch: unexpected shapes (n_in %d out %d ws %zu need %zu)\n", n_in, out_size, ws_size, (size_t)WS_END); grid = -1; return; }
        int dev = 0, cus = 0; (void)hipGetDevice(&dev); (void)hipDeviceGetAttribute(&cus, hipDeviceAttributeMultiprocessorCount, dev);
#if MK_ONE_LAUNCH
        const void* ks[] = {(const void*)k_mega};
#else
        const void* ks[] = {(const void*)k_prologue, (const void*)k_convert, (const void*)k_gemm_kv, (const void*)k_gemm_in, (const void*)k_mixers, (const void*)k_gemm_out, (const void*)k_ln1_router,
                            (const void*)k_scatter, (const void*)k_gemm_gu, (const void*)k_gemm_dn, (const void*)k_combine};
#endif
        for (const void* k : ks) if (hipFuncSetAttribute(k, hipFuncAttributeMaxDynamicSharedMemorySize, LDS_BYTES) != hipSuccess) { fprintf(stderr, "kernel_launch: hipFuncSetAttribute failed\n"); grid = -1; return; }
        grid = cus > 0 ? cus : 256; if (grid > 256) grid = 256;
#if MK_ONE_LAUNCH
        int per_cu = 0;
        if (hipOccupancyMaxActiveBlocksPerMultiprocessor(&per_cu, (const void*)k_mega, NTHREADS, LDS_BYTES) != hipSuccess || per_cu < 1) { fprintf(stderr, "kernel_launch: occupancy query says %d blocks per CU\n", per_cu); grid = -1; return; }
#endif
    }
    if (grid < 0) return;
    KArgs a{};
    for (int i = 0; i < 25; ++i) a.in[i] = (const float*)d_in[i];
    a.out = (float*)d_out; a.ws = (unsigned char*)d_ws; a.layer = 0; a.chunk = 0;
    const dim3 g(grid), b(NTHREADS);
#if MK_ONE_LAUNCH
    (void)hipMemsetAsync((char*)d_ws + WS_CTL, 0, 65536, stream);
    hipLaunchKernelGGL(k_mega, g, b, LDS_BYTES, stream, a);
#else
    hipLaunchKernelGGL(k_prologue, g, b, LDS_BYTES, stream, a);
    hipLaunchKernelGGL(k_gemm_kv, g, b, LDS_BYTES, stream, a);
    for (int l = 0; l < DEPTH; ++l) {
        a.layer = l; a.chunk = 0;
        hipLaunchKernelGGL(k_convert, g, b, LDS_BYTES, stream, a);
        hipLaunchKernelGGL(k_gemm_in, g, b, LDS_BYTES, stream, a);
        hipLaunchKernelGGL(k_mixers, g, b, LDS_BYTES, stream, a);
        hipLaunchKernelGGL(k_gemm_out, g, b, LDS_BYTES, stream, a);
        hipLaunchKernelGGL(k_ln1_router, g, b, LDS_BYTES, stream, a);
        hipLaunchKernelGGL(k_scatter, g, b, LDS_BYTES, stream, a);
        hipLaunchKernelGGL(k_gemm_gu, g, b, LDS_BYTES, stream, a);
        for (int c = 0; c < NCH; ++c) { a.chunk = c;
            hipLaunchKernelGGL(k_gemm_dn, g, b, LDS_BYTES, stream, a);
            hipLaunchKernelGGL(k_combine, g, b, LDS_BYTES, stream, a); }
    }
#endif
}
```

```cpp
#include <hip/hip_runtime.h>
#include <cstdio>
#include <cstdint>

#ifndef MK_ONE_LAUNCH
#define MK_ONE_LAUNCH 1
#endif
#ifndef PROBE_SUB
#define PROBE_SUB 0
#endif
#ifndef PROBE_DUP
#define PROBE_DUP 0
#endif

#define LAS __attribute__((address_space(3)))
typedef unsigned short bf16;
typedef short bf16x8 __attribute__((ext_vector_type(8)));
typedef float f32x4 __attribute__((ext_vector_type(4)));
typedef float f32x2 __attribute__((ext_vector_type(2)));
typedef unsigned u32x4 __attribute__((ext_vector_type(4)));
typedef unsigned u32x2 __attribute__((ext_vector_type(2)));

constexpr int D = 1024, NBATCH = 16, SEQ = 4096, T = NBATCH * SEQ, DEPTH = 4;
constexpr int MEMT = 256, MROWS = NBATCH * MEMT;
constexpr int NPROJ = 1280, POOL_CH = 256, CONV_CH = 256, MEM_CH = 512, HEADS = 4, HD = 128;
constexpr int NE = 64, TOPK = 8, EH = 256;
constexpr int NCH = 2, CH_TOK = T / NCH, CH_SLOTS = CH_TOK * TOPK + NE * 256, CH_TILES_MAX = CH_SLOTS / 256;
constexpr int TBLK = 256, NTB = T / TBLK, TB_PER_CH = NTB / NCH;
constexpr int SH_ROW0 = NCH * CH_SLOTS;
constexpr float LN_EPS = 1e-5f;
constexpr float ALPHA = 1.6817928305074290f;
constexpr float ROUTED_SCALE = 2.5f;

constexpr size_t MiB = 1u << 20;
constexpr size_t WS_CTL = 0;
constexpr size_t CTL_BYTES = 1 * MiB;
constexpr size_t WS_TAB = WS_CTL + CTL_BYTES;
constexpr size_t TAB_HIST = WS_TAB, TAB_NT = WS_TAB + 65536, TAB_TE = WS_TAB + 65536 + 256;
constexpr size_t WS_TOK = WS_TAB + 1 * MiB;
constexpr size_t TOK_E = WS_TOK, TOK_G = WS_TOK + 2 * MiB, TOK_R = WS_TOK + 4 * MiB, TOK_SLOT = WS_TOK + 6 * MiB;
constexpr size_t WS_ROW = WS_TOK + 8 * MiB;
constexpr size_t ROW_TOK = WS_ROW, ROW_GATE = WS_ROW + 2560 * 1024;
constexpr size_t WS_SMALLW = WS_ROW + 5 * MiB;
constexpr size_t W_RT = WS_SMALLW, W_PT = WS_SMALLW + 131072, W_DWT = WS_SMALLW + 196608, W_RTL = WS_SMALLW + 262144;
constexpr size_t WS_WIN = WS_SMALLW + 1 * MiB;
constexpr size_t WS_WOUT = WS_WIN + (size_t)NPROJ * D * 2;
constexpr size_t WS_WGU = WS_WOUT + (size_t)D * D * 2;
constexpr size_t WS_WD = WS_WGU + (size_t)NE * 512 * D * 2;
constexpr size_t WS_WSGU = WS_WD + (size_t)NE * D * EH * 2;
constexpr size_t WS_WSD = WS_WSGU + (size_t)512 * D * 2;
constexpr size_t WS_WKV = WS_WSD + (size_t)D * EH * 2;
constexpr size_t WS_MEMN = WS_WKV + (size_t)DEPTH * D * D * 2;
constexpr size_t WS_MEMP = WS_MEMN + (size_t)MROWS * D * 2;
constexpr size_t WS_KB = WS_MEMP + (size_t)MROWS * D * 2;
constexpr size_t WS_VT = WS_KB + (size_t)DEPTH * MROWS * MEM_CH * 2;
constexpr size_t WS_XB = WS_VT + (size_t)DEPTH * MROWS * MEM_CH * 2;
constexpr size_t WS_ZB = WS_XB + (size_t)T * D * 2;
constexpr size_t WS_U = WS_ZB + (size_t)T * D * 2;
constexpr size_t U_PROJ = WS_U, U_CAT = WS_U + (size_t)T * NPROJ * 2, U_H = WS_U;
constexpr size_t U_BYTES = (size_t)(NCH * CH_SLOTS + T) * EH * 2;
static_assert(U_BYTES >= (size_t)T * NPROJ * 2 + (size_t)T * D * 2, "union region");
constexpr size_t WS_Y = WS_U + U_BYTES;
constexpr size_t WS_END = WS_Y + (size_t)CH_SLOTS * D;
constexpr float Y_SCALE = 32.0f, Y_INV = 1.0f / 32.0f, Y_CLAMP = 240.0f;

constexpr int LDS_STAGE = 0, STAGE_BYTES = 131072;
constexpr int MAXU = 24;
constexpr int LDS_TBL = STAGE_BYTES, LDS_CTLW = LDS_TBL + MAXU * 1024, LDS_BYTES = LDS_CTLW + 1024;
constexpr int NTHREADS = 512, NWAVES = 8;

__device__ __forceinline__ unsigned cvt_pk_bf16(float lo, float hi) { unsigned r; asm volatile("v_cvt_pk_bf16_f32 %0, %1, %2" : "=v"(r) : "v"(lo), "v"(hi)); return r; }
__device__ __forceinline__ float bf2f(unsigned h) { return __uint_as_float(h << 16); }
template <int M> __device__ __forceinline__ float swz_xor(float v) { return __int_as_float(__builtin_amdgcn_ds_swizzle(__float_as_int(v), (M << 10) | 0x1f)); }
__device__ __forceinline__ float bperm_f(int srclane, float v) { return __int_as_float(__builtin_amdgcn_ds_bpermute(srclane << 2, __float_as_int(v))); }
__device__ __forceinline__ int bperm_i(int srclane, int v) { return __builtin_amdgcn_ds_bpermute(srclane << 2, v); }
__device__ __forceinline__ float dpp_f(float v, const int ctrl_sel) {
    const int x = __float_as_int(v);
    int r;
    if (ctrl_sel == 0) r = __builtin_amdgcn_update_dpp(x, x, 0xB1, 0xf, 0xf, false);
    else if (ctrl_sel == 1) r = __builtin_amdgcn_update_dpp(x, x, 0x4E, 0xf, 0xf, false);
    else if (ctrl_sel == 2) r = __builtin_amdgcn_update_dpp(x, x, 0x141, 0xf, 0xf, false);
    else r = __builtin_amdgcn_update_dpp(x, x, 0x140, 0xf, 0xf, false);
    return __int_as_float(r);
}
__device__ __forceinline__ float rl_f(float v, int l) { return __int_as_float(__builtin_amdgcn_readlane(__float_as_int(v), l)); }
__device__ __forceinline__ float wave_sum(float v, int lane) {
    (void)lane;
    v += dpp_f(v, 0); v += dpp_f(v, 1); v += dpp_f(v, 2); v += dpp_f(v, 3);
    return (rl_f(v, 0) + rl_f(v, 16)) + (rl_f(v, 32) + rl_f(v, 48));
}
__device__ __forceinline__ float wave_max(float v, int lane) {
    (void)lane;
    v = fmaxf(v, dpp_f(v, 0)); v = fmaxf(v, dpp_f(v, 1)); v = fmaxf(v, dpp_f(v, 2)); v = fmaxf(v, dpp_f(v, 3));
    return fmaxf(fmaxf(rl_f(v, 0), rl_f(v, 16)), fmaxf(rl_f(v, 32), rl_f(v, 48)));
}
__device__ __forceinline__ float fast_sigmoid(float x) { return __builtin_amdgcn_rcpf(1.0f + __builtin_amdgcn_exp2f(-1.4426950408889634f * x)); }
__device__ __forceinline__ float fast_silu(float x) { return x * fast_sigmoid(x); }
#define LDS_WAIT() asm volatile("s_waitcnt lgkmcnt(0)" ::: "memory")
__device__ __forceinline__ void unpack8(const u32x4 w, float* f) { f[0] = bf2f(w.x & 0xffffu); f[1] = bf2f(w.x >> 16); f[2] = bf2f(w.y & 0xffffu); f[3] = bf2f(w.y >> 16); f[4] = bf2f(w.z & 0xffffu); f[5] = bf2f(w.z >> 16); f[6] = bf2f(w.w & 0xffffu); f[7] = bf2f(w.w >> 16); }
__device__ __forceinline__ void addpack8(const u32x4 w, float* f) { f[0] += bf2f(w.x & 0xffffu); f[1] += bf2f(w.x >> 16); f[2] += bf2f(w.y & 0xffffu); f[3] += bf2f(w.y >> 16); f[4] += bf2f(w.z & 0xffffu); f[5] += bf2f(w.z >> 16); f[6] += bf2f(w.w & 0xffffu); f[7] += bf2f(w.w >> 16); }
__device__ __forceinline__ u32x4 pack8(const float* f) { u32x4 w; w.x = cvt_pk_bf16(f[0], f[1]); w.y = cvt_pk_bf16(f[2], f[3]); w.z = cvt_pk_bf16(f[4], f[5]); w.w = cvt_pk_bf16(f[6], f[7]); return w; }
__device__ __forceinline__ void ln_row16(float* v, const float* g, const float* b, int lane) {
    float s = 0.f;
#pragma unroll
    for (int i = 0; i < 16; ++i) s += v[i];
    const float mean = wave_sum(s, lane) * (1.f / D); float s2 = 0.f;
#pragma unroll
    for (int i = 0; i < 16; ++i) { v[i] -= mean; s2 += v[i] * v[i]; }
    const float rstd = 1.f / sqrtf(wave_sum(s2, lane) * (1.f / D) + LN_EPS);
#pragma unroll
    for (int j = 0; j < 2; ++j) { const f32x4 g0 = *(const f32x4*)(g + 8 * lane + 512 * j), g1 = *(const f32x4*)(g + 8 * lane + 512 * j + 4), b0 = *(const f32x4*)(b + 8 * lane + 512 * j), b1 = *(const f32x4*)(b + 8 * lane + 512 * j + 4);
#pragma unroll
        for (int i = 0; i < 4; ++i) { v[8 * j + i] = v[8 * j + i] * rstd * g0[i] + b0[i]; v[8 * j + 4 + i] = v[8 * j + 4 + i] * rstd * g1[i] + b1[i]; } }
}
#define RSRC_W3 0x00020000
__device__ __forceinline__ bf16x8 bufld8(__amdgpu_buffer_rsrc_t rs, unsigned voff, unsigned soff) { const u32x4 v = __builtin_amdgcn_raw_buffer_load_b128(rs, (int)voff, (int)soff, 0); return __builtin_bit_cast(bf16x8, v); }

#define XB_TMO      128
#define XB_XCNT(j)  (256  + 64 * (j))
#define XB_XSUB(j)  (1280 + 64 * (j))
#define XB_XGEN(j)  (2304 + 64 * (j))
#define XB_TOP      3328
#define XB_TOPGEN   3392
#define XCD_BAR_WORDS 3456
#define XB_SPIN_CAP (1u << 18)
__device__ __forceinline__ unsigned xb_ld(unsigned* p)              { return __hip_atomic_load(p, __ATOMIC_RELAXED, __HIP_MEMORY_SCOPE_AGENT); }
__device__ __forceinline__ unsigned xb_add(unsigned* p, unsigned v) { return __hip_atomic_fetch_add(p, v, __ATOMIC_RELAXED, __HIP_MEMORY_SCOPE_AGENT); }
__device__ __forceinline__ unsigned xb_xcc_id() { return (unsigned)__builtin_amdgcn_s_getreg((3 << 11) | 20) & 0xFu; }
#define XB_SPIN(cond, bar) do { unsigned _sp = 0; while (cond) { __builtin_amdgcn_s_sleep(1); \
    if ((++_sp & 255u) == 0u) { if (xb_ld(&(bar)[XB_TMO])) break; if (_sp > XB_SPIN_CAP) { atomicAdd(&(bar)[XB_TMO], 1u); break; } } } } while (0)
struct XcdBarrier { unsigned* bar; unsigned x; volatile LAS unsigned* st; };
__device__ __forceinline__ XcdBarrier xcd_barrier_post(unsigned* bar, volatile LAS unsigned* st, int tid) {
    XcdBarrier b; b.bar = bar; b.x = xb_xcc_id(); b.st = st;
    if (tid == 0) (void)xb_add(&bar[XB_XCNT(b.x)], 1u);
    return b;
}
__device__ __forceinline__ void xcd_barrier_complete(unsigned* bar, unsigned x, unsigned& nloc, unsigned& nx) {
    const unsigned G = gridDim.x * gridDim.y * gridDim.z;
    unsigned sum, cnt, mine, sp = 0u;
    for (;;) {
        sum = 0u; cnt = 0u; mine = 0u;
#pragma unroll
        for (unsigned j = 0; j < 16; ++j) { const unsigned c = xb_ld(&bar[XB_XCNT(j)]); sum += c; cnt += (c > 0u) ? 1u : 0u; mine = (j == x) ? c : mine; }
        if (sum == G) break;
        __builtin_amdgcn_s_sleep(1);
        if ((++sp & 255u) == 0u) { if (xb_ld(&bar[XB_TMO])) break; if (sp > XB_SPIN_CAP) { atomicAdd(&bar[XB_TMO], 1u); break; } }
    }
    nloc = mine > 0u ? mine : 1u; nx = cnt > 0u ? cnt : 1u;
}
__device__ __forceinline__ void xcd_barrier(const XcdBarrier& b, int tid) {
    asm volatile("s_waitcnt vmcnt(0)" ::: "memory");
    __syncthreads();
    if (tid == 0) {
        unsigned* bar = b.bar;
        __builtin_amdgcn_s_waitcnt(0);
        unsigned nloc = b.st[0], nx = b.st[1];
        if (nloc == 0u) { xcd_barrier_complete(bar, b.x, nloc, nx); b.st[0] = nloc; b.st[1] = nx; }
        const unsigned old = xb_add(&bar[XB_XSUB(b.x)], 1u);
        const unsigned gen = old / nloc;
        if (old + 1u == (gen + 1u) * nloc) {
            __builtin_amdgcn_fence(__ATOMIC_RELEASE, "agent");
            asm volatile("s_waitcnt vmcnt(0)" ::: "memory");
            const unsigned og = xb_add(&bar[XB_TOP], 1u);
            const unsigned tg = og / nx;
            if (og + 1u == (tg + 1u) * nx) xb_add(&bar[XB_TOPGEN], 1u);
            else XB_SPIN(xb_ld(&bar[XB_TOPGEN]) == tg, bar);
            __builtin_amdgcn_fence(__ATOMIC_ACQUIRE, "agent");
            xb_add(&bar[XB_XGEN(b.x)], 1u);
            asm volatile("s_waitcnt vmcnt(0)" ::: "memory");
        } else {
            XB_SPIN(xb_ld(&bar[XB_XGEN(b.x)]) == gen, bar);
            __builtin_amdgcn_fence(__ATOMIC_ACQUIRE, "agent");
            asm volatile("s_waitcnt vmcnt(0)" ::: "memory");
        }
    }
    __syncthreads();
}

__device__ __forceinline__ void grid_bar(const XcdBarrier& b0, int wave_s) {
    unsigned* bp = b0.bar; unsigned x = b0.x; unsigned st = (unsigned)(uintptr_t)b0.st;
    asm volatile("" : "+s"(bp), "+s"(x), "+s"(st));
    XcdBarrier b; b.bar = bp; b.x = x; b.st = (volatile LAS unsigned*)(uintptr_t)st;
    int z = 0; asm volatile("" : "+v"(z)); const int tid = (wave_s << 6) | (int)__builtin_amdgcn_mbcnt_hi(~0u, __builtin_amdgcn_mbcnt_lo(~0u, (unsigned)z));
    xcd_barrier(b, tid);
}

namespace ge {
constexpr int BM = 256, BK = 64, HALF = 128, HTB = HALF * BK * 2, NXCD = 8, WGM = 8;
__device__ __forceinline__ int lds_byte(int r, int c) { const int st = (r >> 4) * 2 + (c >> 5), rr = r & 15, cc = c & 31, ob = rr * 64 + cc * 2; return st * 1024 + (ob ^ (((ob >> 9) & 1) << 5)); }
__device__ __forceinline__ void stage_rc(int b, int& R, int& C) { const int st = b / 1024, sb = b % 1024, swz = sb ^ (((sb >> 9) & 1) << 5); R = (st >> 1) * 16 + swz / 64; C = (st & 1) * 32 + (swz % 64) / 2; }
__device__ __forceinline__ int perm32(int rho) { const int n = rho >> 4, i = rho & 15; return 8 * (i >> 2) + 4 * n + (i & 3); }
__device__ __forceinline__ int xcd_remap(int L, int n) { const int q = n / NXCD, r = n % NXCD, xcd = L % NXCD, off = L / NXCD; return (xcd < r ? xcd * (q + 1) : r * (q + 1) + (xcd - r) * q) + off; }

struct Unit {
    const char* A;
    const char* B;
    char* O;
    int ldc, row0, col0, aux, tbl;
};

template <int K, bool GATHER, class Epi, class Sched>
__device__ __forceinline__ void gemm_phase(const int tid, LAS unsigned char* lds, const LAS int* tbl, const Sched& S, const Epi& E) {
    const int wid = __builtin_amdgcn_readfirstlane(tid >> 6), lane = tid & 63, wr = wid >> 2, wc = wid & 3, fr = lane & 15, fq = lane >> 4;
    constexpr int nt = K / BK;
    static_assert(K % 128 == 0 && K >= 256, "K");
    int Rr[2], Cc[2]; unsigned voffB[2];
#pragma unroll
    for (int i = 0; i < 2; ++i) { int R, C; stage_rc(tid * 16 + i * 8192, R, C); const int Rb = (R & ~31) + perm32(R & 31); Rr[i] = R; Cc[i] = C; voffB[i] = (unsigned)(Rb * K + C) * 2u; }
    constexpr size_t kstep = (size_t)(BK * 2);
    constexpr size_t hstep = (size_t)HALF * K * 2;
    const unsigned ldsw = (unsigned)wid * 1024u;
    const int aoff = lds_byte(wr * 64 + fr, fq * 8), boff = lds_byte(wc * 32 + fr, fq * 8);
#define GE_SA(b, h) (((b) * 2 + (h)) * HTB)
#define GE_SB(b, h) ((4 + (b) * 2 + (h)) * HTB)
#define GE_STAGE_B(bufoff, gbase) do { _Pragma("unroll") for (int _i = 0; _i < 2; ++_i) \
        __builtin_amdgcn_global_load_lds((const unsigned*)((const char*)(gbase) + voffB[_i]), (LAS unsigned*)(lds + (bufoff) + ldsw + _i * 8192), 16, 0, 0); } while (0)
#define GE_STAGE_A(bufoff, gbase, o0, o1) do { \
        __builtin_amdgcn_global_load_lds((const unsigned*)((const char*)(gbase) + (o0)), (LAS unsigned*)(lds + (bufoff) + ldsw), 16, 0, 0); \
        __builtin_amdgcn_global_load_lds((const unsigned*)((const char*)(gbase) + (o1)), (LAS unsigned*)(lds + (bufoff) + ldsw + 8192), 16, 0, 0); } while (0)
#define GE_LDA(dst, b, h) do { _Pragma("unroll") for (int m = 0; m < 4; ++m) _Pragma("unroll") for (int k = 0; k < 2; ++k) dst[m][k] = *(const LAS bf16x8*)(lds + GE_SA(b, h) + aoff + m * 2048 + k * 1024); } while (0)
#define GE_LDB(dst, b, h) do { _Pragma("unroll") for (int n = 0; n < 2; ++n) _Pragma("unroll") for (int k = 0; k < 2; ++k) dst[n][k] = *(const LAS bf16x8*)(lds + GE_SB(b, h) + boff + n * 2048 + k * 1024); } while (0)
#define GE_MMA(ai, bj, At, Bt) do { __builtin_amdgcn_s_setprio(1); _Pragma("unroll") for (int m = 0; m < 4; ++m) _Pragma("unroll") for (int n = 0; n < 2; ++n) _Pragma("unroll") for (int k = 0; k < 2; ++k) \
        acc[ai][bj][m][n] = __builtin_amdgcn_mfma_f32_16x16x32_bf16(Bt[n][k], At[m][k], acc[ai][bj][m][n], 0, 0, 0); __builtin_amdgcn_s_setprio(0); } while (0)
#define GE_WAIT_V(n) asm volatile("s_waitcnt vmcnt(" #n ")" ::: "memory")
#define GE_WAIT_L(n) asm volatile("s_waitcnt lgkmcnt(" #n ")" ::: "memory")
#define GE_BAR __builtin_amdgcn_s_barrier()
#define GE_SCHED __builtin_amdgcn_sched_barrier(0)
#define GE_LOAD_VA(dst, u) do { _Pragma("unroll") for (int _h = 0; _h < 2; ++_h) _Pragma("unroll") for (int _i = 0; _i < 2; ++_i) { \
        if constexpr (GATHER) dst[_h][_i] = (unsigned)tbl[(u).tbl * 256 + _h * 128 + Rr[_i]] * (unsigned)(K * 2) + (unsigned)(Cc[_i] * 2); \
        else dst[_h][_i] = (unsigned)((_h * 128 + Rr[_i]) * K + Cc[_i]) * 2u; } } while (0)
    Unit cur, nxt; int ui = 0;
    if (!S.next(0, cur)) return;
    f32x4 acc[2][2][4][2];
#pragma unroll
    for (int a = 0; a < 2; ++a)
#pragma unroll
        for (int b = 0; b < 2; ++b)
#pragma unroll
            for (int m = 0; m < 4; ++m)
#pragma unroll
                for (int n = 0; n < 2; ++n) acc[a][b][m][n] = (f32x4){0.f, 0.f, 0.f, 0.f};
    bf16x8 At[4][2], B0[2][2], B1[2][2];
    unsigned va[2][2], vn[2][2];
    GE_LOAD_VA(va, cur);
#pragma unroll
    for (int h = 0; h < 2; ++h)
#pragma unroll
        for (int i = 0; i < 2; ++i) vn[h][i] = va[h][i];
    const char* cA = cur.A; const char* cB = cur.B;
    GE_STAGE_B(GE_SB(0, 0), cB); GE_STAGE_B(GE_SB(0, 1), cB + hstep); GE_STAGE_A(GE_SA(0, 0), cA, va[0][0], va[0][1]); GE_STAGE_A(GE_SA(0, 1), cA, va[1][0], va[1][1]);
    if (wr == 1) GE_BAR;
    GE_WAIT_V(2); GE_BAR;
    GE_STAGE_B(GE_SB(1, 0), cB + kstep); GE_STAGE_A(GE_SA(1, 0), cA + kstep, va[0][0], va[0][1]); GE_STAGE_B(GE_SB(1, 1), cB + hstep + kstep);
    GE_WAIT_V(6); GE_BAR;
    for (;;) {
        const bool has_next = S.next(ui + 1, nxt);
        const char* nA = has_next ? nxt.A : cA; const char* nB = has_next ? nxt.B : cB;
        for (int t = 0; t < nt; t += 2) {
            const bool last = (t == nt - 2);
            if (last && has_next) { GE_LOAD_VA(vn, nxt); }
            const char* a1 = cA + (size_t)(t + 1) * kstep;
            const char* a2 = last ? nA : cA + (size_t)(t + 2) * kstep; const char* b2 = last ? nB : cB + (size_t)(t + 2) * kstep;
            const char* a3 = a2 + kstep; const char* b3 = b2 + kstep;
            const unsigned x00 = last ? vn[0][0] : va[0][0], x01 = last ? vn[0][1] : va[0][1], x10 = last ? vn[1][0] : va[1][0], x11 = last ? vn[1][1] : va[1][1];
            GE_LDB(B0, 0, 0); GE_LDB(B1, 0, 1); GE_SCHED; GE_LDA(At, 0, 0); GE_STAGE_A(GE_SA(1, 1), a1, va[1][0], va[1][1]);
            GE_WAIT_V(8); GE_WAIT_L(0); GE_BAR; GE_MMA(0, 0, At, B0); GE_MMA(0, 1, At, B1); GE_BAR; GE_SCHED;
            GE_LDA(At, 0, 1); GE_STAGE_B(GE_SB(0, 0), b2); GE_STAGE_B(GE_SB(0, 1), b2 + hstep); GE_STAGE_A(GE_SA(0, 0), a2, x00, x01);
            GE_WAIT_V(8); GE_WAIT_L(0); GE_BAR; GE_MMA(1, 0, At, B0); GE_MMA(1, 1, At, B1); GE_BAR; GE_SCHED;
            GE_LDB(B0, 1, 0); GE_LDB(B1, 1, 1); GE_SCHED; GE_LDA(At, 1, 0); GE_STAGE_A(GE_SA(0, 1), a2, x10, x11);
            GE_WAIT_V(8); GE_WAIT_L(0); GE_BAR; GE_MMA(0, 0, At, B0); GE_MMA(0, 1, At, B1); GE_BAR; GE_SCHED;
            GE_LDA(At, 1, 1); GE_STAGE_B(GE_SB(1, 0), b3); GE_STAGE_B(GE_SB(1, 1), b3 + hstep); GE_STAGE_A(GE_SA(1, 0), a3, x00, x01);
            GE_WAIT_V(8); GE_WAIT_L(0); GE_BAR; GE_MMA(1, 0, At, B0); GE_MMA(1, 1, At, B1); GE_BAR; GE_SCHED;
        }
        if (wr == 0) GE_BAR;
        E(acc, cur, wr, wc, fr, fq);
        if (!has_next) break;
#pragma unroll
        for (int a = 0; a < 2; ++a)
#pragma unroll
            for (int b = 0; b < 2; ++b)
#pragma unroll
                for (int m = 0; m < 4; ++m)
#pragma unroll
                    for (int n = 0; n < 2; ++n) acc[a][b][m][n] = (f32x4){0.f, 0.f, 0.f, 0.f};
        cur = nxt; cA = nA; cB = nB; ++ui;
#pragma unroll
        for (int h = 0; h < 2; ++h)
#pragma unroll
            for (int i = 0; i < 2; ++i) va[h][i] = vn[h][i];
        if (wr == 1) GE_BAR;
    }
    GE_WAIT_V(0);
    GE_BAR;
#undef GE_SA
#undef GE_SB
#undef GE_STAGE_A
#undef GE_STAGE_B
#undef GE_LDA
#undef GE_LDB
#undef GE_MMA
#undef GE_WAIT_V
#undef GE_WAIT_L
#undef GE_BAR
#undef GE_SCHED
#undef GE_LOAD_VA
}

struct EpiBf16 {
    __device__ __forceinline__ void operator()(const f32x4 (&acc)[2][2][4][2], const Unit& u, int wr, int wc, int fr, int fq) const {
        asm volatile("" : "+v"(fr), "+v"(fq));
#pragma unroll
        for (int ai = 0; ai < 2; ++ai)
#pragma unroll
            for (int m = 0; m < 4; ++m) { bf16* rowp = (bf16*)u.O + (size_t)(u.row0 + ai * HALF + wr * 64 + m * 16 + fr) * u.ldc + u.col0 + wc * 32 + 8 * fq;
#pragma unroll
                for (int bj = 0; bj < 2; ++bj) { const f32x4 v0 = acc[ai][bj][m][0], v1 = acc[ai][bj][m][1];
                    u32x4 w; w.x = cvt_pk_bf16(v0[0], v0[1]); w.y = cvt_pk_bf16(v0[2], v0[3]); w.z = cvt_pk_bf16(v1[0], v1[1]); w.w = cvt_pk_bf16(v1[2], v1[3]);
                    *(u32x4*)(rowp + bj * HALF) = w; } }
    }
};
__device__ __forceinline__ u32x4 res_pack(const u32x4 r, const f32x4 a0, const f32x4 a1) {
    u32x4 w;
    w.x = cvt_pk_bf16(bf2f(r.x & 0xffffu) * ALPHA + a0[0], bf2f(r.x >> 16) * ALPHA + a0[1]); w.y = cvt_pk_bf16(bf2f(r.y & 0xffffu) * ALPHA + a0[2], bf2f(r.y >> 16) * ALPHA + a0[3]);
    w.z = cvt_pk_bf16(bf2f(r.z & 0xffffu) * ALPHA + a1[0], bf2f(r.z >> 16) * ALPHA + a1[1]); w.w = cvt_pk_bf16(bf2f(r.w & 0xffffu) * ALPHA + a1[2], bf2f(r.w >> 16) * ALPHA + a1[3]);
    return w;
}
struct EpiResBf16 {
    const bf16* res; bf16* out;
    __device__ __forceinline__ void operator()(const f32x4 (&acc)[2][2][4][2], const Unit& u, int wr, int wc, int fr, int fq) const {
        asm volatile("" : "+v"(fr), "+v"(fq));
#pragma unroll
        for (int ai = 0; ai < 2; ++ai) {
            u32x4 r[4][2];
#pragma unroll
            for (int m = 0; m < 4; ++m)
#pragma unroll
                for (int bj = 0; bj < 2; ++bj) r[m][bj] = *(const u32x4*)(res + (size_t)(u.row0 + ai * HALF + wr * 64 + m * 16 + fr) * D + u.col0 + wc * 32 + 8 * fq + bj * HALF);
#pragma unroll
            for (int m = 0; m < 4; ++m)
#pragma unroll
                for (int bj = 0; bj < 2; ++bj) *(u32x4*)(out + (size_t)(u.row0 + ai * HALF + wr * 64 + m * 16 + fr) * D + u.col0 + wc * 32 + 8 * fq + bj * HALF) = res_pack(r[m][bj], acc[ai][bj][m][0], acc[ai][bj][m][1]);
            asm volatile("" ::: "memory"); }
    }
};
struct EpiSwiGLU {
    __device__ __forceinline__ void operator()(const f32x4 (&acc)[2][2][4][2], const Unit& u, int wr, int wc, int fr, int fq) const {
        asm volatile("" : "+v"(fr), "+v"(fq));
#pragma unroll
        for (int ai = 0; ai < 2; ++ai)
#pragma unroll
            for (int m = 0; m < 4; ++m) { bf16* rowp = (bf16*)u.O + (size_t)(u.row0 + ai * HALF + wr * 64 + m * 16 + fr) * EH + u.col0 + wc * 32 + 8 * fq;
                const f32x4 g0 = acc[ai][0][m][0], g1 = acc[ai][0][m][1], u0 = acc[ai][1][m][0], u1 = acc[ai][1][m][1];
                float v[8];
#pragma unroll
                for (int j = 0; j < 4; ++j) { v[j] = fast_silu(g0[j]) * u0[j]; v[4 + j] = fast_silu(g1[j]) * u1[j]; }
                u32x4 w; w.x = cvt_pk_bf16(v[0], v[1]); w.y = cvt_pk_bf16(v[2], v[3]); w.z = cvt_pk_bf16(v[4], v[5]); w.w = cvt_pk_bf16(v[6], v[7]);
                *(u32x4*)rowp = w; }
    }
};
struct EpiDown {
    const float* gate; const bf16* res;
    __device__ __forceinline__ void operator()(const f32x4 (&acc)[2][2][4][2], const Unit& u, int wr, int wc, int fr, int fq) const {
        asm volatile("" : "+v"(fr), "+v"(fq));
        if (u.aux >= 0) {
            const __amdgpu_buffer_rsrc_t gr = __builtin_amdgcn_make_buffer_rsrc((void*)(gate + u.aux), (short)0, 256 * 4, RSRC_W3);
#pragma unroll
            for (int ai = 0; ai < 2; ++ai)
#pragma unroll
                for (int m = 0; m < 4; ++m) { const int r = ai * HALF + wr * 64 + m * 16 + fr; const float g = __builtin_bit_cast(float, __builtin_amdgcn_raw_buffer_load_b32(gr, r * 4, 0, 0));
                    unsigned char* rowp = (unsigned char*)u.O + (size_t)(u.row0 + r) * D + u.col0 + wc * 32 + 8 * fq;
                    const float gs = g * Y_SCALE;
#pragma unroll
                    for (int bj = 0; bj < 2; ++bj) { f32x4 v0 = acc[ai][bj][m][0] * gs, v1 = acc[ai][bj][m][1] * gs;
#pragma unroll
                        for (int j = 0; j < 4; ++j) { v0[j] = fminf(fmaxf(v0[j], -Y_CLAMP), Y_CLAMP); v1[j] = fminf(fmaxf(v1[j], -Y_CLAMP), Y_CLAMP); }
                        int w0 = 0, w1 = 0;
                        w0 = __builtin_amdgcn_cvt_pk_fp8_f32(v0[0], v0[1], w0, false); w0 = __builtin_amdgcn_cvt_pk_fp8_f32(v0[2], v0[3], w0, true);
                        w1 = __builtin_amdgcn_cvt_pk_fp8_f32(v1[0], v1[1], w1, false); w1 = __builtin_amdgcn_cvt_pk_fp8_f32(v1[2], v1[3], w1, true);
                        u32x2 w; w.x = (unsigned)w0; w.y = (unsigned)w1;
                        *(u32x2*)(rowp + bj * HALF) = w; } }
        } else {
            bf16* out = (bf16*)u.O;
#pragma unroll
            for (int ai = 0; ai < 2; ++ai) {
                u32x4 r[4][2];
#pragma unroll
                for (int m = 0; m < 4; ++m)
#pragma unroll
                    for (int bj = 0; bj < 2; ++bj) r[m][bj] = *(const u32x4*)(res + (size_t)(u.row0 + ai * HALF + wr * 64 + m * 16 + fr) * D + u.col0 + wc * 32 + 8 * fq + bj * HALF);
#pragma unroll
                for (int m = 0; m < 4; ++m)
#pragma unroll
                    for (int bj = 0; bj < 2; ++bj) *(u32x4*)(out + (size_t)(u.row0 + ai * HALF + wr * 64 + m * 16 + fr) * D + u.col0 + wc * 32 + 8 * fq + bj * HALF) = res_pack(r[m][bj], acc[ai][bj][m][0], acc[ai][bj][m][1]);
                asm volatile("" ::: "memory"); }
        }
    }
};

template <int K> struct SchedDense {
    const char* A; const char* B; char* O; int ldc, nM, nN, G, c;
    __device__ __forceinline__ bool next(int i, Unit& u) const {
        const int nwg = nM * nN; const long L = (long)i * G + c; if (L >= nwg) return false;
        const int wgid = xcd_remap((int)L, nwg);
        const int nig = WGM * nN, gid = wgid / nig, fm = gid * WGM, gsz = (nM - fm) < WGM ? (nM - fm) : WGM;
        const int pm = fm + ((wgid % nig) % gsz), pn = (wgid % nig) / gsz;
        u.A = A + (size_t)pm * (256 * K * 2); u.B = B + (size_t)pn * (256 * K * 2); u.O = O; u.ldc = ldc; u.row0 = pm * 256; u.col0 = pn * 256; u.aux = 0; u.tbl = 0; return true;
    }
};
struct SchedKV {
    const char* memn; const char* memp; const char* wkv; char* kb; char* vt; int G, c;
    __device__ __forceinline__ bool next(int i, Unit& u) const {
        const long L = (long)i * G + c; if (L >= 256) return false;
        const int idx = (int)L, l = idx >> 6, r = idx & 63; u.aux = 0; u.tbl = 0;
        const char* w = wkv + (size_t)l * D * D * 2;
        if (r < 32) { const int pm = r >> 1, pn = r & 1;
            u.A = memn + (size_t)pm * 256 * D * 2; u.B = w + (size_t)pn * 256 * D * 2; u.O = kb + (size_t)l * MROWS * MEM_CH * 2; u.ldc = MEM_CH; u.row0 = pm * 256; u.col0 = pn * 256; }
        else { const int q = r - 32, pm = q >> 4, pn = q & 15;
            u.A = w + (size_t)(512 + pm * 256) * D * 2; u.B = memp + (size_t)pn * 256 * D * 2; u.O = vt + (size_t)l * MROWS * MEM_CH * 2; u.ldc = MROWS; u.row0 = pm * 256; u.col0 = pn * 256; }
        return true;
    }
};
struct SchedGU {
    const char* xb; const char* wgu; const char* wsgu; char* h; const int* ntiles; const int* tile_e; int G, c;
    int nt_[NCH];
    __device__ __forceinline__ void init() {
#pragma unroll
        for (int q = 0; q < NCH; ++q) nt_[q] = ntiles[q]; }
    __device__ __forceinline__ bool next(int i, Unit& u) const {
        int ntot = T / 256;
#pragma unroll
        for (int q = 0; q < NCH; ++q) ntot += nt_[q];
        const int nun = ntot * 2; const long L = (long)i * G + c; if (L >= nun || i >= MAXU) return false;
        const int idx = xcd_remap((int)L, nun), pn = idx & 1; int rt = idx >> 1;
        u.A = xb; u.O = h; u.ldc = EH; u.col0 = pn * 128; u.tbl = i;
        int ch = -1, lt = 0;
#pragma unroll
        for (int q = 0; q < NCH; ++q) { if (ch < 0) { if (rt < nt_[q]) { ch = q; lt = rt; } else rt -= nt_[q]; } }
        if (ch >= 0) { const int e = tile_e[ch * CH_TILES_MAX + lt]; u.B = wgu + (size_t)e * 512 * D * 2 + (size_t)pn * 256 * D * 2; u.row0 = ch * CH_SLOTS + lt * 256; u.aux = -1; }
        else { u.B = wsgu + (size_t)pn * 256 * D * 2; u.row0 = SH_ROW0 + rt * 256; u.aux = rt * 256; }
        return true;
    }
};
struct SchedDN {
    const char* h; const char* wd; const char* wsd; char* y; char* dout; const int* tile_e; int ch, nt, G, c;
    __device__ __forceinline__ bool next(int i, Unit& u) const {
        const int nun = (CH_TOK / 256 + nt) * 4; const long L = (long)i * G + c; if (L >= nun) return false;
        const int idx = xcd_remap((int)L, nun), pn = idx & 3; int rt = idx >> 2; u.tbl = 0; u.ldc = D; u.col0 = pn * 256;
        if (rt < CH_TOK / 256) { const int row = ch * CH_TOK + rt * 256; u.A = h + (size_t)(SH_ROW0 + row) * EH * 2; u.B = wsd + (size_t)pn * 256 * EH * 2; u.O = dout; u.row0 = row; u.aux = -1; }
        else { rt -= CH_TOK / 256; const int e = tile_e[ch * CH_TILES_MAX + rt]; const int slot0 = ch * CH_SLOTS + rt * 256;
            u.A = h + (size_t)slot0 * EH * 2; u.B = wd + (size_t)e * D * EH * 2 + (size_t)pn * 256 * EH * 2; u.O = y; u.row0 = rt * 256; u.aux = slot0; }
        return true;
    }
};
}

struct KArgs { const float* in[25]; float* out; unsigned char* ws; int layer; int chunk; };
typedef const __attribute__((address_space(4))) KArgs* KArgP;
#define KA_OPAQUE(p) asm volatile("" : "+s"(p))
#define PHASE_BEGIN() int z_ = 0; asm volatile("" : "+v"(z_)); int tid = (wave_s << 6) | (int)__builtin_amdgcn_mbcnt_hi(~0u, __builtin_amdgcn_mbcnt_lo(~0u, (unsigned)z_)); asm volatile("" : "+v"(tid)); asm volatile("" : "+s"(bid), "+s"(G)); KA_OPAQUE(ka)
enum { I_X = 0, I_MEM, I_WIN, I_WPOOL, I_PSCALE, I_WDW, I_BDW, I_CNG, I_CNB, I_WKV, I_WOUT, I_LN1G, I_LN1B, I_WR, I_RB, I_WG, I_WU, I_WD, I_WGS, I_WUS, I_WDS, I_LN2G, I_LN2B, I_MNG, I_MNB };

__device__ __forceinline__ void transpose_item(const float* W, int N, bf16* WT, int ldk, int row_off, LAS float* scr, int k0, int n0, int lane, bf16* WTlo = nullptr) {
#pragma unroll 8
    for (int i = 0; i < 32; ++i) { const int kk = 2 * i + (lane >> 5); scr[kk * 33 + (lane & 31)] = W[(size_t)(k0 + kk) * N + n0 + (lane & 31)]; }
    LDS_WAIT(); asm volatile("" ::: "memory");
    const int c = lane & 7;
#pragma unroll
    for (int j = 0; j < 4; ++j) { const int n = (lane >> 3) + 8 * j; const LAS float* s = scr + (8 * c) * 33 + n;
        float f[8];
#pragma unroll
        for (int i = 0; i < 8; ++i) f[i] = s[i * 33];
        const u32x4 o = pack8(f);
        *(u32x4*)(WT + (size_t)(row_off + n) * ldk + k0 + 8 * c) = o;
        if (WTlo) { float h[8]; unpack8(o, h);
#pragma unroll
            for (int i = 0; i < 8; ++i) f[i] -= h[i];
            *(u32x4*)(WTlo + (size_t)(row_off + n) * ldk + k0 + 8 * c) = pack8(f); } }
    LDS_WAIT(); asm volatile("" ::: "memory");
}

__device__ __forceinline__ void phase_convert_layer(KArgP ka, const int wave_s, int l, LAS unsigned char* lds, int bid, int G) {
    PHASE_BEGIN();
    const int lane = tid & 63, wave = __builtin_amdgcn_readfirstlane(tid >> 6);
    LAS float* scr = (LAS float*)(lds + wave * 16384);
    unsigned char* ws = ka->ws;
    constexpr int I_IN = 16 * 40, I_OUT = 16 * 32, I_GU = 64 * 128, I_DN = 64 * 128, I_SH = 128, I_R = 16 * 2, I_P = 4 * 2;
    constexpr int NIT = I_IN + I_OUT + 2 * I_GU + I_DN + 3 * I_SH + I_R + I_P;
    { float* dwt = (float*)(ws + W_DWT); const float* wdw = ka->in[I_WDW] + (size_t)l * 31 * CONV_CH; const float* bdw = ka->in[I_BDW] + (size_t)l * CONV_CH;
        for (int i = bid * NTHREADS + tid; i < 256 * 32; i += G * NTHREADS) { const int j = i >> 8, ch = i & 255; dwt[ch * 32 + j] = (j < 31) ? wdw[j * CONV_CH + ch] : bdw[ch]; } }
    for (int it = bid * NWAVES + wave; it < NIT; it += G * NWAVES) {
        int r = it;
        if (r < I_IN) { const int kb = r / 40, nb = r % 40; transpose_item(ka->in[I_WIN] + (size_t)l * D * NPROJ, NPROJ, (bf16*)(ws + WS_WIN), D, 32 * nb, scr, 64 * kb, 32 * nb, lane); continue; } r -= I_IN;
        if (r < I_OUT) { const int kb = r / 32, nb = r % 32; transpose_item(ka->in[I_WOUT] + (size_t)l * D * D, D, (bf16*)(ws + WS_WOUT), D, 32 * nb, scr, 64 * kb, 32 * nb, lane); continue; } r -= I_OUT;
        if (r < 2 * I_GU) { const int half = r / I_GU; r %= I_GU; const int e = r / 128, q = r % 128, kb = q / 8, nb = q % 8, n0 = 32 * nb;
            const float* W = ka->in[half ? I_WU : I_WG] + ((size_t)l * NE + e) * D * EH;
            transpose_item(W, EH, (bf16*)(ws + WS_WGU) + (size_t)e * 512 * D, D, (n0 >> 7) * 256 + half * 128 + (n0 & 127), scr, 64 * kb, n0, lane); continue; } r -= 2 * I_GU;
        if (r < I_DN) { const int e = r / 128, q = r % 128, kb = q / 32, nb = q % 32;
            transpose_item(ka->in[I_WD] + ((size_t)l * NE + e) * EH * D, D, (bf16*)(ws + WS_WD) + (size_t)e * D * EH, EH, 32 * nb, scr, 64 * kb, 32 * nb, lane); continue; } r -= I_DN;
        if (r < 2 * I_SH) { const int half = r / I_SH; r %= I_SH; const int kb = r / 8, nb = r % 8, n0 = 32 * nb;
            transpose_item(ka->in[half ? I_WUS : I_WGS] + (size_t)l * D * EH, EH, (bf16*)(ws + WS_WSGU), D, (n0 >> 7) * 256 + half * 128 + (n0 & 127), scr, 64 * kb, n0, lane); continue; } r -= 2 * I_SH;
        if (r < I_SH) { const int kb = r / 32, nb = r % 32; transpose_item(ka->in[I_WDS] + (size_t)l * EH * D, D, (bf16*)(ws + WS_WSD), EH, 32 * nb, scr, 64 * kb, 32 * nb, lane); continue; } r -= I_SH;
        if (r < I_R) { const int kb = r / 2, nb = r % 2; transpose_item(ka->in[I_WR] + (size_t)l * D * NE, NE, (bf16*)(ws + W_RT), D, 32 * nb, scr, 64 * kb, 32 * nb, lane, (bf16*)(ws + W_RTL)); continue; } r -= I_R;
        { const int g = r / 2, nb = r % 2; transpose_item(ka->in[I_WPOOL] + ((size_t)l * 4 + g) * 64 * 64, 64, (bf16*)(ws + W_PT) + (size_t)g * 64 * 64, 64, 32 * nb, scr, 0, 32 * nb, lane); }
    }
}

__device__ __forceinline__ void phase_prologue(KArgP ka, const int wave_s, LAS unsigned char* lds, int bid, int G) {
    PHASE_BEGIN();
    const int lane = tid & 63, wave = __builtin_amdgcn_readfirstlane(tid >> 6);
    LAS float* scr = (LAS float*)(lds + wave * 16384);
    unsigned char* ws = ka->ws;
    const int gw = bid * NWAVES + wave, NGW = G * NWAVES;
    for (int it = gw; it < DEPTH * 512; it += NGW) { const int l = it / 512, q = it % 512, kb = q / 32, nb = q % 32;
        transpose_item(ka->in[I_WKV] + (size_t)l * D * D, D, (bf16*)(ws + WS_WKV) + (size_t)l * D * D, D, 32 * nb, scr, 64 * kb, 32 * nb, lane); }
    const float* g = ka->in[I_MNG]; const float* b = ka->in[I_MNB];
    for (int m = gw; m < MROWS; m += NGW) {
        const f32x4* xr = (const f32x4*)(ka->in[I_MEM] + (size_t)m * D) + lane;
        f32x4 v[4]; float s = 0.f;
#pragma unroll
        for (int j = 0; j < 4; ++j) { v[j] = xr[64 * j]; s += (v[j][0] + v[j][1]) + (v[j][2] + v[j][3]); }
        const float mean = wave_sum(s, lane) * (1.f / D); float s2 = 0.f;
#pragma unroll
        for (int j = 0; j < 4; ++j) { v[j] = v[j] - mean; s2 += (v[j][0] * v[j][0] + v[j][1] * v[j][1]) + (v[j][2] * v[j][2] + v[j][3] * v[j][3]); }
        const float rstd = 1.f / sqrtf(wave_sum(s2, lane) * (1.f / D) + LN_EPS);
        u32x2* o8 = (u32x2*)((bf16*)(ws + WS_MEMN) + (size_t)m * D) + lane;
        const int ml = m & 31, mp = (m & ~31) + 8 * ((ml >> 2) & 3) + 4 * (ml >> 4) + (ml & 3);
        u32x2* p8 = (u32x2*)((bf16*)(ws + WS_MEMP) + (size_t)mp * D) + lane;
#pragma unroll
        for (int j = 0; j < 4; ++j) { const f32x4 gg = ((const f32x4*)g)[lane + 64 * j], bb = ((const f32x4*)b)[lane + 64 * j]; const f32x4 y = v[j] * rstd * gg + bb;
            u32x2 w; w.x = cvt_pk_bf16(y[0], y[1]); w.y = cvt_pk_bf16(y[2], y[3]); o8[64 * j] = w; p8[64 * j] = w; }
    }
    const size_t n8 = (size_t)T * D / 8;
    for (size_t i = (size_t)bid * NTHREADS + tid; i < n8; i += (size_t)G * NTHREADS) {
        const f32x4 p0 = ((const f32x4*)ka->in[I_X])[2 * i], p1 = ((const f32x4*)ka->in[I_X])[2 * i + 1];
        u32x4 w; w.x = cvt_pk_bf16(p0[0], p0[1]); w.y = cvt_pk_bf16(p0[2], p0[3]); w.z = cvt_pk_bf16(p1[0], p1[1]); w.w = cvt_pk_bf16(p1[2], p1[3]);
        ((u32x4*)(ws + WS_XB))[i] = w;
    }
}

#define OPAQUE_TID() int z2_ = 0; asm volatile("" : "+v"(z2_)); int tid = (wave_s << 6) | (int)__builtin_amdgcn_mbcnt_hi(~0u, __builtin_amdgcn_mbcnt_lo(~0u, (unsigned)z2_)); asm volatile("" : "+v"(tid)); const int lane = tid & 63, wave = __builtin_amdgcn_readfirstlane(tid >> 6); (void)lane; (void)wave
__device__ __forceinline__ void phase_mixers(KArgP ka, const int wave_s, int l, LAS unsigned char* lds, int bid, int G) {
    PHASE_BEGIN();
    unsigned char* ws = ka->ws;
    const bf16* proj = (const bf16*)(ws + U_PROJ); bf16* cat = (bf16*)(ws + U_CAT);
    const bf16* wpt = (const bf16*)(ws + W_PT);
    const bf16* Kb = (const bf16*)(ws + WS_KB) + (size_t)l * MROWS * MEM_CH; const bf16* Vt = (const bf16*)(ws + WS_VT) + (size_t)l * MROWS * MEM_CH;
    const float* pscale = ka->in[I_PSCALE] + (size_t)l * POOL_CH;
    const float* dwt = (const float*)(ws + W_DWT);
    const float* cng = ka->in[I_CNG] + (size_t)l * CONV_CH; const float* cnb = ka->in[I_CNB] + (size_t)l * CONV_CH;
    for (int item = bid; item < T / 64; item += G) {
        const int b = item / (SEQ / 64), s0 = (item % (SEQ / 64)) * 64; const size_t t0 = (size_t)b * SEQ + s0;
        for (int rep = 0; rep < 1 + (PROBE_SUB & 1); ++rep) {
            OPAQUE_TID();
            LAS bf16* Ub = (LAS bf16*)lds;
            LAS bf16* Db = (LAS bf16*)(lds + 80 * 528);
#pragma unroll 1
            for (int i = tid; i < 80 * 32; i += NTHREADS) { const int r = i >> 5, c8 = i & 31; const int s = s0 - 8 + r;
                u32x4 v = (u32x4){0u, 0u, 0u, 0u}; if (s >= 0 && s < SEQ) v = *(const u32x4*)(proj + ((size_t)b * SEQ + s) * NPROJ + c8 * 8);
                *(LAS u32x4*)(Ub + r * 264 + c8 * 8) = v; }
            __syncthreads();
            { const int ch = tid & 255, half = tid >> 8, g = ch >> 6; const int w = 2 << g, lo = w >> 1, hi = w - 1 - lo;
#pragma unroll 1
                for (int r = half * 32; r < half * 32 + 32; ++r) { const int s = s0 + r; const int st = max(s - lo, 0), en = min(s + hi + 1, SEQ);
                    float sum = 0.f; for (int q = st; q < en; ++q) sum += bf2f(Ub[(q - s0 + 8) * 264 + ch]);
                    const float d = sum / (float)(en - st) - bf2f(Ub[(r + 8) * 264 + ch]);
                    Db[r * 264 + ch] = (bf16)(cvt_pk_bf16(d, 0.f) & 0xffffu); } }
            __syncthreads();
            { const int g = wave >> 1, rh = wave & 1, fr = lane & 15, fq = lane >> 4;
#pragma unroll
                for (int rt = 0; rt < 2; ++rt) {
                    bf16x8 af[2];
#pragma unroll
                    for (int ks = 0; ks < 2; ++ks) af[ks] = *(const LAS bf16x8*)(Db + (rh * 32 + rt * 16 + fr) * 264 + g * 64 + ks * 32 + 8 * fq);
#pragma unroll
                    for (int ct = 0; ct < 4; ++ct) { f32x4 c = (f32x4){0.f, 0.f, 0.f, 0.f};
#pragma unroll
                        for (int ks = 0; ks < 2; ++ks) { const bf16x8 bfv = *(const bf16x8*)(wpt + (size_t)g * 4096 + (ct * 16 + fr) * 64 + ks * 32 + 8 * fq); c = __builtin_amdgcn_mfma_f32_16x16x32_bf16(af[ks], bfv, c, 0, 0, 0); }
                        const int col = g * 64 + ct * 16 + fr; const float sc = pscale[col];
#pragma unroll
                        for (int j = 0; j < 4; ++j) cat[(t0 + rh * 32 + rt * 16 + fq * 4 + j) * D + col] = (bf16)(cvt_pk_bf16(c[j] * sc, 0.f) & 0xffffu); } } }
            __syncthreads();
        }
        for (int rep = 0; rep < 1 + ((PROBE_SUB >> 1) & 1); ++rep) {
            OPAQUE_TID();
            LAS bf16* Gb = (LAS bf16*)lds;
            LAS float* Yc = (LAS float*)(lds + 49152);
#pragma unroll 1
            for (int i = tid; i < 94 * 32; i += NTHREADS) { const int r = i >> 5, c8 = i & 31; const int s = s0 - 15 + r;
                u32x4 o = (u32x4){0u, 0u, 0u, 0u};
                if (s >= 0 && s < SEQ) { const bf16* pr = proj + ((size_t)b * SEQ + s) * NPROJ + 256 + c8 * 8; const u32x4 av = *(const u32x4*)pr, gv = *(const u32x4*)(pr + 256);
                    float y[8];
#pragma unroll
                    for (int j = 0; j < 4; ++j) { const unsigned aw = av[j], gw2 = gv[j];
                        y[2 * j] = bf2f(aw & 0xffffu) * fast_sigmoid(bf2f(gw2 & 0xffffu)); y[2 * j + 1] = bf2f(aw >> 16) * fast_sigmoid(bf2f(gw2 >> 16)); }
                    o.x = cvt_pk_bf16(y[0], y[1]); o.y = cvt_pk_bf16(y[2], y[3]); o.z = cvt_pk_bf16(y[4], y[5]); o.w = cvt_pk_bf16(y[6], y[7]); }
                *(LAS u32x4*)(Gb + r * 256 + c8 * 8) = o; }
            __syncthreads();
            { const int ch = tid & 255, half = tid >> 8; float wv[32];
#pragma unroll
                for (int j = 0; j < 8; ++j) { const f32x4 w4 = ((const f32x4*)(dwt + ch * 32))[j]; wv[4 * j] = w4[0]; wv[4 * j + 1] = w4[1]; wv[4 * j + 2] = w4[2]; wv[4 * j + 3] = w4[3]; }
                const float bias = wv[31];
#pragma unroll 1
                for (int rb = 0; rb < 8; ++rb) { const int r0 = half * 32 + rb * 4; float gv[34];
#pragma unroll
                    for (int j = 0; j < 34; ++j) gv[j] = bf2f(Gb[(r0 + j) * 256 + ch]);
#pragma unroll
                    for (int q = 0; q < 4; ++q) { float y = bias;
#pragma unroll
                        for (int j = 0; j < 31; ++j) y += gv[q + j] * wv[j];
                        Yc[(r0 + q) * 256 + ch] = y; } } }
            __syncthreads();
#pragma unroll 1
            for (int r = wave; r < 64; r += NWAVES) { const f32x4 v = *(const LAS f32x4*)(Yc + r * 256 + lane * 4);
                const float mean = wave_sum((v[0] + v[1]) + (v[2] + v[3]), lane) * (1.f / 256.f); const f32x4 d = v - mean;
                const float rstd = 1.f / sqrtf(wave_sum((d[0] * d[0] + d[1] * d[1]) + (d[2] * d[2] + d[3] * d[3]), lane) * (1.f / 256.f) + LN_EPS);
                const f32x4 gg = ((const f32x4*)cng)[lane], bb = ((const f32x4*)cnb)[lane]; const f32x4 y = d * rstd * gg + bb;
                u32x2 w; w.x = cvt_pk_bf16(fast_silu(y[0]), fast_silu(y[1])); w.y = cvt_pk_bf16(fast_silu(y[2]), fast_silu(y[3]));
                *(u32x2*)(cat + (t0 + r) * D + 256 + lane * 4) = w; }
            __syncthreads();
        }
        for (int rep = 0; rep < 1 + ((PROBE_SUB >> 2) & 1); ++rep) {
            OPAQUE_TID();
            const int hh = wave >> 1, rbase = (wave & 1) * 32, fr = lane & 15, fq = lane >> 4;
            constexpr float SC = 0.08838834764831845f * 1.4426950408889634f;
            const __amdgpu_buffer_rsrc_t kR = __builtin_amdgcn_make_buffer_rsrc((void*)(Kb + (size_t)b * MEMT * MEM_CH + hh * HD), (short)0, MEMT * MEM_CH * 2, RSRC_W3);
            const __amdgpu_buffer_rsrc_t vR = __builtin_amdgcn_make_buffer_rsrc((void*)(Vt + (size_t)hh * HD * MROWS + b * MEMT), (short)0, HD * MROWS * 2, RSRC_W3);
            const __amdgpu_buffer_rsrc_t qR = __builtin_amdgcn_make_buffer_rsrc((void*)(proj + (t0 + rbase) * NPROJ + 768 + hh * HD), (short)0, 32 * NPROJ * 2, RSRC_W3);
            const unsigned klane = (unsigned)(fr * MEM_CH + 8 * fq) * 2u, vlane = (unsigned)(fr * MROWS + 8 * fq) * 2u, qlane = (unsigned)(fr * NPROJ + 8 * fq) * 2u;
            bf16x8 bq[2][4];
#pragma unroll
            for (int qt = 0; qt < 2; ++qt)
#pragma unroll
                for (int ks = 0; ks < 4; ++ks) bq[qt][ks] = bufld8(qR, qlane, (unsigned)(qt * 16 * NPROJ + ks * 32) * 2u);
            f32x4 s[2][16];
#pragma unroll
            for (int ct = 0; ct < 16; ++ct) { s[0][ct] = (f32x4){0.f, 0.f, 0.f, 0.f}; s[1][ct] = (f32x4){0.f, 0.f, 0.f, 0.f};
#pragma unroll
                for (int ks = 0; ks < 4; ++ks) { const bf16x8 kf = bufld8(kR, klane, (unsigned)(ct * 16 * MEM_CH + ks * 32) * 2u);
                    s[0][ct] = __builtin_amdgcn_mfma_f32_16x16x32_bf16(kf, bq[0][ks], s[0][ct], 0, 0, 0); s[1][ct] = __builtin_amdgcn_mfma_f32_16x16x32_bf16(kf, bq[1][ks], s[1][ct], 0, 0, 0); }
                if ((ct & 3) == 3) asm volatile("" ::: "memory"); }
            float inv[2];
            bf16x8 pb[2][8];
#pragma unroll
            for (int qt = 0; qt < 2; ++qt) { float m = s[qt][0][0];
#pragma unroll
                for (int ct = 0; ct < 16; ++ct)
#pragma unroll
                    for (int j = 0; j < 4; ++j) m = fmaxf(m, s[qt][ct][j]);
                m = fmaxf(m, swz_xor<16>(m)); m = fmaxf(m, bperm_f(lane ^ 32, m));
                float sum = 0.f;
#pragma unroll
                for (int ks = 0; ks < 8; ++ks) { float p[8];
#pragma unroll
                    for (int j = 0; j < 4; ++j) { p[j] = __builtin_amdgcn_exp2f((s[qt][2 * ks][j] - m) * SC); p[4 + j] = __builtin_amdgcn_exp2f((s[qt][2 * ks + 1][j] - m) * SC); }
#pragma unroll
                    for (int j = 0; j < 8; ++j) sum += p[j];
                    pb[qt][ks] = __builtin_bit_cast(bf16x8, pack8(p)); }
                sum += swz_xor<16>(sum); sum += bperm_f(lane ^ 32, sum);
                inv[qt] = 1.f / sum; }
            f32x4 o[2][8];
#pragma unroll
            for (int dt = 0; dt < 8; ++dt) { o[0][dt] = (f32x4){0.f, 0.f, 0.f, 0.f}; o[1][dt] = (f32x4){0.f, 0.f, 0.f, 0.f}; }
#pragma unroll
            for (int ks = 0; ks < 8; ++ks) {
#pragma unroll
                for (int dt = 0; dt < 8; ++dt) { const bf16x8 vf = bufld8(vR, vlane, (unsigned)(dt * 16 * MROWS + ks * 32) * 2u);
                    o[0][dt] = __builtin_amdgcn_mfma_f32_16x16x32_bf16(vf, pb[0][ks], o[0][dt], 0, 0, 0); o[1][dt] = __builtin_amdgcn_mfma_f32_16x16x32_bf16(vf, pb[1][ks], o[1][dt], 0, 0, 0); }
                if (ks & 1) asm volatile("" ::: "memory"); }
#pragma unroll
            for (int qt = 0; qt < 2; ++qt) { bf16* orow = cat + (t0 + rbase + qt * 16 + fr) * D + 512 + hh * HD + 4 * fq;
#pragma unroll
                for (int dt = 0; dt < 8; ++dt) { u32x2 w; w.x = cvt_pk_bf16(o[qt][dt][0] * inv[qt], o[qt][dt][1] * inv[qt]); w.y = cvt_pk_bf16(o[qt][dt][2] * inv[qt], o[qt][dt][3] * inv[qt]); *(u32x2*)(orow + dt * 16) = w; } }
        }
    }
}

__device__ __forceinline__ void phase_ln1_router(KArgP ka, const int wave_s, int l, LAS unsigned char* lds, int bid, int G) {
    PHASE_BEGIN();
    const int lane = tid & 63, wave = __builtin_amdgcn_readfirstlane(tid >> 6), fr = lane & 15, fq = lane >> 4;
    unsigned char* ws = ka->ws;
    const bf16* zb = (const bf16*)(ws + WS_ZB); bf16* xb = (bf16*)(ws + WS_XB);
    const float* g = ka->in[I_LN1G] + (size_t)l * D; const float* bta = ka->in[I_LN1B] + (size_t)l * D;
    const float* rbias = ka->in[I_RB] + (size_t)l * NE;
    int* tok_e = (int*)(ws + TOK_E); float* tok_g = (float*)(ws + TOK_G); int* tok_r = (int*)(ws + TOK_R); int* hist = (int*)(ws + TAB_HIST);
    int* row_tok = (int*)(ws + ROW_TOK);
    for (int i = bid * NTHREADS + tid; i < NCH * CH_SLOTS; i += G * NTHREADS) row_tok[i] = 0;
    LAS bf16* Xh = (LAS bf16*)lds;
    LAS bf16* Xl = (LAS bf16*)(lds + 32 * 2064);
    LAS float* Lg = (LAS float*)(lds + 64 * 2064);
    LAS int* hl = (LAS int*)(lds + 64 * 2064 + 16384);
    const int ct = wave & 3, part = wave >> 2;
    bf16x8 wf[32];
    { const bf16* wsrc = (const bf16*)(ws + (part ? W_RTL : W_RT)) + (size_t)(ct * 16 + fr) * D + 8 * fq;
#pragma unroll
        for (int ks = 0; ks < 32; ++ks) wf[ks] = *(const bf16x8*)(wsrc + ks * 32); }
    const float rb = rbias[lane];
#pragma unroll 1
    for (int tb = bid; tb < NTB; tb += G) {
        if (tid < 64) hl[tid] = 0;
        __syncthreads();
#pragma unroll 1
        for (int st = 0; st < 8; ++st) {
            { u32x4 zv[4][2];
#pragma unroll
                for (int rr = 0; rr < 4; ++rr) { const size_t t = (size_t)tb * TBLK + st * 32 + wave * 4 + rr;
#pragma unroll
                    for (int j = 0; j < 2; ++j) zv[rr][j] = *(const u32x4*)(zb + t * D + 8 * lane + 512 * j); }
#pragma unroll
                for (int rr = 0; rr < 4; ++rr) { const int lr = wave * 4 + rr; const size_t t = (size_t)tb * TBLK + st * 32 + lr;
                    float v[16]; unpack8(zv[rr][0], v); unpack8(zv[rr][1], v + 8);
                    ln_row16(v, g, bta, lane);
#pragma unroll
                    for (int j = 0; j < 2; ++j) { const u32x4 w = pack8(v + 8 * j); *(u32x4*)(xb + t * D + 8 * lane + 512 * j) = w; *(LAS u32x4*)(Xh + lr * 1032 + 8 * lane + 512 * j) = w;
                        float lo[8]; float hf[8]; unpack8(w, hf);
#pragma unroll
                        for (int i = 0; i < 8; ++i) lo[i] = v[8 * j + i] - hf[i];
                        *(LAS u32x4*)(Xl + lr * 1032 + 8 * lane + 512 * j) = pack8(lo); } } }
            __syncthreads();
            { f32x4 c0 = (f32x4){0.f, 0.f, 0.f, 0.f}, c1 = (f32x4){0.f, 0.f, 0.f, 0.f};
#pragma unroll
                for (int ks = 0; ks < 32; ++ks) { const bf16x8 a0 = *(const LAS bf16x8*)(Xh + fr * 1032 + ks * 32 + 8 * fq), a1 = *(const LAS bf16x8*)(Xh + (16 + fr) * 1032 + ks * 32 + 8 * fq);
                    c0 = __builtin_amdgcn_mfma_f32_16x16x32_bf16(a0, wf[ks], c0, 0, 0, 0); c1 = __builtin_amdgcn_mfma_f32_16x16x32_bf16(a1, wf[ks], c1, 0, 0, 0);
                    if (part == 0) { const bf16x8 l0 = *(const LAS bf16x8*)(Xl + fr * 1032 + ks * 32 + 8 * fq), l1 = *(const LAS bf16x8*)(Xl + (16 + fr) * 1032 + ks * 32 + 8 * fq);
                        c0 = __builtin_amdgcn_mfma_f32_16x16x32_bf16(l0, wf[ks], c0, 0, 0, 0); c1 = __builtin_amdgcn_mfma_f32_16x16x32_bf16(l1, wf[ks], c1, 0, 0, 0); } }
#pragma unroll
                for (int j = 0; j < 4; ++j) { Lg[(part * 32 + fq * 4 + j) * 64 + ct * 16 + fr] = c0[j]; Lg[(part * 32 + 16 + fq * 4 + j) * 64 + ct * 16 + fr] = c1[j]; } }
            __syncthreads();
#pragma unroll 1
            for (int rr = 0; rr < 4; ++rr) { const int lr = wave * 4 + rr; const size_t t = (size_t)tb * TBLK + st * 32 + lr;
                const float sc = fast_sigmoid(Lg[lr * 64 + lane] + Lg[(32 + lr) * 64 + lane]); float sel = sc + rb;
                int my_e = 0; float my_s = 0.f, ssum = 0.f;
#pragma unroll
                for (int k = 0; k < TOPK; ++k) { const float m = wave_max(sel, lane); const unsigned long long mask = __ballot(sel == m); const int idx = __ffsll((long long)mask) - 1;
                    const float sk = rl_f(sc, idx); ssum += sk; if (lane == idx) sel = -3.0e38f; if (lane == k) { my_e = idx; my_s = sk; } }
                if (lane < TOPK) { const int rank = __hip_atomic_fetch_add(&hl[my_e], 1, __ATOMIC_RELAXED, __HIP_MEMORY_SCOPE_WORKGROUP);
                    tok_e[t * TOPK + lane] = my_e; tok_g[t * TOPK + lane] = my_s / ssum * ROUTED_SCALE; tok_r[t * TOPK + lane] = rank; }
            }
            __syncthreads();
        }
        if (tid < 64) hist[tb * 64 + tid] = hl[tid];
        __syncthreads();
    }
}

__device__ __forceinline__ void phase_scatter(KArgP ka, const int wave_s, LAS unsigned char* lds, int bid, int G) {
    PHASE_BEGIN();
    const int lane = tid & 63;
    unsigned char* ws = ka->ws;
    const int* tok_e = (const int*)(ws + TOK_E); const float* tok_g = (const float*)(ws + TOK_G); const int* tok_r = (const int*)(ws + TOK_R); int* slot_of = (int*)(ws + TOK_SLOT);
    const int* hist = (const int*)(ws + TAB_HIST); int* ntiles = (int*)(ws + TAB_NT); int* tile_e = (int*)(ws + TAB_TE);
    int* row_tok = (int*)(ws + ROW_TOK); float* row_gate = (float*)(ws + ROW_GATE);
    LAS int* ptot = (LAS int*)lds; LAS int* pbef = ptot + 512; LAS int* base = pbef + 512;
    for (int tb = bid; tb < NTB; tb += G) {
        const int ch = tb / TB_PER_CH;
        { const int e = tid & 63, part = tid >> 6; int tot = 0, bef = 0;
            for (int j = 0; j < TB_PER_CH / 8; ++j) { const int blk = ch * TB_PER_CH + part * (TB_PER_CH / 8) + j; const int v = hist[blk * 64 + e]; tot += v; if (blk < tb) bef += v; }
            ptot[part * 64 + e] = tot; pbef[part * 64 + e] = bef; }
        __syncthreads();
        if (tid < 64) { int tot = 0, bef = 0;
#pragma unroll
            for (int p = 0; p < 8; ++p) { tot += ptot[p * 64 + tid]; bef += pbef[p * 64 + tid]; }
            const int padded = (tot + 255) & ~255; int inc = padded;
#pragma unroll
            for (int o = 1; o < 64; o <<= 1) { const int v = bperm_i((lane - o) & 63, inc); if (lane >= o) inc += v; }
            const int ebase = inc - padded;
            base[tid] = ebase + bef;
            if (tb % TB_PER_CH == 0) { if (tid == 63) ntiles[ch] = inc >> 8; for (int j = 0; j < (padded >> 8); ++j) tile_e[ch * CH_TILES_MAX + (ebase >> 8) + j] = tid; }
        }
        __syncthreads();
        for (int q = tid; q < TBLK * TOPK; q += NTHREADS) { const size_t i = (size_t)tb * TBLK * TOPK + q; const int e = tok_e[i]; const int slot = ch * CH_SLOTS + base[e] + tok_r[i];
            row_tok[slot] = (int)(i >> 3); row_gate[slot] = tok_g[i]; slot_of[i] = slot; }
        __syncthreads();
    }
}

__device__ __forceinline__ void add_fp8x16(const u32x4 w, float* v) {
#pragma unroll
    for (int q = 0; q < 4; ++q) { const f32x2 a = __builtin_amdgcn_cvt_pk_f32_fp8((int)w[q], false), b = __builtin_amdgcn_cvt_pk_f32_fp8((int)w[q], true);
        v[4 * q] += a[0]; v[4 * q + 1] += a[1]; v[4 * q + 2] += b[0]; v[4 * q + 3] += b[1]; }
}
__device__ __forceinline__ void phase_combine_ln2(KArgP ka, const int wave_s, int l, int ch, int bid, int G) {
    PHASE_BEGIN();
    const int lane = tid & 63, wave = __builtin_amdgcn_readfirstlane(tid >> 6);
    unsigned char* ws = ka->ws;
    float* dout = ka->out; bf16* xb = (bf16*)(ws + WS_XB); const bf16* zb = (const bf16*)(ws + WS_ZB); const unsigned char* Y = (const unsigned char*)(ws + WS_Y); const int* slot_of = (const int*)(ws + TOK_SLOT);
    const float* g = ka->in[I_LN2G] + (size_t)l * D; const float* bta = ka->in[I_LN2B] + (size_t)l * D;
    const bool last = (l == DEPTH - 1);
    f32x4 gg[4], bb[4];
#pragma unroll
    for (int q = 0; q < 4; ++q) { gg[q] = *(const f32x4*)(g + 16 * lane + 4 * q); bb[q] = *(const f32x4*)(bta + 16 * lane + 4 * q); }
#pragma unroll 1
    for (int q0 = bid * NWAVES + wave; q0 < CH_TOK; q0 += G * NWAVES) { const size_t t = (size_t)ch * CH_TOK + q0;
        int sl[TOPK];
#pragma unroll
        for (int k = 0; k < TOPK; ++k) sl[k] = __builtin_amdgcn_readfirstlane(slot_of[t * TOPK + k]) - ch * CH_SLOTS;
        u32x4 zv[2], yv[TOPK];
#pragma unroll
        for (int j = 0; j < 2; ++j) zv[j] = *(const u32x4*)(zb + t * D + 16 * lane + 8 * j);
#pragma unroll
        for (int k = 0; k < TOPK; ++k) yv[k] = *(const u32x4*)(Y + (size_t)sl[k] * D + 16 * lane);
        float y[16];
#pragma unroll
        for (int i = 0; i < 16; ++i) y[i] = 0.f;
#pragma unroll
        for (int k = 0; k < TOPK; ++k) add_fp8x16(yv[k], y);
        float v[16]; unpack8(zv[0], v); unpack8(zv[1], v + 8);
        float s = 0.f;
#pragma unroll
        for (int i = 0; i < 16; ++i) { v[i] += y[i] * Y_INV; s += v[i]; }
        const float mean = wave_sum(s, lane) * (1.f / D); float s2 = 0.f;
#pragma unroll
        for (int i = 0; i < 16; ++i) { v[i] -= mean; s2 += v[i] * v[i]; }
        const float rstd = 1.f / sqrtf(wave_sum(s2, lane) * (1.f / D) + LN_EPS);
#pragma unroll
        for (int q = 0; q < 4; ++q)
#pragma unroll
            for (int i = 0; i < 4; ++i) v[4 * q + i] = v[4 * q + i] * rstd * gg[q][i] + bb[q][i];
#pragma unroll
        for (int j = 0; j < 2; ++j) *(u32x4*)(xb + t * D + 16 * lane + 8 * j) = pack8(v + 8 * j);
        if (last) {
#pragma unroll
            for (int q = 0; q < 4; ++q) *(f32x4*)(dout + t * D + 16 * lane + 4 * q) = (f32x4){v[4 * q], v[4 * q + 1], v[4 * q + 2], v[4 * q + 3]}; }
    }
}

__device__ __forceinline__ void phase_gemm_kv(KArgP ka, const int wave_s, LAS unsigned char* lds, int bid, int G) {
    PHASE_BEGIN();
    unsigned char* ws = ka->ws;
    ge::SchedKV S{(const char*)(ws + WS_MEMN), (const char*)(ws + WS_MEMP), (const char*)(ws + WS_WKV), (char*)(ws + WS_KB), (char*)(ws + WS_VT), G, bid};
    ge::EpiBf16 E;
    ge::gemm_phase<D, false, ge::EpiBf16, ge::SchedKV>(tid, lds, (const LAS int*)(lds + LDS_TBL), S, E);
}
__device__ __forceinline__ void phase_gemm_in(KArgP ka, const int wave_s, LAS unsigned char* lds, int bid, int G) {
    PHASE_BEGIN();
    unsigned char* ws = ka->ws;
    ge::SchedDense<D> S{(const char*)(ws + WS_XB), (const char*)(ws + WS_WIN), (char*)(ws + U_PROJ), NPROJ, T / 256, NPROJ / 256, G, bid};
    ge::EpiBf16 E;
    ge::gemm_phase<D, false, ge::EpiBf16, ge::SchedDense<D>>(tid, lds, (const LAS int*)(lds + LDS_TBL), S, E);
}
__device__ __forceinline__ void phase_gemm_out(KArgP ka, const int wave_s, int l, LAS unsigned char* lds, int bid, int G) {
    PHASE_BEGIN();
    unsigned char* ws = ka->ws;
    ge::SchedDense<D> S{(const char*)(ws + U_CAT), (const char*)(ws + WS_WOUT), (char*)(ws + WS_ZB), D, T / 256, D / 256, G, bid};
    ge::EpiResBf16 E{(const bf16*)(ws + WS_XB), (bf16*)(ws + WS_ZB)};
    ge::gemm_phase<D, false, ge::EpiResBf16, ge::SchedDense<D>>(tid, lds, (const LAS int*)(lds + LDS_TBL), S, E);
}
__device__ __forceinline__ void phase_gemm_gu(KArgP ka, const int wave_s, LAS unsigned char* lds, int bid, int G) {
    PHASE_BEGIN();
    unsigned char* ws = ka->ws;
    ge::SchedGU S{(const char*)(ws + WS_XB), (const char*)(ws + WS_WGU), (const char*)(ws + WS_WSGU), (char*)(ws + U_H), (const int*)(ws + TAB_NT), (const int*)(ws + TAB_TE), G, bid, {}};
    S.init();
    LAS int* tbl = (LAS int*)(lds + LDS_TBL);
    const int* row_tok = (const int*)(ws + ROW_TOK);
    { ge::Unit u; for (int i = 0; i < MAXU && S.next(i, u); ++i) { const int r = tid; if (r < 256) tbl[i * 256 + r] = (u.aux >= 0) ? (u.aux + r) : row_tok[u.row0 + r]; } }
    __syncthreads();
    ge::EpiSwiGLU E;
    ge::gemm_phase<D, true, ge::EpiSwiGLU, ge::SchedGU>(tid, lds, tbl, S, E);
}
__device__ __forceinline__ void phase_gemm_dn(KArgP ka, const int wave_s, int ch, LAS unsigned char* lds, int bid, int G) {
    PHASE_BEGIN();
    unsigned char* ws = ka->ws;
    ge::SchedDN S{(const char*)(ws + U_H), (const char*)(ws + WS_WD), (const char*)(ws + WS_WSD), (char*)(ws + WS_Y), (char*)(ws + WS_ZB), (const int*)(ws + TAB_TE), ch, ((const int*)(ws + TAB_NT))[ch], G, bid};
    ge::EpiDown E{(const float*)(ws + ROW_GATE), (const bf16*)(ws + WS_XB)};
    ge::gemm_phase<EH, false, ge::EpiDown, ge::SchedDN>(tid, lds, (const LAS int*)(lds + LDS_TBL), S, E);
}

#define KERNEL_HEAD extern __shared__ __attribute__((aligned(16))) unsigned char lds_raw[]; LAS unsigned char* lds = (LAS unsigned char*)lds_raw; const int bid = blockIdx.x, G = gridDim.x; KArgP ka = (KArgP)__builtin_amdgcn_kernarg_segment_ptr(); (void)a; const int wave_s = __builtin_amdgcn_readfirstlane((int)(threadIdx.x >> 6));
#if MK_ONE_LAUNCH
#define RUN(id, call) do { KA_OPAQUE(ka); call; if ((PROBE_DUP >> (id)) & 1) { grid_bar(bar, wave_s); KA_OPAQUE(ka); call; } } while (0)
__global__ void __launch_bounds__(NTHREADS, 2) k_mega(KArgs a) {
    KERNEL_HEAD
    volatile LAS unsigned* misc = (volatile LAS unsigned*)(lds + LDS_CTLW);
    if (threadIdx.x < 64) misc[threadIdx.x] = 0u;
    __syncthreads();
    const XcdBarrier bar = xcd_barrier_post((unsigned*)(ka->ws + WS_CTL), misc + 8, (int)threadIdx.x);
    RUN(1, phase_prologue(ka, wave_s, lds, bid, G));
    RUN(2, phase_convert_layer(ka, wave_s, 0, lds, bid, G));
    grid_bar(bar, wave_s);
    RUN(3, phase_gemm_kv(ka, wave_s, lds, bid, G));
#pragma unroll 1
    for (int l = 0; l < DEPTH; ++l) {
        RUN(4, phase_gemm_in(ka, wave_s, lds, bid, G));
        grid_bar(bar, wave_s);
        RUN(5, phase_mixers(ka, wave_s, l, lds, bid, G));
        grid_bar(bar, wave_s);
        RUN(6, phase_gemm_out(ka, wave_s, l, lds, bid, G));
        grid_bar(bar, wave_s);
        RUN(7, phase_ln1_router(ka, wave_s, l, lds, bid, G));
        grid_bar(bar, wave_s);
        RUN(8, phase_scatter(ka, wave_s, lds, bid, G));
        grid_bar(bar, wave_s);
        RUN(9, phase_gemm_gu(ka, wave_s, lds, bid, G));
        grid_bar(bar, wave_s);
#pragma unroll 1
        for (int c = 0; c < NCH; ++c) {
            RUN(10, phase_gemm_dn(ka, wave_s, c, lds, bid, G));
            grid_bar(bar, wave_s);
            RUN(11, phase_combine_ln2(ka, wave_s, l, c, bid, G));
            if (c == NCH - 1) { if (l == DEPTH - 1) break; RUN(2, phase_convert_layer(ka, wave_s, l + 1, lds, bid, G)); }
            grid_bar(bar, wave_s);
        }
    }
}
#else
__global__ void __launch_bounds__(NTHREADS, 2) k_prologue(KArgs a) { KERNEL_HEAD phase_prologue(ka, wave_s, lds, bid, G); }
__global__ void __launch_bounds__(NTHREADS, 2) k_convert(KArgs a) { KERNEL_HEAD phase_convert_layer(ka, wave_s, ka->layer, lds, bid, G); }
__global__ void __launch_bounds__(NTHREADS, 2) k_gemm_kv(KArgs a) { KERNEL_HEAD phase_gemm_kv(ka, wave_s, lds, bid, G); }
__global__ void __launch_bounds__(NTHREADS, 2) k_gemm_in(KArgs a) { KERNEL_HEAD phase_gemm_in(ka, wave_s, lds, bid, G); }
__global__ void __launch_bounds__(NTHREADS, 2) k_mixers(KArgs a) { KERNEL_HEAD phase_mixers(ka, wave_s, ka->layer, lds, bid, G); }
__global__ void __launch_bounds__(NTHREADS, 2) k_gemm_out(KArgs a) { KERNEL_HEAD phase_gemm_out(ka, wave_s, ka->layer, lds, bid, G); }
__global__ void __launch_bounds__(NTHREADS, 2) k_ln1_router(KArgs a) { KERNEL_HEAD phase_ln1_router(ka, wave_s, ka->layer, lds, bid, G); }
__global__ void __launch_bounds__(NTHREADS, 2) k_scatter(KArgs a) { KERNEL_HEAD phase_scatter(ka, wave_s, lds, bid, G); }
__global__ void __launch_bounds__(NTHREADS, 2) k_gemm_gu(KArgs a) { KERNEL_HEAD phase_gemm_gu(ka, wave_s, lds, bid, G); }
__global__ void __launch_bounds__(NTHREADS, 2) k_gemm_dn(KArgs a) { KERNEL_HEAD phase_gemm_dn(ka, wave_s, ka->chunk, lds, bid, G); }
__global__ void __launch_bounds__(NTHREADS, 2) k_combine(KArgs a) { KERNEL_HEAD (void)lds; phase_combine_ln2(ka, wave_s, ka->layer, ka->chunk, bid, G); }
#endif

extern "C" void kernel_launch(void* const* d_in, const int* in_sizes, int n_in, void* d_out, int out_size, void* d_ws, size_t ws_size, hipStream_t stream) {
    static int grid = 0;
    if (!grid) {
        if (n_in != 25 || out_size != T * D || ws_size < WS_END) { fprintf(stderr, "kernel_launch: unexpected shapes (n_in %d out %d ws %zu need %zu)\n", n_in, out_size, ws_size, (size_t)WS_END); grid = -1; return; }
        int dev = 0, cus = 0; (void)hipGetDevice(&dev); (void)hipDeviceGetAttribute(&cus, hipDeviceAttributeMultiprocessorCount, dev);
#if MK_ONE_LAUNCH
        const void* ks[] = {(const void*)k_mega};
#else
        const void* ks[] = {(const void*)k_prologue, (const void*)k_convert, (const void*)k_gemm_kv, (const void*)k_gemm_in, (const void*)k_mixers, (const void*)k_gemm_out, (const void*)k_ln1_router,
                            (const void*)k_scatter, (const void*)k_gemm_gu, (const void*)k_gemm_dn, (const void*)k_combine};
#endif
        for (const void* k : ks) if (hipFuncSetAttribute(k, hipFuncAttributeMaxDynamicSharedMemorySize, LDS_BYTES) != hipSuccess) { fprintf(stderr, "kernel_launch: hipFuncSetAttribute failed\n"); grid = -1; return; }
        grid = cus > 0 ? cus : 256; if (grid > 256) grid = 256;
#if MK_ONE_LAUNCH
        int per_cu = 0;
        if (hipOccupancyMaxActiveBlocksPerMultiprocessor(&per_cu, (const void*)k_mega, NTHREADS, LDS_BYTES) != hipSuccess || per_cu < 1) { fprintf(stderr, "kernel_launch: occupancy query says %d blocks per CU\n", per_cu); grid = -1; return; }
#endif
    }
    if (grid < 0) return;
    KArgs a{};
    for (int i = 0; i < 25; ++i) a.in[i] = (const float*)d_in[i];
    a.out = (float*)d_out; a.ws = (unsigned char*)d_ws; a.layer = 0; a.chunk = 0;
    const dim3 g(grid), b(NTHREADS);
#if MK_ONE_LAUNCH
    (void)hipMemsetAsync((char*)d_ws + WS_CTL, 0, 65536, stream);
    hipLaunchKernelGGL(k_mega, g, b, LDS_BYTES, stream, a);
#else
    hipLaunchKernelGGL(k_prologue, g, b, LDS_BYTES, stream, a);
    hipLaunchKernelGGL(k_gemm_kv, g, b, LDS_BYTES, stream, a);
    for (int l = 0; l < DEPTH; ++l) {
        a.layer = l; a.chunk = 0;
        hipLaunchKernelGGL(k_convert, g, b, LDS_BYTES, stream, a);
        hipLaunchKernelGGL(k_gemm_in, g, b, LDS_BYTES, stream, a);
        hipLaunchKernelGGL(k_mixers, g, b, LDS_BYTES, stream, a);
        hipLaunchKernelGGL(k_gemm_out, g, b, LDS_BYTES, stream, a);
        hipLaunchKernelGGL(k_ln1_router, g, b, LDS_BYTES, stream, a);
        hipLaunchKernelGGL(k_scatter, g, b, LDS_BYTES, stream, a);
        hipLaunchKernelGGL(k_gemm_gu, g, b, LDS_BYTES, stream, a);
        for (int c = 0; c < NCH; ++c) { a.chunk = c;
            hipLaunchKernelGGL(k_gemm_dn, g, b, LDS_BYTES, stream, a);
            hipLaunchKernelGGL(k_combine, g, b, LDS_BYTES, stream, a); }
    }
#endif
}
```

```cpp
#include <hip/hip_runtime.h>
#include <cstdio>
#include <cstdint>

#ifndef MK_ONE_LAUNCH
#define MK_ONE_LAUNCH 1
#endif
#ifndef PROBE_SUB
#define PROBE_SUB 0
#endif
#ifndef PROBE_T
#define PROBE_T 0
#define PROBE_TPH 10
#endif
#ifndef PROBE_DUP
#define PROBE_DUP 0
#endif

#define LAS __attribute__((address_space(3)))
typedef unsigned short bf16;
typedef short bf16x8 __attribute__((ext_vector_type(8)));
typedef float f32x4 __attribute__((ext_vector_type(4)));
typedef float f32x2 __attribute__((ext_vector_type(2)));
typedef unsigned u32x4 __attribute__((ext_vector_type(4)));
typedef unsigned u32x2 __attribute__((ext_vector_type(2)));

constexpr int D = 1024, NBATCH = 16, SEQ = 4096, T = NBATCH * SEQ, DEPTH = 4;
constexpr int MEMT = 256, MROWS = NBATCH * MEMT;
constexpr int NPROJ = 1280, POOL_CH = 256, CONV_CH = 256, MEM_CH = 512, HEADS = 4, HD = 128;
constexpr int NE = 64, TOPK = 8, EH = 256;
constexpr int NCH = 2, CH_TOK = T / NCH, CH_SLOTS = CH_TOK * TOPK + NE * 256, CH_TILES_MAX = CH_SLOTS / 256;
constexpr int TBLK = 256, NTB = T / TBLK, TB_PER_CH = NTB / NCH;
constexpr int SH_ROW0 = NCH * CH_SLOTS;
constexpr float LN_EPS = 1e-5f;
constexpr float ALPHA = 1.6817928305074290f;
constexpr float ROUTED_SCALE = 2.5f;

constexpr size_t MiB = 1u << 20;
constexpr size_t WS_CTL = 0;
constexpr size_t CTL_BYTES = 1 * MiB;
constexpr size_t WS_TAB = WS_CTL + CTL_BYTES;
constexpr size_t TAB_HIST = WS_TAB, TAB_NT = WS_TAB + 65536, TAB_TE = WS_TAB + 65536 + 256;
constexpr size_t WS_TOK = WS_TAB + 1 * MiB;
constexpr size_t TOK_E = WS_TOK, TOK_G = WS_TOK + 2 * MiB, TOK_R = WS_TOK + 4 * MiB, TOK_SLOT = WS_TOK + 6 * MiB;
constexpr size_t WS_ROW = WS_TOK + 8 * MiB;
constexpr size_t ROW_TOK = WS_ROW, ROW_GATE = WS_ROW + 2560 * 1024;
constexpr size_t WS_SMALLW = WS_ROW + 5 * MiB;
constexpr size_t W_RT = WS_SMALLW, W_PT = WS_SMALLW + 131072, W_DWT = WS_SMALLW + 196608, W_RTL = WS_SMALLW + 262144;
constexpr size_t WS_WIN = WS_SMALLW + 1 * MiB;
constexpr size_t WS_WOUT = WS_WIN + (size_t)NPROJ * D * 2;
constexpr size_t WS_WGU = WS_WOUT + (size_t)D * D * 2;
constexpr size_t WS_WD = WS_WGU + (size_t)NE * 512 * D * 2;
constexpr size_t WS_WSGU = WS_WD + (size_t)NE * D * EH * 2;
constexpr size_t WS_WSD = WS_WSGU + (size_t)512 * D * 2;
constexpr size_t WS_WKV = WS_WSD + (size_t)D * EH * 2;
constexpr size_t WS_MEMN = WS_WKV + (size_t)DEPTH * D * D * 2;
constexpr size_t WS_MEMP = WS_MEMN + (size_t)MROWS * D * 2;
constexpr size_t WS_KB = WS_MEMP + (size_t)MROWS * D * 2;
constexpr size_t WS_VT = WS_KB + (size_t)DEPTH * MROWS * MEM_CH * 2;
constexpr size_t WS_XB = WS_VT + (size_t)DEPTH * MROWS * MEM_CH * 2;
constexpr size_t WS_ZB = WS_XB + (size_t)T * D * 2;
constexpr size_t WS_U = WS_ZB + (size_t)T * D * 2;
constexpr size_t U_PROJ = WS_U, U_CAT = WS_U + (size_t)T * NPROJ * 2, U_H = WS_U;
constexpr size_t U_BYTES = (size_t)(NCH * CH_SLOTS + T) * EH * 2;
static_assert(U_BYTES >= (size_t)T * NPROJ * 2 + (size_t)T * D * 2, "union region");
constexpr size_t WS_Y = WS_U + U_BYTES;
constexpr size_t WS_END = WS_Y + (size_t)CH_SLOTS * D;
constexpr float Y_SCALE = 32.0f, Y_INV = 1.0f / 32.0f, Y_CLAMP = 240.0f;

constexpr int LDS_STAGE = 0, STAGE_BYTES = 131072;
constexpr int MAXU = 24;
constexpr int LDS_TBL = STAGE_BYTES, LDS_CTLW = LDS_TBL + MAXU * 1024, LDS_BYTES = LDS_CTLW + 1024;
constexpr int NTHREADS = 512, NWAVES = 8;

__device__ __forceinline__ unsigned cvt_pk_bf16(float lo, float hi) { unsigned r; asm volatile("v_cvt_pk_bf16_f32 %0, %1, %2" : "=v"(r) : "v"(lo), "v"(hi)); return r; }
__device__ __forceinline__ float bf2f(unsigned h) { return __uint_as_float(h << 16); }
template <int M> __device__ __forceinline__ float swz_xor(float v) { return __int_as_float(__builtin_amdgcn_ds_swizzle(__float_as_int(v), (M << 10) | 0x1f)); }
__device__ __forceinline__ float bperm_f(int srclane, float v) { return __int_as_float(__builtin_amdgcn_ds_bpermute(srclane << 2, __float_as_int(v))); }
__device__ __forceinline__ int bperm_i(int srclane, int v) { return __builtin_amdgcn_ds_bpermute(srclane << 2, v); }
__device__ __forceinline__ float dpp_f(float v, const int ctrl_sel) {
    const int x = __float_as_int(v);
    int r;
    if (ctrl_sel == 0) r = __builtin_amdgcn_update_dpp(x, x, 0xB1, 0xf, 0xf, false);
    else if (ctrl_sel == 1) r = __builtin_amdgcn_update_dpp(x, x, 0x4E, 0xf, 0xf, false);
    else if (ctrl_sel == 2) r = __builtin_amdgcn_update_dpp(x, x, 0x141, 0xf, 0xf, false);
    else r = __builtin_amdgcn_update_dpp(x, x, 0x140, 0xf, 0xf, false);
    return __int_as_float(r);
}
__device__ __forceinline__ float rl_f(float v, int l) { return __int_as_float(__builtin_amdgcn_readlane(__float_as_int(v), l)); }
__device__ __forceinline__ float wave_sum(float v, int lane) {
    (void)lane;
    v += dpp_f(v, 0); v += dpp_f(v, 1); v += dpp_f(v, 2); v += dpp_f(v, 3);
    return (rl_f(v, 0) + rl_f(v, 16)) + (rl_f(v, 32) + rl_f(v, 48));
}
__device__ __forceinline__ float wave_max(float v, int lane) {
    (void)lane;
    v = fmaxf(v, dpp_f(v, 0)); v = fmaxf(v, dpp_f(v, 1)); v = fmaxf(v, dpp_f(v, 2)); v = fmaxf(v, dpp_f(v, 3));
    return fmaxf(fmaxf(rl_f(v, 0), rl_f(v, 16)), fmaxf(rl_f(v, 32), rl_f(v, 48)));
}
__device__ __forceinline__ float fast_sigmoid(float x) { return __builtin_amdgcn_rcpf(1.0f + __builtin_amdgcn_exp2f(-1.4426950408889634f * x)); }
__device__ __forceinline__ float fast_silu(float x) { return x * fast_sigmoid(x); }
__device__ __forceinline__ f32x2 fast_sigmoid2(const f32x2 x) { const f32x2 t = x * (f32x2){-1.4426950408889634f, -1.4426950408889634f};
    f32x2 e = (f32x2){__builtin_amdgcn_exp2f(t[0]), __builtin_amdgcn_exp2f(t[1])}; e = e + (f32x2){1.0f, 1.0f}; return (f32x2){__builtin_amdgcn_rcpf(e[0]), __builtin_amdgcn_rcpf(e[1])}; }
#define LDS_WAIT() asm volatile("s_waitcnt lgkmcnt(0)" ::: "memory")
__device__ __forceinline__ void unpack8(const u32x4 w, float* f) { f[0] = bf2f(w.x & 0xffffu); f[1] = bf2f(w.x >> 16); f[2] = bf2f(w.y & 0xffffu); f[3] = bf2f(w.y >> 16); f[4] = bf2f(w.z & 0xffffu); f[5] = bf2f(w.z >> 16); f[6] = bf2f(w.w & 0xffffu); f[7] = bf2f(w.w >> 16); }
__device__ __forceinline__ void addpack8(const u32x4 w, float* f) { f[0] += bf2f(w.x & 0xffffu); f[1] += bf2f(w.x >> 16); f[2] += bf2f(w.y & 0xffffu); f[3] += bf2f(w.y >> 16); f[4] += bf2f(w.z & 0xffffu); f[5] += bf2f(w.z >> 16); f[6] += bf2f(w.w & 0xffffu); f[7] += bf2f(w.w >> 16); }
__device__ __forceinline__ u32x4 pack8(const float* f) { u32x4 w; w.x = cvt_pk_bf16(f[0], f[1]); w.y = cvt_pk_bf16(f[2], f[3]); w.z = cvt_pk_bf16(f[4], f[5]); w.w = cvt_pk_bf16(f[6], f[7]); return w; }
__device__ __forceinline__ void ln_row16(float* v, const float* g, const float* b, int lane) {
    float s = 0.f;
#pragma unroll
    for (int i = 0; i < 16; ++i) s += v[i];
    const float mean = wave_sum(s, lane) * (1.f / D); float s2 = 0.f;
#pragma unroll
    for (int i = 0; i < 16; ++i) { v[i] -= mean; s2 += v[i] * v[i]; }
    const float rstd = __builtin_amdgcn_rsqf(wave_sum(s2, lane) * (1.f / D) + LN_EPS);
#pragma unroll
    for (int j = 0; j < 2; ++j) { const f32x4 g0 = *(const f32x4*)(g + 8 * lane + 512 * j), g1 = *(const f32x4*)(g + 8 * lane + 512 * j + 4), b0 = *(const f32x4*)(b + 8 * lane + 512 * j), b1 = *(const f32x4*)(b + 8 * lane + 512 * j + 4);
#pragma unroll
        for (int i = 0; i < 4; ++i) { v[8 * j + i] = v[8 * j + i] * rstd * g0[i] + b0[i]; v[8 * j + 4 + i] = v[8 * j + 4 + i] * rstd * g1[i] + b1[i]; } }
}
#define RSRC_W3 0x00020000
__device__ __forceinline__ bf16x8 bufld8(__amdgpu_buffer_rsrc_t rs, unsigned voff, unsigned soff) { const u32x4 v = __builtin_amdgcn_raw_buffer_load_b128(rs, (int)voff, (int)soff, 0); return __builtin_bit_cast(bf16x8, v); }

#define XB_TMO      128
#define XB_XCNT(j)  (256  + 64 * (j))
#define XB_XSUB(j)  (1280 + 64 * (j))
#define XB_XGEN(j)  (2304 + 64 * (j))
#define XB_TOP      3328
#define XB_TOPGEN   3392
#define XCD_BAR_WORDS 3456
#define XB_SPIN_CAP (1u << 18)
__device__ __forceinline__ unsigned xb_ld(unsigned* p)              { return __hip_atomic_load(p, __ATOMIC_RELAXED, __HIP_MEMORY_SCOPE_AGENT); }
__device__ __forceinline__ unsigned xb_add(unsigned* p, unsigned v) { return __hip_atomic_fetch_add(p, v, __ATOMIC_RELAXED, __HIP_MEMORY_SCOPE_AGENT); }
__device__ __forceinline__ unsigned xb_xcc_id() { return (unsigned)__builtin_amdgcn_s_getreg((3 << 11) | 20) & 0xFu; }
#define XB_SPIN(cond, bar) do { unsigned _sp = 0; while (cond) { __builtin_amdgcn_s_sleep(1); \
    if ((++_sp & 255u) == 0u) { if (xb_ld(&(bar)[XB_TMO])) break; if (_sp > XB_SPIN_CAP) { atomicAdd(&(bar)[XB_TMO], 1u); break; } } } } while (0)
struct XcdBarrier { unsigned* bar; unsigned x; volatile LAS unsigned* st; };
__device__ __forceinline__ XcdBarrier xcd_barrier_post(unsigned* bar, volatile LAS unsigned* st, int tid) {
    XcdBarrier b; b.bar = bar; b.x = xb_xcc_id(); b.st = st;
    if (tid == 0) (void)xb_add(&bar[XB_XCNT(b.x)], 1u);
    return b;
}
__device__ __forceinline__ void xcd_barrier_complete(unsigned* bar, unsigned x, unsigned& nloc, unsigned& nx) {
    const unsigned G = gridDim.x * gridDim.y * gridDim.z;
    unsigned sum, cnt, mine, sp = 0u;
    for (;;) {
        sum = 0u; cnt = 0u; mine = 0u;
#pragma unroll
        for (unsigned j = 0; j < 16; ++j) { const unsigned c = xb_ld(&bar[XB_XCNT(j)]); sum += c; cnt += (c > 0u) ? 1u : 0u; mine = (j == x) ? c : mine; }
        if (sum == G) break;
        __builtin_amdgcn_s_sleep(1);
        if ((++sp & 255u) == 0u) { if (xb_ld(&bar[XB_TMO])) break; if (sp > XB_SPIN_CAP) { atomicAdd(&bar[XB_TMO], 1u); break; } }
    }
    nloc = mine > 0u ? mine : 1u; nx = cnt > 0u ? cnt : 1u;
}
__device__ __forceinline__ void xcd_barrier(const XcdBarrier& b, int tid) {
    asm volatile("s_waitcnt vmcnt(0)" ::: "memory");
    __syncthreads();
    if (tid == 0) {
        unsigned* bar = b.bar;
        __builtin_amdgcn_s_waitcnt(0);
        unsigned nloc = b.st[0], nx = b.st[1];
        if (nloc == 0u) { xcd_barrier_complete(bar, b.x, nloc, nx); b.st[0] = nloc; b.st[1] = nx; }
        const unsigned old = xb_add(&bar[XB_XSUB(b.x)], 1u);
        const unsigned gen = old / nloc;
        if (old + 1u == (gen + 1u) * nloc) {
            __builtin_amdgcn_fence(__ATOMIC_RELEASE, "agent");
            asm volatile("s_waitcnt vmcnt(0)" ::: "memory");
            const unsigned og = xb_add(&bar[XB_TOP], 1u);
            const unsigned tg = og / nx;
            if (og + 1u == (tg + 1u) * nx) xb_add(&bar[XB_TOPGEN], 1u);
            else XB_SPIN(xb_ld(&bar[XB_TOPGEN]) == tg, bar);
            __builtin_amdgcn_fence(__ATOMIC_ACQUIRE, "agent");
            xb_add(&bar[XB_XGEN(b.x)], 1u);
            asm volatile("s_waitcnt vmcnt(0)" ::: "memory");
        } else {
            XB_SPIN(xb_ld(&bar[XB_XGEN(b.x)]) == gen, bar);
            __builtin_amdgcn_fence(__ATOMIC_ACQUIRE, "agent");
            asm volatile("s_waitcnt vmcnt(0)" ::: "memory");
        }
    }
    __syncthreads();
}

__device__ __forceinline__ void grid_bar(const XcdBarrier& b0, int wave_s) {
    unsigned* bp = b0.bar; unsigned x = b0.x; unsigned st = (unsigned)(uintptr_t)b0.st;
    asm volatile("" : "+s"(bp), "+s"(x), "+s"(st));
    XcdBarrier b; b.bar = bp; b.x = x; b.st = (volatile LAS unsigned*)(uintptr_t)st;
    int z = 0; asm volatile("" : "+v"(z)); const int tid = (wave_s << 6) | (int)__builtin_amdgcn_mbcnt_hi(~0u, __builtin_amdgcn_mbcnt_lo(~0u, (unsigned)z));
    xcd_barrier(b, tid);
}

namespace ge {
constexpr int BM = 256, BK = 64, HALF = 128, HTB = HALF * BK * 2, NXCD = 8, WGM = 8;
__device__ __forceinline__ void stage_rc(int b, int& R, int& C) { const int row = b >> 7, pos = (b >> 4) & 7; R = row; C = (pos ^ ((row >> 1) & 7)) * 8; }
__device__ __forceinline__ int perm32(int rho) { const int n = rho >> 4, i = rho & 15; return 8 * (i >> 2) + 4 * n + (i & 3); }
__device__ __forceinline__ int xcd_remap(int L, int n) { const int q = n / NXCD, r = n % NXCD, xcd = L % NXCD, off = L / NXCD; return (xcd < r ? xcd * (q + 1) : r * (q + 1) + (xcd - r) * q) + off; }

struct Unit {
    const char* A;
    const char* B;
    char* O;
    int ldc, row0, col0, aux, tbl;
};

template <int K, bool GATHER, class Epi, class Sched, int PT = 0, int BPERM = 0>
__device__ __forceinline__ void gemm_phase(const int tid, LAS unsigned char* lds, const LAS int* tbl, const Sched& S, const Epi& E) {
    const int wid = __builtin_amdgcn_readfirstlane(tid >> 6), lane = tid & 63, wr = wid >> 2, wc = wid & 3, fr = lane & 15, fq = lane >> 4;
    constexpr int nt = K / BK;
    static_assert(K % 128 == 0 && K >= 256, "K");
    int Rr[2], Cc[2]; unsigned voffB[2][2];
#pragma unroll
    for (int i = 0; i < 2; ++i) { int R, C; stage_rc(tid * 16 + i * 8192, R, C); Rr[i] = R; Cc[i] = C;
#pragma unroll
        for (int h = 0; h < 2; ++h) { const int Rb = BPERM ? (64 * (R >> 5) + 16 * ((R & 15) >> 2) + 8 * h + 4 * ((R >> 4) & 1) + (R & 3)) : (128 * h + (R & ~31) + perm32(R & 31));
            voffB[h][i] = (unsigned)(Rb * K + C) * 2u; } }
    constexpr size_t kstep = (size_t)(BK * 2);
    constexpr size_t hstep = (size_t)HALF * K * 2;
    const unsigned ldsw = (unsigned)wid * 1024u;
    int aoffk[2], boffk[2];
#pragma unroll
    for (int k = 0; k < 2; ++k) { const int pos = ((4 * k + fq) ^ ((fr >> 1) & 7)) << 4; aoffk[k] = (wr * 64 + fr) * 128 + pos; boffk[k] = (wc * 32 + fr) * 128 + pos; }
#define GE_SA(b, h) (((b) * 2 + (h)) * HTB)
#define GE_SB(b, h) ((4 + (b) * 2 + (h)) * HTB)
#define GE_RSRC(p) __builtin_amdgcn_make_buffer_rsrc((void*)(p), (short)0, 0x7fffffff, RSRC_W3)
#define GE_STAGE_B(bufoff, gbase, h) do { const __amdgpu_buffer_rsrc_t _rs = GE_RSRC(gbase); _Pragma("unroll") for (int _i = 0; _i < 2; ++_i) \
        __builtin_amdgcn_raw_ptr_buffer_load_lds(_rs, (LAS void*)(lds + (bufoff) + ldsw + _i * 8192), 16, (int)voffB[h][_i], 0, 0, 0); } while (0)
#define GE_STAGE_A(bufoff, gbase, o0, o1) do { const __amdgpu_buffer_rsrc_t _rs = GE_RSRC(gbase); \
        __builtin_amdgcn_raw_ptr_buffer_load_lds(_rs, (LAS void*)(lds + (bufoff) + ldsw), 16, (int)(o0), 0, 0, 0); \
        __builtin_amdgcn_raw_ptr_buffer_load_lds(_rs, (LAS void*)(lds + (bufoff) + ldsw + 8192), 16, (int)(o1), 0, 0, 0); } while (0)
#define GE_LDA(dst, b, h) do { _Pragma("unroll") for (int m = 0; m < 4; ++m) _Pragma("unroll") for (int k = 0; k < 2; ++k) dst[m][k] = *(const LAS bf16x8*)(lds + GE_SA(b, h) + aoffk[k] + m * 2048); } while (0)
#define GE_LDB(dst, b, h) do { _Pragma("unroll") for (int n = 0; n < 2; ++n) _Pragma("unroll") for (int k = 0; k < 2; ++k) dst[n][k] = *(const LAS bf16x8*)(lds + GE_SB(b, h) + boffk[k] + n * 2048); } while (0)
#define GE_MMA(ai, bj, At, Bt) do { __builtin_amdgcn_s_setprio(1); _Pragma("unroll") for (int m = 0; m < 4; ++m) _Pragma("unroll") for (int n = 0; n < 2; ++n) _Pragma("unroll") for (int k = 0; k < 2; ++k) \
        acc[ai][bj][m][n] = __builtin_amdgcn_mfma_f32_16x16x32_bf16(Bt[n][k], At[m][k], acc[ai][bj][m][n], 0, 0, 0); __builtin_amdgcn_s_setprio(0); } while (0)
#define GE_WAIT_V(n) asm volatile("s_waitcnt vmcnt(" #n ")" ::: "memory")
#define GE_WAIT_L(n) asm volatile("s_waitcnt lgkmcnt(" #n ")" ::: "memory")
#define GE_BAR __builtin_amdgcn_s_barrier()
#define GE_SCHED __builtin_amdgcn_sched_barrier(0)
#define GE_LOAD_VA(dst, u) do { _Pragma("unroll") for (int _h = 0; _h < 2; ++_h) _Pragma("unroll") for (int _i = 0; _i < 2; ++_i) { \
        if constexpr (GATHER) dst[_h][_i] = (unsigned)tbl[(u).tbl * 256 + _h * 128 + Rr[_i]] * (unsigned)(K * 2) + (unsigned)(Cc[_i] * 2); \
        else dst[_h][_i] = (unsigned)((_h * 128 + Rr[_i]) * K + Cc[_i]) * 2u; } } while (0)
    Unit cur, nxt; int ui = 0;
    if (!S.next(0, cur)) return;
    f32x4 acc[2][2][4][2];
#pragma unroll
    for (int a = 0; a < 2; ++a)
#pragma unroll
        for (int b = 0; b < 2; ++b)
#pragma unroll
            for (int m = 0; m < 4; ++m)
#pragma unroll
                for (int n = 0; n < 2; ++n) acc[a][b][m][n] = (f32x4){0.f, 0.f, 0.f, 0.f};
    bf16x8 At[4][2], B0[2][2], B1[2][2];
    unsigned va[2][2], vn[2][2];
    GE_LOAD_VA(va, cur);
#pragma unroll
    for (int h = 0; h < 2; ++h)
#pragma unroll
        for (int i = 0; i < 2; ++i) vn[h][i] = va[h][i];
    const char* cA = cur.A; const char* cB = cur.B;
    GE_STAGE_B(GE_SB(0, 0), cB, 0); GE_STAGE_B(GE_SB(0, 1), cB, 1); GE_STAGE_A(GE_SA(0, 0), cA, va[0][0], va[0][1]); GE_STAGE_A(GE_SA(0, 1), cA, va[1][0], va[1][1]);
    if (wr == 1) GE_BAR;
    GE_WAIT_V(2); GE_BAR;
    GE_STAGE_B(GE_SB(1, 0), cB + kstep, 0); GE_STAGE_A(GE_SA(1, 0), cA + kstep, va[0][0], va[0][1]); GE_STAGE_B(GE_SB(1, 1), cB + kstep, 1);
    GE_WAIT_V(6); GE_BAR;
    unsigned long long pt_acc = 0, pt_t0 = PT ? __builtin_amdgcn_s_memtime() : 0ull;
    for (;;) {
        if (PT == 3) pt_t0 = __builtin_amdgcn_s_memtime();
        const bool has_next = S.next(ui + 1, nxt);
        const char* nA = has_next ? nxt.A : cA; const char* nB = has_next ? nxt.B : cB;
        if (PT == 3) pt_acc += __builtin_amdgcn_s_memtime() - pt_t0;
        if (PT == 1) pt_t0 = __builtin_amdgcn_s_memtime();
        for (int t = 0; t < nt; t += 2) {
            const bool last = (t == nt - 2);
            if (last && has_next) { GE_LOAD_VA(vn, nxt); }
            const char* a1 = cA + (size_t)(t + 1) * kstep;
            const char* a2 = last ? nA : cA + (size_t)(t + 2) * kstep; const char* b2 = last ? nB : cB + (size_t)(t + 2) * kstep;
            const char* a3 = a2 + kstep; const char* b3 = b2 + kstep;
            const unsigned x00 = last ? vn[0][0] : va[0][0], x01 = last ? vn[0][1] : va[0][1], x10 = last ? vn[1][0] : va[1][0], x11 = last ? vn[1][1] : va[1][1];
            GE_LDB(B0, 0, 0); GE_LDB(B1, 0, 1); GE_SCHED; GE_LDA(At, 0, 0); GE_STAGE_A(GE_SA(1, 1), a1, va[1][0], va[1][1]);
            GE_WAIT_V(8); GE_WAIT_L(0); GE_BAR; GE_MMA(0, 0, At, B0); GE_MMA(0, 1, At, B1); GE_BAR; GE_SCHED;
            GE_LDA(At, 0, 1); GE_STAGE_B(GE_SB(0, 0), b2, 0); GE_STAGE_B(GE_SB(0, 1), b2, 1); GE_STAGE_A(GE_SA(0, 0), a2, x00, x01);
            GE_WAIT_V(8); GE_WAIT_L(0); GE_BAR; GE_MMA(1, 0, At, B0); GE_MMA(1, 1, At, B1); GE_BAR; GE_SCHED;
            GE_LDB(B0, 1, 0); GE_LDB(B1, 1, 1); GE_SCHED; GE_LDA(At, 1, 0); GE_STAGE_A(GE_SA(0, 1), a2, x10, x11);
            GE_WAIT_V(8); GE_WAIT_L(0); GE_BAR; GE_MMA(0, 0, At, B0); GE_MMA(0, 1, At, B1); GE_BAR; GE_SCHED;
            GE_LDA(At, 1, 1); GE_STAGE_B(GE_SB(1, 0), b3, 0); GE_STAGE_B(GE_SB(1, 1), b3, 1); GE_STAGE_A(GE_SA(1, 0), a3, x00, x01);
            GE_WAIT_V(8); GE_WAIT_L(0); GE_BAR; GE_MMA(1, 0, At, B0); GE_MMA(1, 1, At, B1); GE_BAR; GE_SCHED;
        }
        if (PT == 1) pt_acc += __builtin_amdgcn_s_memtime() - pt_t0;
        if (PT == 3) pt_t0 = __builtin_amdgcn_s_memtime();
        if (wr == 0) GE_BAR;
        if (PT == 3) pt_acc += __builtin_amdgcn_s_memtime() - pt_t0;
        if (PT == 2) pt_t0 = __builtin_amdgcn_s_memtime();
        E(acc, cur, wr, wc, fr, fq);
        if (PT == 2) { asm volatile("s_waitcnt vmcnt(0)" ::: "memory"); pt_acc += __builtin_amdgcn_s_memtime() - pt_t0; }
        if (PT == 3) pt_t0 = __builtin_amdgcn_s_memtime();
        if (!has_next) break;
#pragma unroll
        for (int a = 0; a < 2; ++a)
#pragma unroll
            for (int b = 0; b < 2; ++b)
#pragma unroll
                for (int m = 0; m < 4; ++m)
#pragma unroll
                    for (int n = 0; n < 2; ++n) acc[a][b][m][n] = (f32x4){0.f, 0.f, 0.f, 0.f};
        cur = nxt; cA = nA; cB = nB; ++ui;
#pragma unroll
        for (int h = 0; h < 2; ++h)
#pragma unroll
            for (int i = 0; i < 2; ++i) va[h][i] = vn[h][i];
        if (wr == 1) GE_BAR;
        if (PT == 3) pt_acc += __builtin_amdgcn_s_memtime() - pt_t0;
    }
    GE_WAIT_V(0);
    GE_BAR;
    if (PT) { const unsigned long long t1 = __builtin_amdgcn_s_memtime(); while (__builtin_amdgcn_s_memtime() - t1 < pt_acc) __builtin_amdgcn_s_sleep(8); }
#undef GE_SA
#undef GE_SB
#undef GE_STAGE_A
#undef GE_STAGE_B
#undef GE_RSRC
#undef GE_LDA
#undef GE_LDB
#undef GE_MMA
#undef GE_WAIT_V
#undef GE_WAIT_L
#undef GE_BAR
#undef GE_SCHED
#undef GE_LOAD_VA
}

struct EpiBf16 {
    __device__ __forceinline__ void operator()(const f32x4 (&acc)[2][2][4][2], const Unit& u, int wr, int wc, int fr, int fq) const {
        asm volatile("" : "+v"(fr), "+v"(fq));
#pragma unroll
        for (int ai = 0; ai < 2; ++ai)
#pragma unroll
            for (int m = 0; m < 4; ++m) { bf16* rowp = (bf16*)u.O + (size_t)(u.row0 + ai * HALF + wr * 64 + m * 16 + fr) * u.ldc + u.col0 + wc * 32 + 8 * fq;
#pragma unroll
                for (int bj = 0; bj < 2; ++bj) { const f32x4 v0 = acc[ai][bj][m][0], v1 = acc[ai][bj][m][1];
                    u32x4 w; w.x = cvt_pk_bf16(v0[0], v0[1]); w.y = cvt_pk_bf16(v0[2], v0[3]); w.z = cvt_pk_bf16(v1[0], v1[1]); w.w = cvt_pk_bf16(v1[2], v1[3]);
                    *(u32x4*)(rowp + bj * HALF) = w; } }
    }
};
__device__ __forceinline__ u32x4 res_pack(const u32x4 r, const f32x4 a0, const f32x4 a1) {
    u32x4 w;
    w.x = cvt_pk_bf16(bf2f(r.x & 0xffffu) * ALPHA + a0[0], bf2f(r.x >> 16) * ALPHA + a0[1]); w.y = cvt_pk_bf16(bf2f(r.y & 0xffffu) * ALPHA + a0[2], bf2f(r.y >> 16) * ALPHA + a0[3]);
    w.z = cvt_pk_bf16(bf2f(r.z & 0xffffu) * ALPHA + a1[0], bf2f(r.z >> 16) * ALPHA + a1[1]); w.w = cvt_pk_bf16(bf2f(r.w & 0xffffu) * ALPHA + a1[2], bf2f(r.w >> 16) * ALPHA + a1[3]);
    return w;
}
struct EpiResBf16 {
    const bf16* res; bf16* out;
    __device__ __forceinline__ void operator()(const f32x4 (&acc)[2][2][4][2], const Unit& u, int wr, int wc, int fr, int fq) const {
        asm volatile("" : "+v"(fr), "+v"(fq));
#pragma unroll
        for (int ai = 0; ai < 2; ++ai) {
            u32x4 r[4][2];
#pragma unroll
            for (int m = 0; m < 4; ++m)
#pragma unroll
                for (int bj = 0; bj < 2; ++bj) r[m][bj] = *(const u32x4*)(res + (size_t)(u.row0 + ai * HALF + wr * 64 + m * 16 + fr) * D + u.col0 + wc * 32 + 8 * fq + bj * HALF);
#pragma unroll
            for (int m = 0; m < 4; ++m)
#pragma unroll
                for (int bj = 0; bj < 2; ++bj) *(u32x4*)(out + (size_t)(u.row0 + ai * HALF + wr * 64 + m * 16 + fr) * D + u.col0 + wc * 32 + 8 * fq + bj * HALF) = res_pack(r[m][bj], acc[ai][bj][m][0], acc[ai][bj][m][1]);
            asm volatile("" ::: "memory"); }
    }
};
struct EpiSwiGLU {
    __device__ __forceinline__ void operator()(const f32x4 (&acc)[2][2][4][2], const Unit& u, int wr, int wc, int fr, int fq) const {
        asm volatile("" : "+v"(fr), "+v"(fq));
#pragma unroll
        for (int ai = 0; ai < 2; ++ai)
#pragma unroll
            for (int m = 0; m < 4; ++m) { bf16* rowp = (bf16*)u.O + (size_t)(u.row0 + ai * HALF + wr * 64 + m * 16 + fr) * EH + u.col0 + wc * 32 + 8 * fq;
                const f32x4 g0 = acc[ai][0][m][0], g1 = acc[ai][0][m][1], u0 = acc[ai][1][m][0], u1 = acc[ai][1][m][1];
                f32x2 v[4];
#pragma unroll
                for (int j = 0; j < 2; ++j) { const f32x2 ga = (f32x2){g0[2 * j], g0[2 * j + 1]}, gb = (f32x2){g1[2 * j], g1[2 * j + 1]};
                    v[j] = ga * fast_sigmoid2(ga) * (f32x2){u0[2 * j], u0[2 * j + 1]}; v[2 + j] = gb * fast_sigmoid2(gb) * (f32x2){u1[2 * j], u1[2 * j + 1]}; }
                u32x4 w; w.x = cvt_pk_bf16(v[0][0], v[0][1]); w.y = cvt_pk_bf16(v[1][0], v[1][1]); w.z = cvt_pk_bf16(v[2][0], v[2][1]); w.w = cvt_pk_bf16(v[3][0], v[3][1]);
                *(u32x4*)rowp = w; }
    }
};
struct EpiDown {
    static constexpr int VM_OPS = 8;
    const float* gate; const bf16* res;
    __device__ __forceinline__ void operator()(const f32x4 (&acc)[2][2][4][2], const Unit& u, int wr, int wc, int fr, int fq) const {
        asm volatile("" : "+v"(fr), "+v"(fq));
        if (u.aux >= 0) {
#pragma unroll
            for (int ai = 0; ai < 2; ++ai)
#pragma unroll
                for (int m = 0; m < 4; ++m) { const int r = ai * HALF + wr * 64 + m * 16 + fr;
                    unsigned char* rowp = (unsigned char*)u.O + ((size_t)(u.row0 >> 8) * 4 + (u.col0 >> 8)) * 65536 + r * 256 + wc * 64 + 16 * fq;
                    u32x4 w;
#pragma unroll
                    for (int bj = 0; bj < 2; ++bj) { f32x4 v0 = acc[ai][bj][m][0] * Y_SCALE, v1 = acc[ai][bj][m][1] * Y_SCALE;
#pragma unroll
                        for (int j = 0; j < 4; ++j) { v0[j] = __builtin_amdgcn_fmed3f(v0[j], -Y_CLAMP, Y_CLAMP); v1[j] = __builtin_amdgcn_fmed3f(v1[j], -Y_CLAMP, Y_CLAMP); }
                        int w0 = 0, w1 = 0;
                        w0 = __builtin_amdgcn_cvt_pk_fp8_f32(v0[0], v0[1], w0, false); w0 = __builtin_amdgcn_cvt_pk_fp8_f32(v0[2], v0[3], w0, true);
                        w1 = __builtin_amdgcn_cvt_pk_fp8_f32(v1[0], v1[1], w1, false); w1 = __builtin_amdgcn_cvt_pk_fp8_f32(v1[2], v1[3], w1, true);
                        w[2 * bj] = (unsigned)w0; w[2 * bj + 1] = (unsigned)w1; }
                    *(u32x4*)rowp = w; }
        } else {
            bf16* out = (bf16*)u.O;
#pragma unroll
            for (int ai = 0; ai < 2; ++ai) {
                u32x4 r[4][2];
#pragma unroll
                for (int m = 0; m < 4; ++m)
#pragma unroll
                    for (int bj = 0; bj < 2; ++bj) r[m][bj] = *(const u32x4*)(res + (size_t)(u.row0 + ai * HALF + wr * 64 + m * 16 + fr) * D + u.col0 + wc * 64 + 16 * fq + 8 * bj);
#pragma unroll
                for (int m = 0; m < 4; ++m)
#pragma unroll
                    for (int bj = 0; bj < 2; ++bj) *(u32x4*)(out + (size_t)(u.row0 + ai * HALF + wr * 64 + m * 16 + fr) * D + u.col0 + wc * 64 + 16 * fq + 8 * bj) = res_pack(r[m][bj], acc[ai][bj][m][0], acc[ai][bj][m][1]);
                asm volatile("" ::: "memory"); }
        }
    }
};

template <int K> struct SchedDense {
    const char* A; const char* B; char* O; int ldc, nM, nN, G, c;
    __device__ __forceinline__ bool next(int i, Unit& u) const {
        const int nwg = nM * nN; const long L = (long)i * G + c; if (L >= nwg) return false;
        const int wgid = xcd_remap((int)L, nwg);
        const int nig = WGM * nN, gid = wgid / nig, fm = gid * WGM, gsz = (nM - fm) < WGM ? (nM - fm) : WGM;
        const int pm = fm + ((wgid % nig) % gsz), pn = (wgid % nig) / gsz;
        u.A = A + (size_t)pm * (256 * K * 2); u.B = B + (size_t)pn * (256 * K * 2); u.O = O; u.ldc = ldc; u.row0 = pm * 256; u.col0 = pn * 256; u.aux = 0; u.tbl = 0; return true;
    }
};
struct SchedKV {
    const char* memn; const char* memp; const char* wkv; char* kb; char* vt; int G, c;
    __device__ __forceinline__ bool next(int i, Unit& u) const {
        const long L = (long)i * G + c; if (L >= 256) return false;
        const int idx = (int)L, l = idx >> 6, r = idx & 63; u.aux = 0; u.tbl = 0;
        const char* w = wkv + (size_t)l * D * D * 2;
        if (r < 32) { const int pm = r >> 1, pn = r & 1;
            u.A = memn + (size_t)pm * 256 * D * 2; u.B = w + (size_t)pn * 256 * D * 2; u.O = kb + (size_t)l * MROWS * MEM_CH * 2; u.ldc = MEM_CH; u.row0 = pm * 256; u.col0 = pn * 256; }
        else { const int q = r - 32, pm = q >> 4, pn = q & 15;
            u.A = w + (size_t)(512 + pm * 256) * D * 2; u.B = memp + (size_t)pn * 256 * D * 2; u.O = vt + (size_t)l * MROWS * MEM_CH * 2; u.ldc = MROWS; u.row0 = pm * 256; u.col0 = pn * 256; }
        return true;
    }
};
struct SchedGU {
    const char* xb; const char* wgu; const char* wsgu; char* h; const int* ntiles; const int* tile_e; int G, c;
    int nt_[NCH];
    __device__ __forceinline__ void init() {
#pragma unroll
        for (int q = 0; q < NCH; ++q) nt_[q] = ntiles[q]; }
    __device__ __forceinline__ bool next(int i, Unit& u) const {
        int ntot = T / 256;
#pragma unroll
        for (int q = 0; q < NCH; ++q) ntot += nt_[q];
        const int nun = ntot * 2; const long L = (long)i * G + c; if (L >= nun || i >= MAXU) return false;
        const int idx = xcd_remap((int)L, nun), pn = idx & 1; int rt = idx >> 1;
        u.A = xb; u.O = h; u.ldc = EH; u.col0 = pn * 128; u.tbl = i;
        int ch = -1, lt = 0;
#pragma unroll
        for (int q = 0; q < NCH; ++q) { if (ch < 0) { if (rt < nt_[q]) { ch = q; lt = rt; } else rt -= nt_[q]; } }
        if (ch >= 0) { const int e = tile_e[ch * CH_TILES_MAX + lt]; u.B = wgu + (size_t)e * 512 * D * 2 + (size_t)pn * 256 * D * 2; u.row0 = ch * CH_SLOTS + lt * 256; u.aux = -1; }
        else { u.B = wsgu + (size_t)pn * 256 * D * 2; u.row0 = SH_ROW0 + rt * 256; u.aux = rt * 256; }
        return true;
    }
};
struct SchedDN {
    const char* h; const char* wd; const char* wsd; char* y; char* dout; const int* tile_e; int ch, nt, G, c;
    __device__ __forceinline__ bool next(int i, Unit& u) const {
        const int nun = (CH_TOK / 256 + nt) * 4; const long L = (long)i * G + c; if (L >= nun) return false;
        const int idx = xcd_remap((int)L, nun), pn = idx & 3; const int p = idx >> 2; u.tbl = 0; u.ldc = D; u.col0 = pn * 256;
        constexpr int NS = CH_TOK / 256; const int R = NS + nt;
        const int c0 = (int)(((long)p * NS) / R), c1 = (int)(((long)(p + 1) * NS) / R);
        int rt = (c1 > c0) ? c0 : NS + (p - c0);
        if (rt < CH_TOK / 256) { const int row = ch * CH_TOK + rt * 256; u.A = h + (size_t)(SH_ROW0 + row) * EH * 2; u.B = wsd + (size_t)pn * 256 * EH * 2; u.O = dout; u.row0 = row; u.aux = -1; }
        else { rt -= CH_TOK / 256; const int e = tile_e[ch * CH_TILES_MAX + rt]; const int slot0 = ch * CH_SLOTS + rt * 256;
            u.A = h + (size_t)slot0 * EH * 2; u.B = wd + (size_t)e * D * EH * 2 + (size_t)pn * 256 * EH * 2; u.O = y; u.row0 = rt * 256; u.aux = slot0; }
        return true;
    }
};
}

struct KArgs { const float* in[25]; float* out; unsigned char* ws; int layer; int chunk; };
typedef const __attribute__((address_space(4))) KArgs* KArgP;
#define KA_OPAQUE(p) asm volatile("" : "+s"(p))
#define PHASE_BEGIN() int z_ = 0; asm volatile("" : "+v"(z_)); int tid = (wave_s << 6) | (int)__builtin_amdgcn_mbcnt_hi(~0u, __builtin_amdgcn_mbcnt_lo(~0u, (unsigned)z_)); asm volatile("" : "+v"(tid)); asm volatile("" : "+s"(bid), "+s"(G)); KA_OPAQUE(ka)
enum { I_X = 0, I_MEM, I_WIN, I_WPOOL, I_PSCALE, I_WDW, I_BDW, I_CNG, I_CNB, I_WKV, I_WOUT, I_LN1G, I_LN1B, I_WR, I_RB, I_WG, I_WU, I_WD, I_WGS, I_WUS, I_WDS, I_LN2G, I_LN2B, I_MNG, I_MNB };

__device__ __forceinline__ void transpose_item(const float* W, int N, bf16* WT, int ldk, int row_off, LAS float* scr, int k0, int n0, int lane, bf16* WTlo = nullptr) {
    { f32x4 ld[8]; const int c4 = lane & 7, kr = lane >> 3;
#pragma unroll
        for (int i = 0; i < 8; ++i) ld[i] = __builtin_nontemporal_load((const f32x4*)(W + (size_t)(k0 + kr + 8 * i) * N + n0 + 4 * c4));
#pragma unroll
        for (int i = 0; i < 8; ++i) { LAS float* d = scr + (kr + 8 * i) * 33 + 4 * c4; d[0] = ld[i][0]; d[1] = ld[i][1]; d[2] = ld[i][2]; d[3] = ld[i][3]; } }
    LDS_WAIT(); asm volatile("" ::: "memory");
    const int c = lane & 7;
#pragma unroll
    for (int j = 0; j < 4; ++j) { const int n = (lane >> 3) + 8 * j; const LAS float* s = scr + (8 * c) * 33 + n;
        float f[8];
#pragma unroll
        for (int i = 0; i < 8; ++i) f[i] = s[i * 33];
        const u32x4 o = pack8(f);
        *(u32x4*)(WT + (size_t)(row_off + n) * ldk + k0 + 8 * c) = o;
        if (WTlo) { float h[8]; unpack8(o, h);
#pragma unroll
            for (int i = 0; i < 8; ++i) f[i] -= h[i];
            *(u32x4*)(WTlo + (size_t)(row_off + n) * ldk + k0 + 8 * c) = pack8(f); } }
    LDS_WAIT(); asm volatile("" ::: "memory");
}

struct CItem { const float* src; bf16* dst; int ld, ldk, k0, gu_half; };
__device__ __forceinline__ CItem cdecode(KArgP ka, unsigned char* ws, int l, int it) {
    if (it < 2 * NE * 16) { const int half = it / (NE * 16), r = it % (NE * 16), e = r >> 4, kb = r & 15;
        return CItem{ka->in[half ? I_WU : I_WG] + ((size_t)l * NE + e) * D * EH + (size_t)kb * 64 * EH, (bf16*)(ws + WS_WGU) + (size_t)e * 512 * D, EH, D, kb * 64, half}; }
    const int r = it - 2 * NE * 16, e = r >> 4, kb = (r >> 2) & 3, nb = r & 3;
    return CItem{ka->in[I_WD] + ((size_t)l * NE + e) * EH * D + (size_t)kb * 64 * D + nb * 256, (bf16*)(ws + WS_WD) + (size_t)e * D * EH + (size_t)nb * 256 * EH, D, EH, kb * 64, -1};
}
__device__ __forceinline__ void phase_convert_layer(KArgP ka, const int wave_s, int l, LAS unsigned char* lds, int bid, int G) {
    PHASE_BEGIN();
    const int lane = tid & 63, wave = __builtin_amdgcn_readfirstlane(tid >> 6);
    unsigned char* ws = ka->ws;
    { float* dwt = (float*)(ws + W_DWT); const float* wdw = ka->in[I_WDW] + (size_t)l * 31 * CONV_CH; const float* bdw = ka->in[I_BDW] + (size_t)l * CONV_CH;
        for (int i = bid * NTHREADS + tid; i < 256 * 32; i += G * NTHREADS) { const int j = i >> 8, ch = i & 255; dwt[ch * 32 + j] = (j < 31) ? wdw[j * CONV_CH + ch] : bdw[ch]; } }
    {
        constexpr int NCI = 2 * NE * 16 + NE * 16, TS = 257, TBYTES = 64 * TS * 4;
        f32x4 ld[8];
        int it = bid; int buf = 0;
        CItem d = cdecode(ka, ws, l, it < NCI ? it : 0);
        if (it < NCI) {
#pragma unroll
            for (int i = 0; i < 8; ++i) ld[i] = __builtin_nontemporal_load((const f32x4*)(d.src + (size_t)(i * 8 + wave) * d.ld + lane * 4));
        }
#pragma unroll 1
        for (; it < NCI; it += G) {
            LAS float* Tt = (LAS float*)(lds + buf * TBYTES);
#pragma unroll
            for (int i = 0; i < 8; ++i) { LAS float* p = Tt + (i * 8 + wave) * TS + lane * 4; p[0] = ld[i][0]; p[1] = ld[i][1]; p[2] = ld[i][2]; p[3] = ld[i][3]; }
            __syncthreads();
            const CItem dc = d;
            const int itn = it + G;
            if (itn < NCI) { d = cdecode(ka, ws, l, itn);
#pragma unroll
                for (int i = 0; i < 8; ++i) ld[i] = __builtin_nontemporal_load((const f32x4*)(d.src + (size_t)(i * 8 + wave) * d.ld + lane * 4)); }
#pragma unroll
            for (int p = 0; p < 4; ++p) { const int idx = p * NTHREADS + tid, n = idx >> 3, kc = idx & 7;
                float f[8];
#pragma unroll
                for (int i = 0; i < 8; ++i) f[i] = Tt[(8 * kc + i) * TS + n];
                const int row = dc.gu_half >= 0 ? ((n >> 7) * 256 + dc.gu_half * 128 + (n & 127)) : n;
                *(u32x4*)(dc.dst + (size_t)row * dc.ldk + dc.k0 + 8 * kc) = pack8(f); }
            buf ^= 1;
        }
        __syncthreads();
    }
    LAS float* scr = (LAS float*)(lds + wave * 16384);
    constexpr int I_IN = 16 * 40, I_OUT = 16 * 32, I_SH = 128, I_R = 16 * 2, I_P = 4 * 2;
    constexpr int NIT = I_IN + I_OUT + 3 * I_SH + I_R + I_P;
    for (int it = bid * NWAVES + wave; it < NIT; it += G * NWAVES) {
        int r = it;
        if (r < I_IN) { const int kb = r / 40, nb = r % 40; transpose_item(ka->in[I_WIN] + (size_t)l * D * NPROJ, NPROJ, (bf16*)(ws + WS_WIN), D, 32 * nb, scr, 64 * kb, 32 * nb, lane); continue; } r -= I_IN;
        if (r < I_OUT) { const int kb = r / 32, nb = r % 32; transpose_item(ka->in[I_WOUT] + (size_t)l * D * D, D, (bf16*)(ws + WS_WOUT), D, 32 * nb, scr, 64 * kb, 32 * nb, lane); continue; } r -= I_OUT;
        if (r < 2 * I_SH) { const int half = r / I_SH; r %= I_SH; const int kb = r / 8, nb = r % 8, n0 = 32 * nb;
            transpose_item(ka->in[half ? I_WUS : I_WGS] + (size_t)l * D * EH, EH, (bf16*)(ws + WS_WSGU), D, (n0 >> 7) * 256 + half * 128 + (n0 & 127), scr, 64 * kb, n0, lane); continue; } r -= 2 * I_SH;
        if (r < I_SH) { const int kb = r / 32, nb = r % 32; transpose_item(ka->in[I_WDS] + (size_t)l * EH * D, D, (bf16*)(ws + WS_WSD), EH, 32 * nb, scr, 64 * kb, 32 * nb, lane); continue; } r -= I_SH;
        if (r < I_R) { const int kb = r / 2, nb = r % 2; transpose_item(ka->in[I_WR] + (size_t)l * D * NE, NE, (bf16*)(ws + W_RT), D, 32 * nb, scr, 64 * kb, 32 * nb, lane, (bf16*)(ws + W_RTL)); continue; } r -= I_R;
        { const int g = r / 2, nb = r % 2; transpose_item(ka->in[I_WPOOL] + ((size_t)l * 4 + g) * 64 * 64, 64, (bf16*)(ws + W_PT) + (size_t)g * 64 * 64, 64, 32 * nb, scr, 0, 32 * nb, lane); }
    }
}

__device__ __forceinline__ void phase_prologue(KArgP ka, const int wave_s, LAS unsigned char* lds, int bid, int G) {
    PHASE_BEGIN();
    const int lane = tid & 63, wave = __builtin_amdgcn_readfirstlane(tid >> 6);
    LAS float* scr = (LAS float*)(lds + wave * 16384);
    unsigned char* ws = ka->ws;
    const int gw = bid * NWAVES + wave, NGW = G * NWAVES;
    for (int it = gw; it < DEPTH * 512; it += NGW) { const int l = it / 512, q = it % 512, kb = q / 32, nb = q % 32;
        transpose_item(ka->in[I_WKV] + (size_t)l * D * D, D, (bf16*)(ws + WS_WKV) + (size_t)l * D * D, D, 32 * nb, scr, 64 * kb, 32 * nb, lane); }
    const float* g = ka->in[I_MNG]; const float* b = ka->in[I_MNB];
    for (int m = gw; m < MROWS; m += NGW) {
        const f32x4* xr = (const f32x4*)(ka->in[I_MEM] + (size_t)m * D) + lane;
        f32x4 v[4]; float s = 0.f;
#pragma unroll
        for (int j = 0; j < 4; ++j) { v[j] = xr[64 * j]; s += (v[j][0] + v[j][1]) + (v[j][2] + v[j][3]); }
        const float mean = wave_sum(s, lane) * (1.f / D); float s2 = 0.f;
#pragma unroll
        for (int j = 0; j < 4; ++j) { v[j] = v[j] - mean; s2 += (v[j][0] * v[j][0] + v[j][1] * v[j][1]) + (v[j][2] * v[j][2] + v[j][3] * v[j][3]); }
        const float rstd = __builtin_amdgcn_rsqf(wave_sum(s2, lane) * (1.f / D) + LN_EPS);
        u32x2* o8 = (u32x2*)((bf16*)(ws + WS_MEMN) + (size_t)m * D) + lane;
        const int ml = m & 31, mp = (m & ~31) + 8 * ((ml >> 2) & 3) + 4 * (ml >> 4) + (ml & 3);
        u32x2* p8 = (u32x2*)((bf16*)(ws + WS_MEMP) + (size_t)mp * D) + lane;
#pragma unroll
        for (int j = 0; j < 4; ++j) { const f32x4 gg = ((const f32x4*)g)[lane + 64 * j], bb = ((const f32x4*)b)[lane + 64 * j]; const f32x4 y = v[j] * rstd * gg + bb;
            u32x2 w; w.x = cvt_pk_bf16(y[0], y[1]); w.y = cvt_pk_bf16(y[2], y[3]); o8[64 * j] = w; p8[64 * j] = w; }
    }
    const size_t n8 = (size_t)T * D / 8;
    for (size_t i = (size_t)bid * NTHREADS + tid; i < n8; i += (size_t)G * NTHREADS) {
        const f32x4 p0 = __builtin_nontemporal_load((const f32x4*)ka->in[I_X] + 2 * i), p1 = __builtin_nontemporal_load((const f32x4*)ka->in[I_X] + 2 * i + 1);
        u32x4 w; w.x = cvt_pk_bf16(p0[0], p0[1]); w.y = cvt_pk_bf16(p0[2], p0[3]); w.z = cvt_pk_bf16(p1[0], p1[1]); w.w = cvt_pk_bf16(p1[2], p1[3]);
        ((u32x4*)(ws + WS_XB))[i] = w;
    }
}

#define OPAQUE_TID() int z2_ = 0; asm volatile("" : "+v"(z2_)); int tid = (wave_s << 6) | (int)__builtin_amdgcn_mbcnt_hi(~0u, __builtin_amdgcn_mbcnt_lo(~0u, (unsigned)z2_)); asm volatile("" : "+v"(tid)); const int lane = tid & 63, wave = __builtin_amdgcn_readfirstlane(tid >> 6); (void)lane; (void)wave
__device__ __forceinline__ void phase_mixers(KArgP ka, const int wave_s, int l, LAS unsigned char* lds, int bid, int G) {
    PHASE_BEGIN();
    unsigned char* ws = ka->ws;
    const bf16* proj = (const bf16*)(ws + U_PROJ); bf16* cat = (bf16*)(ws + U_CAT);
    const bf16* wpt = (const bf16*)(ws + W_PT);
    const bf16* Kb = (const bf16*)(ws + WS_KB) + (size_t)l * MROWS * MEM_CH; const bf16* Vt = (const bf16*)(ws + WS_VT) + (size_t)l * MROWS * MEM_CH;
    const float* pscale = ka->in[I_PSCALE] + (size_t)l * POOL_CH;
    const float* dwt = (const float*)(ws + W_DWT);
    const float* cng = ka->in[I_CNG] + (size_t)l * CONV_CH; const float* cnb = ka->in[I_CNB] + (size_t)l * CONV_CH;
#pragma unroll 1
    for (int item = bid; item < T / 256; item += G) {
        const int b = item >> 4, s256 = (item & 15) * 256; const size_t t256 = (size_t)b * SEQ + s256;
        {
            OPAQUE_TID();
            const int fr = lane & 15, fq = lane >> 4, x2 = fr >> 2, x0 = fq ^ (fr & 3);
            constexpr float SC = 0.08838834764831845f * 1.4426950408889634f;
            const __amdgpu_buffer_rsrc_t qR = __builtin_amdgcn_make_buffer_rsrc((void*)(proj + (t256 + wave * 32) * NPROJ + 768), (short)0, 32 * NPROJ * 2, RSRC_W3);
            const unsigned qlane = (unsigned)(fr * NPROJ + 8 * fq) * 2u;
            const unsigned kbase = (unsigned)(fr * 256), vbase = 65536u + (unsigned)(fr * 512);
            const int kr = tid >> 4, ksw = (tid & 15) ^ (kr & 15), vr = tid >> 5, vsw = (tid & 31) ^ (vr & 15);
#define ATT_STAGE_K(h_) do { const char* ksrc = (const char*)(Kb + ((size_t)b * MEMT + kr) * MEM_CH + (h_) * HD + ksw * 8); _Pragma("unroll") \
                for (int i = 0; i < 8; ++i) __builtin_amdgcn_global_load_lds((const unsigned*)(ksrc + (size_t)i * 32 * MEM_CH * 2), (LAS unsigned*)(lds + (i * 512 + wave * 64) * 16), 16, 0, 0); } while (0)
#define ATT_STAGE_V(h_) do { const char* vsrc = (const char*)(Vt + (size_t)((h_) * HD + vr) * MROWS + b * MEMT + vsw * 8); _Pragma("unroll") \
                for (int i = 0; i < 8; ++i) __builtin_amdgcn_global_load_lds((const unsigned*)(vsrc + (size_t)i * 16 * MROWS * 2), (LAS unsigned*)(lds + 65536 + (i * 512 + wave * 64) * 16), 16, 0, 0); } while (0)
#define ATT_LOAD_Q(h_) do { _Pragma("unroll") for (int qt = 0; qt < 2; ++qt) _Pragma("unroll") for (int ks = 0; ks < 4; ++ks) { const unsigned so_ = (unsigned)(qt * 16 * NPROJ + (h_) * HD + ks * 32) * 2u; \
                asm volatile("buffer_load_dwordx4 %0, %1, %2, %3 offen" : "=v"(bq[qt][ks]) : "v"(qlane), "s"(qR), "s"(so_) : "memory"); } } while (0)
            bf16x8 bq[2][4];
#define ATT_Q_READY(n_) do { asm volatile("s_waitcnt vmcnt(" #n_ ")" ::: "memory"); _Pragma("unroll") for (int qt = 0; qt < 2; ++qt) _Pragma("unroll") for (int ks = 0; ks < 4; ++ks) asm volatile("" : "+v"(bq[qt][ks])); \
                __builtin_amdgcn_sched_barrier(0); } while (0)
            ATT_STAGE_K(0); ATT_LOAD_Q(0); ATT_Q_READY(0);
#pragma unroll 1
            for (int hh = 0; hh < HEADS; ++hh) {
                __builtin_amdgcn_s_barrier();
                ATT_STAGE_V(hh);
                f32x4 s[2][16];
#pragma unroll
                for (int ct = 0; ct < 16; ++ct) { s[0][ct] = (f32x4){0.f, 0.f, 0.f, 0.f}; s[1][ct] = (f32x4){0.f, 0.f, 0.f, 0.f};
#pragma unroll
                    for (int ks = 0; ks < 4; ++ks) { const bf16x8 kf = *(const LAS bf16x8*)(lds + kbase + (unsigned)((((ks ^ x2) << 2) | x0) << 4) + ct * 4096);
                        s[0][ct] = __builtin_amdgcn_mfma_f32_16x16x32_bf16(kf, bq[0][ks], s[0][ct], 0, 0, 0); s[1][ct] = __builtin_amdgcn_mfma_f32_16x16x32_bf16(kf, bq[1][ks], s[1][ct], 0, 0, 0); } }
                float inv[2];
                bf16x8 pb[2][8];
#pragma unroll
                for (int qt = 0; qt < 2; ++qt) { float m = s[qt][0][0];
#pragma unroll
                    for (int ct = 0; ct < 16; ++ct)
#pragma unroll
                        for (int j = 0; j < 4; ++j) m = fmaxf(m, s[qt][ct][j]);
                    m = fmaxf(m, swz_xor<16>(m)); m = fmaxf(m, bperm_f(lane ^ 32, m));
                    const float nm = -m * SC; float sum = 0.f;
#pragma unroll
                    for (int ks = 0; ks < 8; ++ks) { float p[8];
#pragma unroll
                        for (int j = 0; j < 4; ++j) { p[j] = __builtin_amdgcn_exp2f(__builtin_fmaf(s[qt][2 * ks][j], SC, nm)); p[4 + j] = __builtin_amdgcn_exp2f(__builtin_fmaf(s[qt][2 * ks + 1][j], SC, nm)); }
#pragma unroll
                        for (int j = 0; j < 8; ++j) sum += p[j];
                        pb[qt][ks] = __builtin_bit_cast(bf16x8, pack8(p)); }
                    sum += swz_xor<16>(sum); sum += bperm_f(lane ^ 32, sum);
                    inv[qt] = __builtin_amdgcn_rcpf(sum); }
                asm volatile("s_waitcnt vmcnt(0)" ::: "memory");
                __builtin_amdgcn_s_barrier();
                if (hh + 1 < HEADS) { ATT_STAGE_K(hh + 1); ATT_LOAD_Q(hh + 1); }
                __builtin_amdgcn_sched_barrier(0);
                f32x4 o[2][8];
#pragma unroll
                for (int dt = 0; dt < 8; ++dt) { o[0][dt] = (f32x4){0.f, 0.f, 0.f, 0.f}; o[1][dt] = (f32x4){0.f, 0.f, 0.f, 0.f}; }
#pragma unroll
                for (int ks = 0; ks < 8; ++ks) {
#pragma unroll
                    for (int dt = 0; dt < 8; ++dt) { const bf16x8 vf = *(const LAS bf16x8*)(lds + vbase + (unsigned)((((ks ^ x2) << 2) | x0) << 4) + dt * 8192);
                        o[0][dt] = __builtin_amdgcn_mfma_f32_16x16x32_bf16(vf, pb[0][ks], o[0][dt], 0, 0, 0); o[1][dt] = __builtin_amdgcn_mfma_f32_16x16x32_bf16(vf, pb[1][ks], o[1][dt], 0, 0, 0); } }
#pragma unroll
                for (int qt = 0; qt < 2; ++qt) { bf16* orow = cat + (t256 + wave * 32 + qt * 16 + fr) * D + 512 + hh * HD + 4 * fq;
#pragma unroll
                    for (int dt = 0; dt < 8; ++dt) { u32x2 w; w.x = cvt_pk_bf16(o[qt][dt][0] * inv[qt], o[qt][dt][1] * inv[qt]); w.y = cvt_pk_bf16(o[qt][dt][2] * inv[qt], o[qt][dt][3] * inv[qt]); *(u32x2*)(orow + dt * 16) = w; } }
                ATT_Q_READY(16);
            }
            __syncthreads();
#undef ATT_STAGE_K
#undef ATT_STAGE_V
#undef ATT_LOAD_Q
#undef ATT_Q_READY
        }
#pragma unroll 1
        for (int hp = 0; hp < 2; ++hp) {
            const int s0 = s256 + hp * 128;
            OPAQUE_TID();
            LAS bf16* Gb = (LAS bf16*)lds;
            LAS float* Yc = (LAS float*)(lds + 81920);
            const int c2 = tid & 127, rg = tid >> 7; f32x2 wv[32];
#pragma unroll
            for (int j = 0; j < 8; ++j) { const f32x4 wa = ((const f32x4*)(dwt + (2 * c2) * 32))[j], wb = ((const f32x4*)(dwt + (2 * c2 + 1) * 32))[j];
#pragma unroll
                for (int i = 0; i < 4; ++i) wv[4 * j + i] = (f32x2){wa[i], wb[i]}; }
            const f32x4 gg = ((const f32x4*)cng)[lane], bb = ((const f32x4*)cnb)[lane];
            { u32x4 av[10], gv[10];
#pragma unroll
                for (int q = 0; q < 10; ++q) { const int i = tid + q * NTHREADS, r = i >> 5, c8 = i & 31, sp = s0 - 15 + r;
                    av[q] = (u32x4){0u, 0u, 0u, 0u}; gv[q] = av[q];
                    if (i < 158 * 32 && sp >= 0 && sp < SEQ) { const bf16* pr = proj + ((size_t)b * SEQ + sp) * NPROJ + 256 + c8 * 8; av[q] = __builtin_nontemporal_load((const u32x4*)pr); gv[q] = __builtin_nontemporal_load((const u32x4*)(pr + 256)); } }
#pragma unroll
                for (int q = 0; q < 10; ++q) { const int i = tid + q * NTHREADS, r = i >> 5, c8 = i & 31;
                    float a8[8], g8[8]; unpack8(av[q], a8); unpack8(gv[q], g8);
#pragma unroll
                    for (int j = 0; j < 8; j += 2) { const f32x2 r2 = (f32x2){a8[j], a8[j + 1]} * fast_sigmoid2((f32x2){g8[j], g8[j + 1]}); a8[j] = r2[0]; a8[j + 1] = r2[1]; }
                    if (i < 158 * 32) *(LAS u32x4*)(Gb + r * 256 + c8 * 8) = pack8(a8); } }
            __syncthreads();
#pragma unroll 1
            for (int sub2 = 0; sub2 < 2; ++sub2) { const size_t t0 = t256 + hp * 128 + sub2 * 64;
                { const f32x2 bias = wv[31];
#pragma unroll 1
                    for (int rb = 0; rb < 4; ++rb) { const int r0 = rg * 16 + rb * 4; f32x2 gv[34];
#pragma unroll
                        for (int j = 0; j < 34; ++j) { const unsigned w = *(const LAS unsigned*)(Gb + (sub2 * 64 + r0 + j) * 256 + 2 * c2); gv[j] = (f32x2){bf2f(w & 0xffffu), bf2f(w >> 16)}; }
#pragma unroll
                        for (int q = 0; q < 4; ++q) { f32x2 y = bias;
#pragma unroll
                            for (int j = 0; j < 31; ++j) y = gv[q + j] * wv[j] + y;
                            *(LAS f32x2*)(Yc + (r0 + q) * 256 + 2 * c2) = y; } } }
                __syncthreads();
                {
#pragma unroll 2
                    for (int r = wave; r < 64; r += NWAVES) { const f32x4 v = *(const LAS f32x4*)(Yc + r * 256 + lane * 4);
                        const float mean = wave_sum((v[0] + v[1]) + (v[2] + v[3]), lane) * (1.f / 256.f); const f32x4 d = v - mean;
                        const float rstd = __builtin_amdgcn_rsqf(wave_sum((d[0] * d[0] + d[1] * d[1]) + (d[2] * d[2] + d[3] * d[3]), lane) * (1.f / 256.f) + LN_EPS);
                        const f32x4 y = d * rstd * gg + bb;
                        const f32x2 ya = (f32x2){y[0], y[1]}, yb = (f32x2){y[2], y[3]}; const f32x2 za = ya * fast_sigmoid2(ya), zb2 = yb * fast_sigmoid2(yb);
                        u32x2 w; w.x = cvt_pk_bf16(za[0], za[1]); w.y = cvt_pk_bf16(zb2[0], zb2[1]);
                        *(u32x2*)(cat + (t0 + r) * D + 256 + lane * 4) = w; } }
                __syncthreads();
            }
        }
        constexpr int PR = 128;
#pragma unroll 1
        for (int pt = 0; pt < 256 / PR; ++pt) {
            const int s0 = s256 + pt * PR; const size_t t0 = t256 + pt * PR;
            {
                OPAQUE_TID();
                LAS bf16* Ub = (LAS bf16*)lds;
                LAS bf16* Db = (LAS bf16*)(lds + (PR + 16) * 528);
                bf16x8 wfp[4][2]; float scp[4];
                { const int g = wave >> 1, fr = lane & 15, fq = lane >> 4;
#pragma unroll
                    for (int ct = 0; ct < 4; ++ct) { scp[ct] = pscale[g * 64 + ct * 16 + fr];
#pragma unroll
                        for (int ks = 0; ks < 2; ++ks) wfp[ct][ks] = *(const bf16x8*)(wpt + (size_t)g * 4096 + (ct * 16 + fr) * 64 + ks * 32 + 8 * fq); } }
                { u32x4 uv[(PR + 16) / 16];
#pragma unroll
                    for (int q = 0; q < (PR + 16) / 16; ++q) { const int i = tid + q * NTHREADS, r = i >> 5, c8 = i & 31, sp = s0 - 8 + r;
                        uv[q] = (u32x4){0u, 0u, 0u, 0u}; if (sp >= 0 && sp < SEQ) uv[q] = __builtin_nontemporal_load((const u32x4*)(proj + ((size_t)b * SEQ + sp) * NPROJ + c8 * 8)); }
#pragma unroll
                    for (int q = 0; q < (PR + 16) / 16; ++q) { const int i = tid + q * NTHREADS, r = i >> 5, c8 = i & 31; *(LAS u32x4*)(Ub + r * 264 + c8 * 8) = uv[q]; } }
                __syncthreads();
                { const int c2 = tid & 127, rg = tid >> 7, g = c2 >> 5; const int w = 2 << g, lo = w >> 1, hi = w - 1 - lo;
#define POOL_LD2(row) ({ const unsigned _w = *(const LAS unsigned*)(Ub + (row) * 264 + 2 * c2); (f32x2){bf2f(_w & 0xffffu), bf2f(_w >> 16)}; })
                    const int r0 = rg * (PR / 4); f32x2 run = (f32x2){0.f, 0.f};
#pragma unroll
                    for (int k = 0; k < 16; ++k) { const f32x2 t = POOL_LD2(r0 - lo + k + 8); if (k < w) run += t; }
                    if (s0 != 0 && s0 + PR != SEQ) {
                        const float invw = 1.0f / (float)w;
#pragma unroll 1
                        for (int rb = r0; rb < r0 + PR / 4; rb += 8) {
                            f32x2 cv[8], av[8], sv[8];
#pragma unroll
                            for (int i = 0; i < 8; ++i) { cv[i] = POOL_LD2(rb + i + 8); av[i] = POOL_LD2(rb + i + 9 + hi); sv[i] = POOL_LD2(rb + i + 8 - lo); }
#pragma unroll
                            for (int i = 0; i < 8; ++i) { const f32x2 d = run * invw - cv[i];
                                *(LAS unsigned*)(Db + (rb + i) * 264 + 2 * c2) = cvt_pk_bf16(d[0], d[1]);
                                run += av[i] - sv[i]; } }
                    } else {
#pragma unroll 4
                        for (int r = r0; r < r0 + PR / 4; ++r) { const int sp = s0 + r; const int st = max(sp - lo, 0), en = min(sp + hi + 1, SEQ);
                            const f32x2 d = run * __builtin_amdgcn_rcpf((float)(en - st)) - POOL_LD2(r + 8);
                            *(LAS unsigned*)(Db + r * 264 + 2 * c2) = cvt_pk_bf16(d[0], d[1]);
                            run += POOL_LD2(r + 9 + hi) - POOL_LD2(r + 8 - lo); }
                    }
#undef POOL_LD2
                }
                __syncthreads();
                { const int g = wave >> 1, rh = wave & 1, fr = lane & 15, fq = lane >> 4;
#pragma unroll
                    for (int rt = 0; rt < PR / 32; ++rt) {
                        bf16x8 af[2];
#pragma unroll
                        for (int ks = 0; ks < 2; ++ks) af[ks] = *(const LAS bf16x8*)(Db + (rh * (PR / 2) + rt * 16 + fr) * 264 + g * 64 + ks * 32 + 8 * fq);
#pragma unroll
                        for (int ct = 0; ct < 4; ++ct) { f32x4 c = (f32x4){0.f, 0.f, 0.f, 0.f};
#pragma unroll
                            for (int ks = 0; ks < 2; ++ks) c = __builtin_amdgcn_mfma_f32_16x16x32_bf16(af[ks], wfp[ct][ks], c, 0, 0, 0);
                            const int col = g * 64 + ct * 16 + fr; const float sc = scp[ct];
#pragma unroll
                            for (int j = 0; j < 4; ++j) Ub[(rh * (PR / 2) + rt * 16 + fq * 4 + j) * 264 + col] = (bf16)(cvt_pk_bf16(c[j] * sc, 0.f) & 0xffffu); } } }
                __syncthreads();
#pragma unroll
                for (int q = 0; q < PR / 16; ++q) { const int i = tid + q * NTHREADS, r = i >> 5, c8 = i & 31; *(u32x4*)(cat + (t0 + r) * D + c8 * 8) = *(const LAS u32x4*)(Ub + r * 264 + c8 * 8); }
                __syncthreads();
            }
        }
    }
}

__device__ __forceinline__ void ln_row16r(float* v, const f32x4* gv, const f32x4* bv, int lane) {
    float s = 0.f;
#pragma unroll
    for (int i = 0; i < 16; ++i) s += v[i];
    const float mean = wave_sum(s, lane) * (1.f / D); float s2 = 0.f;
#pragma unroll
    for (int i = 0; i < 16; ++i) { v[i] -= mean; s2 += v[i] * v[i]; }
    const float rstd = __builtin_amdgcn_rsqf(wave_sum(s2, lane) * (1.f / D) + LN_EPS);
#pragma unroll
    for (int q = 0; q < 4; ++q)
#pragma unroll
        for (int i = 0; i < 4; ++i) v[4 * q + i] = v[4 * q + i] * rstd * gv[q][i] + bv[q][i];
}
__device__ __forceinline__ void phase_ln1_router(KArgP ka, const int wave_s, int l, LAS unsigned char* lds, int bid, int G) {
    PHASE_BEGIN();
    const int lane = tid & 63, wave = __builtin_amdgcn_readfirstlane(tid >> 6), fr = lane & 15, fq = lane >> 4;
    unsigned char* ws = ka->ws;
    const bf16* zb = (const bf16*)(ws + WS_ZB); bf16* xb = (bf16*)(ws + WS_XB);
    const float* g = ka->in[I_LN1G] + (size_t)l * D; const float* bta = ka->in[I_LN1B] + (size_t)l * D;
    const float* rbias = ka->in[I_RB] + (size_t)l * NE;
    int* tok_e = (int*)(ws + TOK_E); float* tok_g = (float*)(ws + TOK_G); int* tok_r = (int*)(ws + TOK_R); int* hist = (int*)(ws + TAB_HIST);
    int* row_tok = (int*)(ws + ROW_TOK);
    for (int i = bid * NTHREADS + tid; i < NCH * CH_SLOTS; i += G * NTHREADS) row_tok[i] = 0;
    LAS bf16* Xh = (LAS bf16*)lds;
    LAS float* Lg = (LAS float*)(lds + 32 * 2064);
    LAS int* hl = (LAS int*)(lds + 32 * 2064 + 65536);
    const int kw = wave * 128;
    bf16x8 wf[4][2][4];
#pragma unroll
    for (int ct = 0; ct < 4; ++ct)
#pragma unroll
        for (int part = 0; part < 2; ++part)
#pragma unroll
            for (int ks = 0; ks < 4; ++ks) wf[ct][part][ks] = *(const bf16x8*)((const bf16*)(ws + (part ? W_RTL : W_RT)) + (size_t)(ct * 16 + fr) * D + kw + ks * 32 + 8 * fq);
    const float rb = rbias[lane];
    f32x4 gv[4], bv[4];
#pragma unroll
    for (int q = 0; q < 4; ++q) { gv[q] = *(const f32x4*)(g + 8 * lane + 512 * (q >> 1) + 4 * (q & 1)); bv[q] = *(const f32x4*)(bta + 8 * lane + 512 * (q >> 1) + 4 * (q & 1)); }
#pragma unroll 1
    for (int tb = bid; tb < NTB; tb += G) {
        if (tid < 64) hl[tid] = 0;
        __syncthreads();
        u32x4 zv[4][2];
#pragma unroll
        for (int rr = 0; rr < 4; ++rr) { const size_t t = (size_t)tb * TBLK + wave * 4 + rr;
#pragma unroll
            for (int j = 0; j < 2; ++j) zv[rr][j] = __builtin_nontemporal_load((const u32x4*)(zb + t * D + 8 * lane + 512 * j)); }
#pragma unroll 1
        for (int st = 0; st < 8; ++st) {
            {
#pragma unroll
                for (int rr = 0; rr < 4; ++rr) { const int lr = wave * 4 + rr; const size_t t = (size_t)tb * TBLK + st * 32 + lr;
                    float v[16]; unpack8(zv[rr][0], v); unpack8(zv[rr][1], v + 8);
                    ln_row16r(v, gv, bv, lane);
#pragma unroll
                    for (int j = 0; j < 2; ++j) { const u32x4 w = pack8(v + 8 * j); *(u32x4*)(xb + t * D + 8 * lane + 512 * j) = w; *(LAS u32x4*)(Xh + lr * 1032 + 8 * lane + 512 * j) = w;
                        } }
                if (st < 7) {
#pragma unroll
                    for (int rr = 0; rr < 4; ++rr) { const size_t t = (size_t)tb * TBLK + (st + 1) * 32 + wave * 4 + rr;
#pragma unroll
                        for (int j = 0; j < 2; ++j) zv[rr][j] = __builtin_nontemporal_load((const u32x4*)(zb + t * D + 8 * lane + 512 * j)); } } }
            __syncthreads();
#pragma unroll
            for (int rt = 0; rt < 2; ++rt) { bf16x8 a[4];
#pragma unroll
                for (int ks = 0; ks < 4; ++ks) a[ks] = *(const LAS bf16x8*)(Xh + (rt * 16 + fr) * 1032 + kw + ks * 32 + 8 * fq);
#pragma unroll
                for (int ct = 0; ct < 4; ++ct) { f32x4 c = (f32x4){0.f, 0.f, 0.f, 0.f};
#pragma unroll
                    for (int ks = 0; ks < 4; ++ks) { c = __builtin_amdgcn_mfma_f32_16x16x32_bf16(a[ks], wf[ct][0][ks], c, 0, 0, 0); c = __builtin_amdgcn_mfma_f32_16x16x32_bf16(a[ks], wf[ct][1][ks], c, 0, 0, 0); }
#pragma unroll
                    for (int j = 0; j < 4; ++j) Lg[(wave * 32 + rt * 16 + fq * 4 + j) * 64 + ct * 16 + fr] = c[j]; } }
            __syncthreads();
#pragma unroll 1
            for (int rr = 0; rr < 4; ++rr) { const int lr = wave * 4 + rr; const size_t t = (size_t)tb * TBLK + st * 32 + lr;
                float lg = 0.f;
#pragma unroll
                for (int w = 0; w < NWAVES; ++w) lg += Lg[(w * 32 + lr) * 64 + lane];
                const float sc = fast_sigmoid(lg); float sel = sc + rb;
                Lg[lr * 64 + lane] = sel;
                int r4[4] = {0, 0, 0, 0};
#pragma unroll
                for (int j4 = 0; j4 < 16; ++j4) { const f32x4 q = *(const LAS f32x4*)(Lg + lr * 64 + 4 * j4);
#pragma unroll
                    for (int c = 0; c < 4; ++c) r4[c] += (q[c] > sel) ? 1 : 0; }
                const bool selb = ((r4[0] + r4[1]) + (r4[2] + r4[3])) < TOPK; const unsigned long long smask = __ballot(selb);
                if (__popcll(smask) == TOPK) {
                    const int k = (int)__builtin_amdgcn_mbcnt_hi((unsigned)(smask >> 32), __builtin_amdgcn_mbcnt_lo((unsigned)smask, 0u));
                    const float ssum = wave_sum(selb ? sc : 0.f, lane);
                    if (selb) { const int rank = __hip_atomic_fetch_add(&hl[lane], 1, __ATOMIC_RELAXED, __HIP_MEMORY_SCOPE_WORKGROUP);
                        tok_e[t * TOPK + k] = lane; tok_g[t * TOPK + k] = sc * __builtin_amdgcn_rcpf(ssum) * ROUTED_SCALE; tok_r[t * TOPK + k] = rank; }
                } else {
                    int my_e = 0; float my_s = 0.f, ssum = 0.f;
#pragma unroll 1
                    for (int k = 0; k < TOPK; ++k) { const float m = wave_max(sel, lane); const unsigned long long mask = __ballot(sel == m); const int idx = mask ? (__ffsll((long long)mask) - 1) : k;
                        const float sk = rl_f(sc, idx); ssum += sk; if (lane == idx) sel = -3.0e38f; if (lane == k) { my_e = idx; my_s = sk; } }
                    if (lane < TOPK) { const int rank = __hip_atomic_fetch_add(&hl[my_e], 1, __ATOMIC_RELAXED, __HIP_MEMORY_SCOPE_WORKGROUP);
                        tok_e[t * TOPK + lane] = my_e; tok_g[t * TOPK + lane] = my_s / ssum * ROUTED_SCALE; tok_r[t * TOPK + lane] = rank; }
                }
            }
            __syncthreads();
        }
        if (tid < 64) hist[tb * 64 + tid] = hl[tid];
        __syncthreads();
    }
}

__device__ __forceinline__ void phase_scatter(KArgP ka, const int wave_s, LAS unsigned char* lds, int bid, int G) {
    PHASE_BEGIN();
    const int lane = tid & 63;
    unsigned char* ws = ka->ws;
    const int* tok_e = (const int*)(ws + TOK_E); const int* tok_r = (const int*)(ws + TOK_R); int* slot_of = (int*)(ws + TOK_SLOT);
    const int* hist = (const int*)(ws + TAB_HIST); int* ntiles = (int*)(ws + TAB_NT); int* tile_e = (int*)(ws + TAB_TE);
    int* row_tok = (int*)(ws + ROW_TOK);
    LAS int* ptot = (LAS int*)lds; LAS int* pbef = ptot + 512; LAS int* base = pbef + 512;
    for (int tb = bid; tb < NTB; tb += G) {
        const int ch = tb / TB_PER_CH;
        int te[TBLK * TOPK / NTHREADS], tr[TBLK * TOPK / NTHREADS];
#pragma unroll
        for (int j = 0; j < TBLK * TOPK / NTHREADS; ++j) { const size_t i = (size_t)tb * TBLK * TOPK + tid + j * NTHREADS; te[j] = tok_e[i]; tr[j] = tok_r[i]; }
        { const int e = tid & 63, part = tid >> 6; int tot = 0, bef = 0;
            for (int j = 0; j < TB_PER_CH / 8; ++j) { const int blk = ch * TB_PER_CH + part * (TB_PER_CH / 8) + j; const int v = hist[blk * 64 + e]; tot += v; if (blk < tb) bef += v; }
            ptot[part * 64 + e] = tot; pbef[part * 64 + e] = bef; }
        __syncthreads();
        if (tid < 64) { int tot = 0, bef = 0;
#pragma unroll
            for (int p = 0; p < 8; ++p) { tot += ptot[p * 64 + tid]; bef += pbef[p * 64 + tid]; }
            const int padded = (tot + 255) & ~255; int inc = padded;
#pragma unroll
            for (int o = 1; o < 64; o <<= 1) { const int v = bperm_i((lane - o) & 63, inc); if (lane >= o) inc += v; }
            const int ebase = inc - padded;
            base[tid] = ebase + bef;
            if (tb % TB_PER_CH == 0) { if (tid == 63) ntiles[ch] = inc >> 8; for (int j = 0; j < (padded >> 8); ++j) tile_e[ch * CH_TILES_MAX + (ebase >> 8) + j] = tid; }
        }
        __syncthreads();
#pragma unroll
        for (int j = 0; j < TBLK * TOPK / NTHREADS; ++j) { const size_t i = (size_t)tb * TBLK * TOPK + tid + j * NTHREADS; const int slot = ch * CH_SLOTS + base[te[j]] + tr[j];
            row_tok[slot] = (int)(i >> 3); slot_of[i] = slot; }
        __syncthreads();
    }
}

__device__ __forceinline__ void add_fp8x16(const u32x4 w, float* v, float g) {
#pragma unroll
    for (int q = 0; q < 4; ++q) { const f32x2 a = __builtin_amdgcn_cvt_pk_f32_fp8((int)w[q], false), b = __builtin_amdgcn_cvt_pk_f32_fp8((int)w[q], true);
        v[4 * q] += a[0] * g; v[4 * q + 1] += a[1] * g; v[4 * q + 2] += b[0] * g; v[4 * q + 3] += b[1] * g; }
}
__device__ __forceinline__ void phase_combine_ln2(KArgP ka, const int wave_s, int l, int ch, int bid, int G) {
    PHASE_BEGIN();
    const int lane = tid & 63, wave = __builtin_amdgcn_readfirstlane(tid >> 6);
    unsigned char* ws = ka->ws;
    float* dout = ka->out; bf16* xb = (bf16*)(ws + WS_XB); const bf16* zb = (const bf16*)(ws + WS_ZB); const unsigned char* Y = (const unsigned char*)(ws + WS_Y); const int* slot_of = (const int*)(ws + TOK_SLOT);
    const float* tok_g = (const float*)(ws + TOK_G);
    const float* g = ka->in[I_LN2G] + (size_t)l * D; const float* bta = ka->in[I_LN2B] + (size_t)l * D;
    const bool last = (l == DEPTH - 1);
    f32x4 gg[4], bb[4];
#pragma unroll
    for (int q = 0; q < 4; ++q) { gg[q] = *(const f32x4*)(g + 16 * lane + 4 * q); bb[q] = *(const f32x4*)(bta + 16 * lane + 4 * q); }
#pragma unroll 1
    for (int q0 = bid * NWAVES + wave; q0 < CH_TOK; q0 += G * NWAVES) { const size_t t = (size_t)ch * CH_TOK + q0;
        int sl[TOPK]; float gk[TOPK];
#pragma unroll
        for (int k = 0; k < TOPK; ++k) { sl[k] = __builtin_amdgcn_readfirstlane(slot_of[t * TOPK + k]) - ch * CH_SLOTS; gk[k] = __int_as_float(__builtin_amdgcn_readfirstlane(__float_as_int(tok_g[t * TOPK + k]))) * Y_INV; }
        u32x4 zv[2], yv[TOPK];
#pragma unroll
        for (int j = 0; j < 2; ++j) zv[j] = __builtin_nontemporal_load((const u32x4*)(zb + t * D + 16 * lane + 8 * j));
#pragma unroll
        for (int k = 0; k < TOPK; ++k) yv[k] = __builtin_nontemporal_load((const u32x4*)(Y + ((size_t)(sl[k] >> 8) * 4 + (lane >> 4)) * 65536 + (sl[k] & 255) * 256 + (lane & 15) * 16));
        float y[16];
#pragma unroll
        for (int i = 0; i < 16; ++i) y[i] = 0.f;
#pragma unroll
        for (int k = 0; k < TOPK; ++k) add_fp8x16(yv[k], y, gk[k]);
        float v[16]; unpack8(zv[0], v); unpack8(zv[1], v + 8);
        float s = 0.f;
#pragma unroll
        for (int i = 0; i < 16; ++i) { v[i] += y[i]; s += v[i]; }
        const float mean = wave_sum(s, lane) * (1.f / D); float s2 = 0.f;
#pragma unroll
        for (int i = 0; i < 16; ++i) { v[i] -= mean; s2 += v[i] * v[i]; }
        const float rstd = __builtin_amdgcn_rsqf(wave_sum(s2, lane) * (1.f / D) + LN_EPS);
#pragma unroll
        for (int q = 0; q < 4; ++q)
#pragma unroll
            for (int i = 0; i < 4; ++i) v[4 * q + i] = v[4 * q + i] * rstd * gg[q][i] + bb[q][i];
        if (!last) {
#pragma unroll
            for (int j = 0; j < 2; ++j) *(u32x4*)(xb + t * D + 16 * lane + 8 * j) = pack8(v + 8 * j); }
        if (last) {
#pragma unroll
            for (int q = 0; q < 4; ++q) *(f32x4*)(dout + t * D + 16 * lane + 4 * q) = (f32x4){v[4 * q], v[4 * q + 1], v[4 * q + 2], v[4 * q + 3]}; }
    }
}

__device__ __forceinline__ void phase_gemm_kv(KArgP ka, const int wave_s, LAS unsigned char* lds, int bid, int G) {
    PHASE_BEGIN();
    unsigned char* ws = ka->ws;
    ge::SchedKV S{(const char*)(ws + WS_MEMN), (const char*)(ws + WS_MEMP), (const char*)(ws + WS_WKV), (char*)(ws + WS_KB), (char*)(ws + WS_VT), G, bid};
    ge::EpiBf16 E;
    ge::gemm_phase<D, false, ge::EpiBf16, ge::SchedKV>(tid, lds, (const LAS int*)(lds + LDS_TBL), S, E);
}
__device__ __forceinline__ void phase_gemm_in(KArgP ka, const int wave_s, LAS unsigned char* lds, int bid, int G) {
    PHASE_BEGIN();
    unsigned char* ws = ka->ws;
    ge::SchedDense<D> S{(const char*)(ws + WS_XB), (const char*)(ws + WS_WIN), (char*)(ws + U_PROJ), NPROJ, T / 256, NPROJ / 256, G, bid};
    ge::EpiBf16 E;
    ge::gemm_phase<D, false, ge::EpiBf16, ge::SchedDense<D>>(tid, lds, (const LAS int*)(lds + LDS_TBL), S, E);
}
__device__ __forceinline__ void phase_gemm_out(KArgP ka, const int wave_s, int l, LAS unsigned char* lds, int bid, int G) {
    PHASE_BEGIN();
    unsigned char* ws = ka->ws;
    ge::SchedDense<D> S{(const char*)(ws + U_CAT), (const char*)(ws + WS_WOUT), (char*)(ws + WS_ZB), D, T / 256, D / 256, G, bid};
    ge::EpiResBf16 E{(const bf16*)(ws + WS_XB), (bf16*)(ws + WS_ZB)};
    ge::gemm_phase<D, false, ge::EpiResBf16, ge::SchedDense<D>>(tid, lds, (const LAS int*)(lds + LDS_TBL), S, E);
}
__device__ __forceinline__ void phase_gemm_gu(KArgP ka, const int wave_s, LAS unsigned char* lds, int bid, int G) {
    PHASE_BEGIN();
    unsigned char* ws = ka->ws;
    ge::SchedGU S{(const char*)(ws + WS_XB), (const char*)(ws + WS_WGU), (const char*)(ws + WS_WSGU), (char*)(ws + U_H), (const int*)(ws + TAB_NT), (const int*)(ws + TAB_TE), G, bid, {}};
    S.init();
    LAS int* tbl = (LAS int*)(lds + LDS_TBL);
    const int* row_tok = (const int*)(ws + ROW_TOK);
    { ge::Unit u; for (int i = 0; i < MAXU && S.next(i, u); ++i) { const int r = tid; if (r < 256) tbl[i * 256 + r] = (u.aux >= 0) ? (u.aux + r) : row_tok[u.row0 + r]; } }
    __syncthreads();
    ge::EpiSwiGLU E;
    ge::gemm_phase<D, true, ge::EpiSwiGLU, ge::SchedGU, (PROBE_TPH == 9 ? PROBE_T : 0)>(tid, lds, tbl, S, E);
}
__device__ __forceinline__ void phase_gemm_dn(KArgP ka, const int wave_s, int ch, LAS unsigned char* lds, int bid, int G) {
    PHASE_BEGIN();
    unsigned char* ws = ka->ws;
    ge::SchedDN S{(const char*)(ws + U_H), (const char*)(ws + WS_WD), (const char*)(ws + WS_WSD), (char*)(ws + WS_Y), (char*)(ws + WS_ZB), (const int*)(ws + TAB_TE), ch, ((const int*)(ws + TAB_NT))[ch], G, bid};
    ge::EpiDown E{(const float*)(ws + ROW_GATE), (const bf16*)(ws + WS_XB)};
    ge::gemm_phase<EH, false, ge::EpiDown, ge::SchedDN, (PROBE_TPH == 10 ? PROBE_T : 0), 1>(tid, lds, (const LAS int*)(lds + LDS_TBL), S, E);
}

#define KERNEL_HEAD extern __shared__ __attribute__((aligned(16))) unsigned char lds_raw[]; LAS unsigned char* lds = (LAS unsigned char*)lds_raw; const int bid = blockIdx.x, G = gridDim.x; KArgP ka = (KArgP)__builtin_amdgcn_kernarg_segment_ptr(); (void)a; const int wave_s = __builtin_amdgcn_readfirstlane((int)(threadIdx.x >> 6));
#if MK_ONE_LAUNCH
#define RUN(id, call) do { KA_OPAQUE(ka); call; if ((PROBE_DUP >> (id)) & 1) { grid_bar(bar, wave_s); KA_OPAQUE(ka); call; } } while (0)
__global__ void __launch_bounds__(NTHREADS, 2) k_mega(KArgs a) {
    KERNEL_HEAD
    volatile LAS unsigned* misc = (volatile LAS unsigned*)(lds + LDS_CTLW);
    if (threadIdx.x < 64) misc[threadIdx.x] = 0u;
    __syncthreads();
    const XcdBarrier bar = xcd_barrier_post((unsigned*)(ka->ws + WS_CTL), misc + 8, (int)threadIdx.x);
    RUN(1, phase_prologue(ka, wave_s, lds, bid, G));
    RUN(2, phase_convert_layer(ka, wave_s, 0, lds, bid, G));
    grid_bar(bar, wave_s);
    RUN(3, phase_gemm_kv(ka, wave_s, lds, bid, G));
#pragma unroll 1
    for (int l = 0; l < DEPTH; ++l) {
        RUN(4, phase_gemm_in(ka, wave_s, lds, bid, G));
        grid_bar(bar, wave_s);
        RUN(5, phase_mixers(ka, wave_s, l, lds, bid, G));
        grid_bar(bar, wave_s);
        RUN(6, phase_gemm_out(ka, wave_s, l, lds, bid, G));
        grid_bar(bar, wave_s);
        RUN(7, phase_ln1_router(ka, wave_s, l, lds, bid, G));
        grid_bar(bar, wave_s);
        RUN(8, phase_scatter(ka, wave_s, lds, bid, G));
        grid_bar(bar, wave_s);
        RUN(9, phase_gemm_gu(ka, wave_s, lds, bid, G));
        grid_bar(bar, wave_s);
#pragma unroll 1
        for (int c = 0; c < NCH; ++c) {
            RUN(10, phase_gemm_dn(ka, wave_s, c, lds, bid, G));
            grid_bar(bar, wave_s);
            RUN(11, phase_combine_ln2(ka, wave_s, l, c, bid, G));
            if (c == NCH - 1) { if (l == DEPTH - 1) break; RUN(2, phase_convert_layer(ka, wave_s, l + 1, lds, bid, G)); }
            grid_bar(bar, wave_s);
        }
    }
}
#else
__global__ void __launch_bounds__(NTHREADS, 2) k_prologue(KArgs a) { KERNEL_HEAD phase_prologue(ka, wave_s, lds, bid, G); }
__global__ void __launch_bounds__(NTHREADS, 2) k_convert(KArgs a) { KERNEL_HEAD phase_convert_layer(ka, wave_s, ka->layer, lds, bid, G); }
__global__ void __launch_bounds__(NTHREADS, 2) k_gemm_kv(KArgs a) { KERNEL_HEAD phase_gemm_kv(ka, wave_s, lds, bid, G); }
__global__ void __launch_bounds__(NTHREADS, 2) k_gemm_in(KArgs a) { KERNEL_HEAD phase_gemm_in(ka, wave_s, lds, bid, G); }
__global__ void __launch_bounds__(NTHREADS, 2) k_mixers(KArgs a) { KERNEL_HEAD phase_mixers(ka, wave_s, ka->layer, lds, bid, G); }
__global__ void __launch_bounds__(NTHREADS, 2) k_gemm_out(KArgs a) { KERNEL_HEAD phase_gemm_out(ka, wave_s, ka->layer, lds, bid, G); }
__global__ void __launch_bounds__(NTHREADS, 2) k_ln1_router(KArgs a) { KERNEL_HEAD phase_ln1_router(ka, wave_s, ka->layer, lds, bid, G); }
__global__ void __launch_bounds__(NTHREADS, 2) k_scatter(KArgs a) { KERNEL_HEAD phase_scatter(ka, wave_s, lds, bid, G); }
__global__ void __launch_bounds__(NTHREADS, 2) k_gemm_gu(KArgs a) { KERNEL_HEAD phase_gemm_gu(ka, wave_s, lds, bid, G); }
__global__ void __launch_bounds__(NTHREADS, 2) k_gemm_dn(KArgs a) { KERNEL_HEAD phase_gemm_dn(ka, wave_s, ka->chunk, lds, bid, G); }
__global__ void __launch_bounds__(NTHREADS, 2) k_combine(KArgs a) { KERNEL_HEAD (void)lds; phase_combine_ln2(ka, wave_s, ka->layer, ka->chunk, bid, G); }
#endif

extern "C" void kernel_launch(void* const* d_in, const int* in_sizes, int n_in, void* d_out, int out_size, void* d_ws, size_t ws_size, hipStream_t stream) {
    static int grid = 0;
    if (!grid) {
        if (n_in != 25 || out_size != T * D || ws_size < WS_END) { fprintf(stderr, "kernel_launch: unexpected shapes (n_in %d out %d ws %zu need %zu)\n", n_in, out_size, ws_size, (size_t)WS_END); grid = -1; return; }
        int dev = 0, cus = 0; (void)hipGetDevice(&dev); (void)hipDeviceGetAttribute(&cus, hipDeviceAttributeMultiprocessorCount, dev);
#if MK_ONE_LAUNCH
        const void* ks[] = {(const void*)k_mega};
#else
        const void* ks[] = {(const void*)k_prologue, (const void*)k_convert, (const void*)k_gemm_kv, (const void*)k_gemm_in, (const void*)k_mixers, (const void*)k_gemm_out, (const void*)k_ln1_router,
                            (const void*)k_scatter, (const void*)k_gemm_gu, (const void*)k_gemm_dn, (const void*)k_combine};
#endif
        for (const void* k : ks) if (hipFuncSetAttribute(k, hipFuncAttributeMaxDynamicSharedMemorySize, LDS_BYTES) != hipSuccess) { fprintf(stderr, "kernel_launch: hipFuncSetAttribute failed\n"); grid = -1; return; }
        grid = cus > 0 ? cus : 256; if (grid > 256) grid = 256;
#if MK_ONE_LAUNCH
        int per_cu = 0;
        if (hipOccupancyMaxActiveBlocksPerMultiprocessor(&per_cu, (const void*)k_mega, NTHREADS, LDS_BYTES) != hipSuccess || per_cu < 1) { fprintf(stderr, "kernel_launch: occupancy query says %d blocks per CU\n", per_cu); grid = -1; return; }
#endif
    }
    if (grid < 0) return;
    KArgs a{};
    for (int i = 0; i < 25; ++i) a.in[i] = (const float*)d_in[i];
    a.out = (float*)d_out; a.ws = (unsigned char*)d_ws; a.layer = 0; a.chunk = 0;
    const dim3 g(grid), b(NTHREADS);
#if MK_ONE_LAUNCH
    (void)hipMemsetAsync((char*)d_ws + WS_CTL, 0, 65536, stream);
    hipLaunchKernelGGL(k_mega, g, b, LDS_BYTES, stream, a);
#else
    hipLaunchKernelGGL(k_prologue, g, b, LDS_BYTES, stream, a);
    hipLaunchKernelGGL(k_gemm_kv, g, b, LDS_BYTES, stream, a);
    for (int l = 0; l < DEPTH; ++l) {
        a.layer = l; a.chunk = 0;
        hipLaunchKernelGGL(k_convert, g, b, LDS_BYTES, stream, a);
        hipLaunchKernelGGL(k_gemm_in, g, b, LDS_BYTES, stream, a);
        hipLaunchKernelGGL(k_mixers, g, b, LDS_BYTES, stream, a);
        hipLaunchKernelGGL(k_gemm_out, g, b, LDS_BYTES, stream, a);
        hipLaunchKernelGGL(k_ln1_router, g, b, LDS_BYTES, stream, a);
        hipLaunchKernelGGL(k_scatter, g, b, LDS_BYTES, stream, a);
        hipLaunchKernelGGL(k_gemm_gu, g, b, LDS_BYTES, stream, a);
        for (int c = 0; c < NCH; ++c) { a.chunk = c;
            hipLaunchKernelGGL(k_gemm_dn, g, b, LDS_BYTES, stream, a);
            hipLaunchKernelGGL(k_combine, g, b, LDS_BYTES, stream, a); }
    }
#endif
}
```

```cpp
#include <hip/hip_runtime.h>
#include <cstdio>
#include <cstdint>

#ifndef MK_ONE_LAUNCH
#define MK_ONE_LAUNCH 1
#endif
#ifndef PROBE_SUB
#define PROBE_SUB 0
#endif
#ifndef PROBE_T
#define PROBE_T 0
#define PROBE_TPH 10
#endif
#ifndef PROBE_DUP
#define PROBE_DUP 0
#endif

#define LAS __attribute__((address_space(3)))
typedef unsigned short bf16;
typedef short bf16x8 __attribute__((ext_vector_type(8)));
typedef float f32x4 __attribute__((ext_vector_type(4)));
typedef float f32x2 __attribute__((ext_vector_type(2)));
typedef unsigned u32x4 __attribute__((ext_vector_type(4)));
typedef unsigned u32x2 __attribute__((ext_vector_type(2)));

constexpr int D = 1024, NBATCH = 16, SEQ = 4096, T = NBATCH * SEQ, DEPTH = 4;
constexpr int MEMT = 256, MROWS = NBATCH * MEMT;
constexpr int NPROJ = 1280, POOL_CH = 256, CONV_CH = 256, MEM_CH = 512, HEADS = 4, HD = 128;
constexpr int NE = 64, TOPK = 8, EH = 256;
constexpr int NCH = 2, CH_TOK = T / NCH, CH_SLOTS = CH_TOK * TOPK + NE * 256, CH_TILES_MAX = CH_SLOTS / 256;
constexpr int TBLK = 256, NTB = T / TBLK, TB_PER_CH = NTB / NCH;
constexpr int SH_ROW0 = NCH * CH_SLOTS;
constexpr float LN_EPS = 1e-5f;
constexpr float ALPHA = 1.6817928305074290f;
constexpr float ROUTED_SCALE = 2.5f;

constexpr size_t MiB = 1u << 20;
constexpr size_t WS_CTL = 0;
constexpr size_t CTL_BYTES = 1 * MiB;
constexpr size_t WS_TAB = WS_CTL + CTL_BYTES;
constexpr size_t TAB_HIST = WS_TAB, TAB_NT = WS_TAB + 65536, TAB_TE = WS_TAB + 65536 + 256;
constexpr size_t WS_TOK = WS_TAB + 1 * MiB;
constexpr size_t TOK_E = WS_TOK, TOK_G = WS_TOK + 2 * MiB, TOK_R = WS_TOK + 4 * MiB, TOK_SLOT = WS_TOK + 6 * MiB;
constexpr size_t WS_ROW = WS_TOK + 8 * MiB;
constexpr size_t ROW_TOK = WS_ROW, ROW_GATE = WS_ROW + 2560 * 1024;
constexpr size_t WS_SMALLW = WS_ROW + 5 * MiB;
constexpr size_t W_RT = WS_SMALLW, W_PT = WS_SMALLW + 131072, W_DWT = WS_SMALLW + 196608, W_RTL = WS_SMALLW + 262144;
constexpr size_t WS_WIN = WS_SMALLW + 1 * MiB;
constexpr size_t WS_WOUT = WS_WIN + (size_t)NPROJ * D * 2;
constexpr size_t WS_WGU = WS_WOUT + (size_t)D * D * 2;
constexpr size_t WS_WD = WS_WGU + (size_t)NE * 512 * D * 2;
constexpr size_t WS_WSGU = WS_WD + (size_t)NE * D * EH * 2;
constexpr size_t WS_WSD = WS_WSGU + (size_t)512 * D * 2;
constexpr size_t WS_WKV = WS_WSD + (size_t)D * EH * 2;
constexpr size_t WS_MEMN = WS_WKV + (size_t)DEPTH * D * D * 2;
constexpr size_t WS_MEMP = WS_MEMN + (size_t)MROWS * D * 2;
constexpr size_t WS_KB = WS_MEMP + (size_t)MROWS * D * 2;
constexpr size_t WS_VT = WS_KB + (size_t)DEPTH * MROWS * MEM_CH * 2;
constexpr size_t WS_XB = WS_VT + (size_t)DEPTH * MROWS * MEM_CH * 2;
constexpr size_t WS_ZB = WS_XB + (size_t)T * D * 2;
constexpr size_t WS_U = WS_ZB + (size_t)T * D * 2;
constexpr size_t U_PROJ = WS_U, U_CAT = WS_U + (size_t)T * NPROJ * 2, U_H = WS_U;
constexpr size_t U_BYTES = (size_t)(NCH * CH_SLOTS + T) * EH * 2;
static_assert(U_BYTES >= (size_t)T * NPROJ * 2 + (size_t)T * D * 2, "union region");
constexpr size_t WS_Y = WS_U + U_BYTES;
constexpr size_t WS_END = WS_Y + (size_t)CH_SLOTS * D;
constexpr float Y_SCALE = 32.0f, Y_INV = 1.0f / 32.0f, Y_CLAMP = 240.0f;

constexpr int LDS_STAGE = 0, STAGE_BYTES = 131072;
constexpr int MAXU = 24;
constexpr int LDS_TBL = STAGE_BYTES, LDS_CTLW = LDS_TBL + MAXU * 1024, LDS_BYTES = LDS_CTLW + 1024;
constexpr int NTHREADS = 512, NWAVES = 8;

__device__ __forceinline__ unsigned cvt_pk_bf16(float lo, float hi) { unsigned r; asm volatile("v_cvt_pk_bf16_f32 %0, %1, %2" : "=v"(r) : "v"(lo), "v"(hi)); return r; }
__device__ __forceinline__ float bf2f(unsigned h) { return __uint_as_float(h << 16); }
template <int M> __device__ __forceinline__ float swz_xor(float v) { return __int_as_float(__builtin_amdgcn_ds_swizzle(__float_as_int(v), (M << 10) | 0x1f)); }
__device__ __forceinline__ float bperm_f(int srclane, float v) { return __int_as_float(__builtin_amdgcn_ds_bpermute(srclane << 2, __float_as_int(v))); }
__device__ __forceinline__ int bperm_i(int srclane, int v) { return __builtin_amdgcn_ds_bpermute(srclane << 2, v); }
__device__ __forceinline__ float dpp_f(float v, const int ctrl_sel) {
    const int x = __float_as_int(v);
    int r;
    if (ctrl_sel == 0) r = __builtin_amdgcn_update_dpp(x, x, 0xB1, 0xf, 0xf, false);
    else if (ctrl_sel == 1) r = __builtin_amdgcn_update_dpp(x, x, 0x4E, 0xf, 0xf, false);
    else if (ctrl_sel == 2) r = __builtin_amdgcn_update_dpp(x, x, 0x141, 0xf, 0xf, false);
    else r = __builtin_amdgcn_update_dpp(x, x, 0x140, 0xf, 0xf, false);
    return __int_as_float(r);
}
__device__ __forceinline__ float rl_f(float v, int l) { return __int_as_float(__builtin_amdgcn_readlane(__float_as_int(v), l)); }
__device__ __forceinline__ float wave_sum(float v, int lane) {
    (void)lane;
    v += dpp_f(v, 0); v += dpp_f(v, 1); v += dpp_f(v, 2); v += dpp_f(v, 3);
    return (rl_f(v, 0) + rl_f(v, 16)) + (rl_f(v, 32) + rl_f(v, 48));
}
__device__ __forceinline__ float wave_max(float v, int lane) {
    (void)lane;
    v = fmaxf(v, dpp_f(v, 0)); v = fmaxf(v, dpp_f(v, 1)); v = fmaxf(v, dpp_f(v, 2)); v = fmaxf(v, dpp_f(v, 3));
    return fmaxf(fmaxf(rl_f(v, 0), rl_f(v, 16)), fmaxf(rl_f(v, 32), rl_f(v, 48)));
}
__device__ __forceinline__ float fast_sigmoid(float x) { return __builtin_amdgcn_rcpf(1.0f + __builtin_amdgcn_exp2f(-1.4426950408889634f * x)); }
__device__ __forceinline__ float fast_silu(float x) { return x * fast_sigmoid(x); }
__device__ __forceinline__ f32x2 fast_sigmoid2(const f32x2 x) { const f32x2 t = x * (f32x2){-1.4426950408889634f, -1.4426950408889634f};
    f32x2 e = (f32x2){__builtin_amdgcn_exp2f(t[0]), __builtin_amdgcn_exp2f(t[1])}; e = e + (f32x2){1.0f, 1.0f}; return (f32x2){__builtin_amdgcn_rcpf(e[0]), __builtin_amdgcn_rcpf(e[1])}; }
#define LDS_WAIT() asm volatile("s_waitcnt lgkmcnt(0)" ::: "memory")
__device__ __forceinline__ void unpack8(const u32x4 w, float* f) { f[0] = bf2f(w.x & 0xffffu); f[1] = bf2f(w.x >> 16); f[2] = bf2f(w.y & 0xffffu); f[3] = bf2f(w.y >> 16); f[4] = bf2f(w.z & 0xffffu); f[5] = bf2f(w.z >> 16); f[6] = bf2f(w.w & 0xffffu); f[7] = bf2f(w.w >> 16); }
__device__ __forceinline__ void addpack8(const u32x4 w, float* f) { f[0] += bf2f(w.x & 0xffffu); f[1] += bf2f(w.x >> 16); f[2] += bf2f(w.y & 0xffffu); f[3] += bf2f(w.y >> 16); f[4] += bf2f(w.z & 0xffffu); f[5] += bf2f(w.z >> 16); f[6] += bf2f(w.w & 0xffffu); f[7] += bf2f(w.w >> 16); }
__device__ __forceinline__ u32x4 pack8(const float* f) { u32x4 w; w.x = cvt_pk_bf16(f[0], f[1]); w.y = cvt_pk_bf16(f[2], f[3]); w.z = cvt_pk_bf16(f[4], f[5]); w.w = cvt_pk_bf16(f[6], f[7]); return w; }
__device__ __forceinline__ void ln_row16(float* v, const float* g, const float* b, int lane) {
    float s = 0.f;
#pragma unroll
    for (int i = 0; i < 16; ++i) s += v[i];
    const float mean = wave_sum(s, lane) * (1.f / D); float s2 = 0.f;
#pragma unroll
    for (int i = 0; i < 16; ++i) { v[i] -= mean; s2 += v[i] * v[i]; }
    const float rstd = __builtin_amdgcn_rsqf(wave_sum(s2, lane) * (1.f / D) + LN_EPS);
#pragma unroll
    for (int j = 0; j < 2; ++j) { const f32x4 g0 = *(const f32x4*)(g + 8 * lane + 512 * j), g1 = *(const f32x4*)(g + 8 * lane + 512 * j + 4), b0 = *(const f32x4*)(b + 8 * lane + 512 * j), b1 = *(const f32x4*)(b + 8 * lane + 512 * j + 4);
#pragma unroll
        for (int i = 0; i < 4; ++i) { v[8 * j + i] = v[8 * j + i] * rstd * g0[i] + b0[i]; v[8 * j + 4 + i] = v[8 * j + 4 + i] * rstd * g1[i] + b1[i]; } }
}
#define RSRC_W3 0x00020000
__device__ __forceinline__ bf16x8 bufld8(__amdgpu_buffer_rsrc_t rs, unsigned voff, unsigned soff) { const u32x4 v = __builtin_amdgcn_raw_buffer_load_b128(rs, (int)voff, (int)soff, 0); return __builtin_bit_cast(bf16x8, v); }

#define XB_TMO      128
#define XB_XCNT(j)  (256  + 64 * (j))
#define XB_XSUB(j)  (1280 + 64 * (j))
#define XB_XGEN(j)  (2304 + 64 * (j))
#define XB_TOP      3328
#define XB_TOPGEN   3392
#define XCD_BAR_WORDS 3456
#define XB_SPIN_CAP (1u << 18)
__device__ __forceinline__ unsigned xb_ld(unsigned* p)              { return __hip_atomic_load(p, __ATOMIC_RELAXED, __HIP_MEMORY_SCOPE_AGENT); }
__device__ __forceinline__ unsigned xb_add(unsigned* p, unsigned v) { return __hip_atomic_fetch_add(p, v, __ATOMIC_RELAXED, __HIP_MEMORY_SCOPE_AGENT); }
__device__ __forceinline__ unsigned xb_xcc_id() { return (unsigned)__builtin_amdgcn_s_getreg((3 << 11) | 20) & 0xFu; }
#define XB_SPIN(cond, bar) do { unsigned _sp = 0; while (cond) { __builtin_amdgcn_s_sleep(1); \
    if ((++_sp & 255u) == 0u) { if (xb_ld(&(bar)[XB_TMO])) break; if (_sp > XB_SPIN_CAP) { atomicAdd(&(bar)[XB_TMO], 1u); break; } } } } while (0)
struct XcdBarrier { unsigned* bar; unsigned x; volatile LAS unsigned* st; };
__device__ __forceinline__ XcdBarrier xcd_barrier_post(unsigned* bar, volatile LAS unsigned* st, int tid) {
    XcdBarrier b; b.bar = bar; b.x = xb_xcc_id(); b.st = st;
    if (tid == 0) (void)xb_add(&bar[XB_XCNT(b.x)], 1u);
    return b;
}
__device__ __forceinline__ void xcd_barrier_complete(unsigned* bar, unsigned x, unsigned& nloc, unsigned& nx) {
    const unsigned G = gridDim.x * gridDim.y * gridDim.z;
    unsigned sum, cnt, mine, sp = 0u;
    for (;;) {
        sum = 0u; cnt = 0u; mine = 0u;
#pragma unroll
        for (unsigned j = 0; j < 16; ++j) { const unsigned c = xb_ld(&bar[XB_XCNT(j)]); sum += c; cnt += (c > 0u) ? 1u : 0u; mine = (j == x) ? c : mine; }
        if (sum == G) break;
        __builtin_amdgcn_s_sleep(1);
        if ((++sp & 255u) == 0u) { if (xb_ld(&bar[XB_TMO])) break; if (sp > XB_SPIN_CAP) { atomicAdd(&bar[XB_TMO], 1u); break; } }
    }
    nloc = mine > 0u ? mine : 1u; nx = cnt > 0u ? cnt : 1u;
}
__device__ __forceinline__ void xcd_barrier(const XcdBarrier& b, int tid) {
    asm volatile("s_waitcnt vmcnt(0)" ::: "memory");
    __syncthreads();
    if (tid == 0) {
        unsigned* bar = b.bar;
        __builtin_amdgcn_s_waitcnt(0);
        unsigned nloc = b.st[0], nx = b.st[1];
        if (nloc == 0u) { xcd_barrier_complete(bar, b.x, nloc, nx); b.st[0] = nloc; b.st[1] = nx; }
        const unsigned old = xb_add(&bar[XB_XSUB(b.x)], 1u);
        const unsigned gen = old / nloc;
        if (old + 1u == (gen + 1u) * nloc) {
            __builtin_amdgcn_fence(__ATOMIC_RELEASE, "agent");
            asm volatile("s_waitcnt vmcnt(0)" ::: "memory");
            const unsigned og = xb_add(&bar[XB_TOP], 1u);
            const unsigned tg = og / nx;
            if (og + 1u == (tg + 1u) * nx) xb_add(&bar[XB_TOPGEN], 1u);
            else XB_SPIN(xb_ld(&bar[XB_TOPGEN]) == tg, bar);
            __builtin_amdgcn_fence(__ATOMIC_ACQUIRE, "agent");
            xb_add(&bar[XB_XGEN(b.x)], 1u);
            asm volatile("s_waitcnt vmcnt(0)" ::: "memory");
        } else {
            XB_SPIN(xb_ld(&bar[XB_XGEN(b.x)]) == gen, bar);
            __builtin_amdgcn_fence(__ATOMIC_ACQUIRE, "agent");
            asm volatile("s_waitcnt vmcnt(0)" ::: "memory");
        }
    }
    __syncthreads();
}

__device__ __forceinline__ void grid_bar(const XcdBarrier& b0, int wave_s) {
    unsigned* bp = b0.bar; unsigned x = b0.x; unsigned st = (unsigned)(uintptr_t)b0.st;
    asm volatile("" : "+s"(bp), "+s"(x), "+s"(st));
    XcdBarrier b; b.bar = bp; b.x = x; b.st = (volatile LAS unsigned*)(uintptr_t)st;
    int z = 0; asm volatile("" : "+v"(z)); const int tid = (wave_s << 6) | (int)__builtin_amdgcn_mbcnt_hi(~0u, __builtin_amdgcn_mbcnt_lo(~0u, (unsigned)z));
    xcd_barrier(b, tid);
}

namespace ge {
constexpr int BM = 256, BK = 64, HALF = 128, HTB = HALF * BK * 2, NXCD = 8, WGM = 8;
__device__ __forceinline__ void stage_rc(int b, int& R, int& C) { const int row = b >> 7, pos = (b >> 4) & 7; R = row; C = (pos ^ ((row >> 1) & 7)) * 8; }
__device__ __forceinline__ int perm32(int rho) { const int n = rho >> 4, i = rho & 15; return 8 * (i >> 2) + 4 * n + (i & 3); }
__device__ __forceinline__ int xcd_remap(int L, int n) { const int q = n / NXCD, r = n % NXCD, xcd = L % NXCD, off = L / NXCD; return (xcd < r ? xcd * (q + 1) : r * (q + 1) + (xcd - r) * q) + off; }

struct Unit {
    const char* A;
    const char* B;
    char* O;
    int ldc, row0, col0, aux, tbl;
};

template <int K, bool GATHER, class Epi, class Sched, int PT = 0, int BPERM = 0>
__device__ __forceinline__ void gemm_phase(const int tid, LAS unsigned char* lds, const LAS int* tbl, const Sched& S, const Epi& E) {
    const int wid = __builtin_amdgcn_readfirstlane(tid >> 6), lane = tid & 63, wr = wid >> 2, wc = wid & 3, fr = lane & 15, fq = lane >> 4;
    constexpr int nt = K / BK;
    static_assert(K % 128 == 0 && K >= 256, "K");
    int Rr[2], Cc[2]; unsigned voffB[2][2];
#pragma unroll
    for (int i = 0; i < 2; ++i) { int R, C; stage_rc(tid * 16 + i * 8192, R, C); Rr[i] = R; Cc[i] = C;
#pragma unroll
        for (int h = 0; h < 2; ++h) { const int Rb = BPERM ? (64 * (R >> 5) + 16 * ((R & 15) >> 2) + 8 * h + 4 * ((R >> 4) & 1) + (R & 3)) : (128 * h + (R & ~31) + perm32(R & 31));
            voffB[h][i] = (unsigned)(Rb * K + C) * 2u; } }
    constexpr size_t kstep = (size_t)(BK * 2);
    constexpr size_t hstep = (size_t)HALF * K * 2;
    const unsigned ldsw = (unsigned)wid * 1024u;
    int aoffk[2], boffk[2];
#pragma unroll
    for (int k = 0; k < 2; ++k) { const int pos = ((4 * k + fq) ^ ((fr >> 1) & 7)) << 4; aoffk[k] = (wr * 64 + fr) * 128 + pos; boffk[k] = (wc * 32 + fr) * 128 + pos; }
#define GE_SA(b, h) (((b) * 2 + (h)) * HTB)
#define GE_SB(b, h) ((4 + (b) * 2 + (h)) * HTB)
#define GE_RSRC(p) __builtin_amdgcn_make_buffer_rsrc((void*)(p), (short)0, 0x7fffffff, RSRC_W3)
#define GE_STAGE_B(bufoff, gbase, h) do { const __amdgpu_buffer_rsrc_t _rs = GE_RSRC(gbase); _Pragma("unroll") for (int _i = 0; _i < 2; ++_i) \
        __builtin_amdgcn_raw_ptr_buffer_load_lds(_rs, (LAS void*)(lds + (bufoff) + ldsw + _i * 8192), 16, (int)voffB[h][_i], 0, 0, 0); } while (0)
#define GE_STAGE_A(bufoff, gbase, o0, o1) do { const __amdgpu_buffer_rsrc_t _rs = GE_RSRC(gbase); \
        __builtin_amdgcn_raw_ptr_buffer_load_lds(_rs, (LAS void*)(lds + (bufoff) + ldsw), 16, (int)(o0), 0, 0, 0); \
        __builtin_amdgcn_raw_ptr_buffer_load_lds(_rs, (LAS void*)(lds + (bufoff) + ldsw + 8192), 16, (int)(o1), 0, 0, 0); } while (0)
#define GE_LDA(dst, b, h) do { _Pragma("unroll") for (int m = 0; m < 4; ++m) _Pragma("unroll") for (int k = 0; k < 2; ++k) dst[m][k] = *(const LAS bf16x8*)(lds + GE_SA(b, h) + aoffk[k] + m * 2048); } while (0)
#define GE_LDB(dst, b, h) do { _Pragma("unroll") for (int n = 0; n < 2; ++n) _Pragma("unroll") for (int k = 0; k < 2; ++k) dst[n][k] = *(const LAS bf16x8*)(lds + GE_SB(b, h) + boffk[k] + n * 2048); } while (0)
#define GE_MMA(ai, bj, At, Bt) do { __builtin_amdgcn_s_setprio(1); _Pragma("unroll") for (int m = 0; m < 4; ++m) _Pragma("unroll") for (int n = 0; n < 2; ++n) _Pragma("unroll") for (int k = 0; k < 2; ++k) \
        acc[ai][bj][m][n] = __builtin_amdgcn_mfma_f32_16x16x32_bf16(Bt[n][k], At[m][k], acc[ai][bj][m][n], 0, 0, 0); __builtin_amdgcn_s_setprio(0); } while (0)
#define GE_WAIT_V(n) asm volatile("s_waitcnt vmcnt(" #n ")" ::: "memory")
#define GE_WAIT_L(n) asm volatile("s_waitcnt lgkmcnt(" #n ")" ::: "memory")
#define GE_BAR __builtin_amdgcn_s_barrier()
#define GE_SCHED __builtin_amdgcn_sched_barrier(0)
#define GE_LOAD_VA(dst, u) do { _Pragma("unroll") for (int _h = 0; _h < 2; ++_h) _Pragma("unroll") for (int _i = 0; _i < 2; ++_i) { \
        if constexpr (GATHER) dst[_h][_i] = (unsigned)tbl[(u).tbl * 256 + _h * 128 + Rr[_i]] * (unsigned)(K * 2) + (unsigned)(Cc[_i] * 2); \
        else dst[_h][_i] = (unsigned)((_h * 128 + Rr[_i]) * K + Cc[_i]) * 2u; } } while (0)
    Unit cur, nxt; int ui = 0;
    if (!S.next(0, cur)) return;
    f32x4 acc[2][2][4][2];
#pragma unroll
    for (int a = 0; a < 2; ++a)
#pragma unroll
        for (int b = 0; b < 2; ++b)
#pragma unroll
            for (int m = 0; m < 4; ++m)
#pragma unroll
                for (int n = 0; n < 2; ++n) acc[a][b][m][n] = (f32x4){0.f, 0.f, 0.f, 0.f};
    bf16x8 At[4][2], B0[2][2], B1[2][2];
    unsigned va[2][2], vn[2][2];
    GE_LOAD_VA(va, cur);
#pragma unroll
    for (int h = 0; h < 2; ++h)
#pragma unroll
        for (int i = 0; i < 2; ++i) vn[h][i] = va[h][i];
    const char* cA = cur.A; const char* cB = cur.B;
    GE_STAGE_B(GE_SB(0, 0), cB, 0); GE_STAGE_B(GE_SB(0, 1), cB, 1); GE_STAGE_A(GE_SA(0, 0), cA, va[0][0], va[0][1]); GE_STAGE_A(GE_SA(0, 1), cA, va[1][0], va[1][1]);
    if (wr == 1) GE_BAR;
    GE_WAIT_V(2); GE_BAR;
    GE_STAGE_B(GE_SB(1, 0), cB + kstep, 0); GE_STAGE_A(GE_SA(1, 0), cA + kstep, va[0][0], va[0][1]); GE_STAGE_B(GE_SB(1, 1), cB + kstep, 1);
    GE_WAIT_V(6); GE_BAR;
    unsigned long long pt_acc = 0, pt_t0 = PT ? __builtin_amdgcn_s_memtime() : 0ull;
    for (;;) {
        if (PT == 3) pt_t0 = __builtin_amdgcn_s_memtime();
        const bool has_next = S.next(ui + 1, nxt);
        const char* nA = has_next ? nxt.A : cA; const char* nB = has_next ? nxt.B : cB;
        if (PT == 3) pt_acc += __builtin_amdgcn_s_memtime() - pt_t0;
        if (PT == 1) pt_t0 = __builtin_amdgcn_s_memtime();
        for (int t = 0; t < nt; t += 2) {
            const bool last = (t == nt - 2);
            if (last && has_next) { GE_LOAD_VA(vn, nxt); }
            const char* a1 = cA + (size_t)(t + 1) * kstep;
            const char* a2 = last ? nA : cA + (size_t)(t + 2) * kstep; const char* b2 = last ? nB : cB + (size_t)(t + 2) * kstep;
            const char* a3 = a2 + kstep; const char* b3 = b2 + kstep;
            const unsigned x00 = last ? vn[0][0] : va[0][0], x01 = last ? vn[0][1] : va[0][1], x10 = last ? vn[1][0] : va[1][0], x11 = last ? vn[1][1] : va[1][1];
            GE_LDB(B0, 0, 0); GE_LDB(B1, 0, 1); GE_SCHED; GE_LDA(At, 0, 0); GE_STAGE_A(GE_SA(1, 1), a1, va[1][0], va[1][1]);
            GE_WAIT_V(8); GE_WAIT_L(0); GE_BAR; GE_MMA(0, 0, At, B0); GE_MMA(0, 1, At, B1); GE_BAR; GE_SCHED;
            GE_LDA(At, 0, 1); GE_STAGE_B(GE_SB(0, 0), b2, 0); GE_STAGE_B(GE_SB(0, 1), b2, 1); GE_STAGE_A(GE_SA(0, 0), a2, x00, x01);
            GE_WAIT_V(8); GE_WAIT_L(0); GE_BAR; GE_MMA(1, 0, At, B0); GE_MMA(1, 1, At, B1); GE_BAR; GE_SCHED;
            GE_LDB(B0, 1, 0); GE_LDB(B1, 1, 1); GE_SCHED; GE_LDA(At, 1, 0); GE_STAGE_A(GE_SA(0, 1), a2, x10, x11);
            GE_WAIT_V(8); GE_WAIT_L(0); GE_BAR; GE_MMA(0, 0, At, B0); GE_MMA(0, 1, At, B1); GE_BAR; GE_SCHED;
            GE_LDA(At, 1, 1); GE_STAGE_B(GE_SB(1, 0), b3, 0); GE_STAGE_B(GE_SB(1, 1), b3, 1); GE_STAGE_A(GE_SA(1, 0), a3, x00, x01);
            GE_WAIT_V(8); GE_WAIT_L(0); GE_BAR; GE_MMA(1, 0, At, B0); GE_MMA(1, 1, At, B1); GE_BAR; GE_SCHED;
        }
        if (PT == 1) pt_acc += __builtin_amdgcn_s_memtime() - pt_t0;
        if (PT == 3) pt_t0 = __builtin_amdgcn_s_memtime();
        if (wr == 0) GE_BAR;
        if (PT == 3) pt_acc += __builtin_amdgcn_s_memtime() - pt_t0;
        if (PT == 2) pt_t0 = __builtin_amdgcn_s_memtime();
        E(acc, cur, wr, wc, fr, fq);
        if (PT == 2) { asm volatile("s_waitcnt vmcnt(0)" ::: "memory"); pt_acc += __builtin_amdgcn_s_memtime() - pt_t0; }
        if (PT == 3) pt_t0 = __builtin_amdgcn_s_memtime();
        if (!has_next) break;
#pragma unroll
        for (int a = 0; a < 2; ++a)
#pragma unroll
            for (int b = 0; b < 2; ++b)
#pragma unroll
                for (int m = 0; m < 4; ++m)
#pragma unroll
                    for (int n = 0; n < 2; ++n) acc[a][b][m][n] = (f32x4){0.f, 0.f, 0.f, 0.f};
        cur = nxt; cA = nA; cB = nB; ++ui;
#pragma unroll
        for (int h = 0; h < 2; ++h)
#pragma unroll
            for (int i = 0; i < 2; ++i) va[h][i] = vn[h][i];
        if (wr == 1) GE_BAR;
        if (PT == 3) pt_acc += __builtin_amdgcn_s_memtime() - pt_t0;
    }
    GE_WAIT_V(0);
    GE_BAR;
    if (PT) { const unsigned long long t1 = __builtin_amdgcn_s_memtime(); while (__builtin_amdgcn_s_memtime() - t1 < pt_acc) __builtin_amdgcn_s_sleep(8); }
#undef GE_SA
#undef GE_SB
#undef GE_STAGE_A
#undef GE_STAGE_B
#undef GE_RSRC
#undef GE_LDA
#undef GE_LDB
#undef GE_MMA
#undef GE_WAIT_V
#undef GE_WAIT_L
#undef GE_BAR
#undef GE_SCHED
#undef GE_LOAD_VA
}

struct EpiBf16 {
    __device__ __forceinline__ void operator()(const f32x4 (&acc)[2][2][4][2], const Unit& u, int wr, int wc, int fr, int fq) const {
        asm volatile("" : "+v"(fr), "+v"(fq));
#pragma unroll
        for (int ai = 0; ai < 2; ++ai)
#pragma unroll
            for (int m = 0; m < 4; ++m) { bf16* rowp = (bf16*)u.O + (size_t)(u.row0 + ai * HALF + wr * 64 + m * 16 + fr) * u.ldc + u.col0 + wc * 32 + 8 * fq;
#pragma unroll
                for (int bj = 0; bj < 2; ++bj) { const f32x4 v0 = acc[ai][bj][m][0], v1 = acc[ai][bj][m][1];
                    u32x4 w; w.x = cvt_pk_bf16(v0[0], v0[1]); w.y = cvt_pk_bf16(v0[2], v0[3]); w.z = cvt_pk_bf16(v1[0], v1[1]); w.w = cvt_pk_bf16(v1[2], v1[3]);
                    *(u32x4*)(rowp + bj * HALF) = w; } }
    }
};
__device__ __forceinline__ u32x4 res_pack(const u32x4 r, const f32x4 a0, const f32x4 a1) {
    u32x4 w;
    w.x = cvt_pk_bf16(bf2f(r.x & 0xffffu) * ALPHA + a0[0], bf2f(r.x >> 16) * ALPHA + a0[1]); w.y = cvt_pk_bf16(bf2f(r.y & 0xffffu) * ALPHA + a0[2], bf2f(r.y >> 16) * ALPHA + a0[3]);
    w.z = cvt_pk_bf16(bf2f(r.z & 0xffffu) * ALPHA + a1[0], bf2f(r.z >> 16) * ALPHA + a1[1]); w.w = cvt_pk_bf16(bf2f(r.w & 0xffffu) * ALPHA + a1[2], bf2f(r.w >> 16) * ALPHA + a1[3]);
    return w;
}
struct EpiResBf16 {
    const bf16* res; bf16* out;
    __device__ __forceinline__ void operator()(const f32x4 (&acc)[2][2][4][2], const Unit& u, int wr, int wc, int fr, int fq) const {
        asm volatile("" : "+v"(fr), "+v"(fq));
#pragma unroll
        for (int ai = 0; ai < 2; ++ai) {
            u32x4 r[4][2];
#pragma unroll
            for (int m = 0; m < 4; ++m)
#pragma unroll
                for (int bj = 0; bj < 2; ++bj) r[m][bj] = *(const u32x4*)(res + (size_t)(u.row0 + ai * HALF + wr * 64 + m * 16 + fr) * D + u.col0 + wc * 32 + 8 * fq + bj * HALF);
#pragma unroll
            for (int m = 0; m < 4; ++m)
#pragma unroll
                for (int bj = 0; bj < 2; ++bj) *(u32x4*)(out + (size_t)(u.row0 + ai * HALF + wr * 64 + m * 16 + fr) * D + u.col0 + wc * 32 + 8 * fq + bj * HALF) = res_pack(r[m][bj], acc[ai][bj][m][0], acc[ai][bj][m][1]);
            asm volatile("" ::: "memory"); }
    }
};
struct EpiSwiGLU {
    __device__ __forceinline__ void operator()(const f32x4 (&acc)[2][2][4][2], const Unit& u, int wr, int wc, int fr, int fq) const {
        asm volatile("" : "+v"(fr), "+v"(fq));
#pragma unroll
        for (int ai = 0; ai < 2; ++ai)
#pragma unroll
            for (int m = 0; m < 4; ++m) { bf16* rowp = (bf16*)u.O + (size_t)(u.row0 + ai * HALF + wr * 64 + m * 16 + fr) * EH + u.col0 + wc * 32 + 8 * fq;
                const f32x4 g0 = acc[ai][0][m][0], g1 = acc[ai][0][m][1], u0 = acc[ai][1][m][0], u1 = acc[ai][1][m][1];
                f32x2 v[4];
#pragma unroll
                for (int j = 0; j < 2; ++j) { const f32x2 ga = (f32x2){g0[2 * j], g0[2 * j + 1]}, gb = (f32x2){g1[2 * j], g1[2 * j + 1]};
                    v[j] = ga * fast_sigmoid2(ga) * (f32x2){u0[2 * j], u0[2 * j + 1]}; v[2 + j] = gb * fast_sigmoid2(gb) * (f32x2){u1[2 * j], u1[2 * j + 1]}; }
                u32x4 w; w.x = cvt_pk_bf16(v[0][0], v[0][1]); w.y = cvt_pk_bf16(v[1][0], v[1][1]); w.z = cvt_pk_bf16(v[2][0], v[2][1]); w.w = cvt_pk_bf16(v[3][0], v[3][1]);
                *(u32x4*)rowp = w; }
    }
};
struct EpiDown {
    static constexpr int VM_OPS = 8;
    const float* gate; const bf16* res;
    __device__ __forceinline__ void operator()(const f32x4 (&acc)[2][2][4][2], const Unit& u, int wr, int wc, int fr, int fq) const {
        asm volatile("" : "+v"(fr), "+v"(fq));
        if (u.aux >= 0) {
#pragma unroll
            for (int ai = 0; ai < 2; ++ai)
#pragma unroll
                for (int m = 0; m < 4; ++m) { const int r = ai * HALF + wr * 64 + m * 16 + fr;
                    unsigned char* rowp = (unsigned char*)u.O + ((size_t)(u.row0 >> 8) * 4 + (u.col0 >> 8)) * 65536 + r * 256 + wc * 64 + 16 * fq;
                    u32x4 w;
#pragma unroll
                    for (int bj = 0; bj < 2; ++bj) { f32x4 v0 = acc[ai][bj][m][0] * Y_SCALE, v1 = acc[ai][bj][m][1] * Y_SCALE;
#pragma unroll
                        for (int j = 0; j < 4; ++j) { v0[j] = __builtin_amdgcn_fmed3f(v0[j], -Y_CLAMP, Y_CLAMP); v1[j] = __builtin_amdgcn_fmed3f(v1[j], -Y_CLAMP, Y_CLAMP); }
                        int w0 = 0, w1 = 0;
                        w0 = __builtin_amdgcn_cvt_pk_fp8_f32(v0[0], v0[1], w0, false); w0 = __builtin_amdgcn_cvt_pk_fp8_f32(v0[2], v0[3], w0, true);
                        w1 = __builtin_amdgcn_cvt_pk_fp8_f32(v1[0], v1[1], w1, false); w1 = __builtin_amdgcn_cvt_pk_fp8_f32(v1[2], v1[3], w1, true);
                        w[2 * bj] = (unsigned)w0; w[2 * bj + 1] = (unsigned)w1; }
                    *(u32x4*)rowp = w; }
        } else {
            bf16* out = (bf16*)u.O;
#pragma unroll
            for (int ai = 0; ai < 2; ++ai) {
                u32x4 r[4][2];
#pragma unroll
                for (int m = 0; m < 4; ++m)
#pragma unroll
                    for (int bj = 0; bj < 2; ++bj) r[m][bj] = *(const u32x4*)(res + (size_t)(u.row0 + ai * HALF + wr * 64 + m * 16 + fr) * D + u.col0 + wc * 64 + 16 * fq + 8 * bj);
#pragma unroll
                for (int m = 0; m < 4; ++m)
#pragma unroll
                    for (int bj = 0; bj < 2; ++bj) *(u32x4*)(out + (size_t)(u.row0 + ai * HALF + wr * 64 + m * 16 + fr) * D + u.col0 + wc * 64 + 16 * fq + 8 * bj) = res_pack(r[m][bj], acc[ai][bj][m][0], acc[ai][bj][m][1]);
                asm volatile("" ::: "memory"); }
        }
    }
};

template <int K> struct SchedDense {
    const char* A; const char* B; char* O; int ldc, nM, nN, G, c;
    __device__ __forceinline__ bool next(int i, Unit& u) const {
        const int nwg = nM * nN; const long L = (long)i * G + c; if (L >= nwg) return false;
        const int wgid = xcd_remap((int)L, nwg);
        const int nig = WGM * nN, gid = wgid / nig, fm = gid * WGM, gsz = (nM - fm) < WGM ? (nM - fm) : WGM;
        const int pm = fm + ((wgid % nig) % gsz), pn = (wgid % nig) / gsz;
        u.A = A + (size_t)pm * (256 * K * 2); u.B = B + (size_t)pn * (256 * K * 2); u.O = O; u.ldc = ldc; u.row0 = pm * 256; u.col0 = pn * 256; u.aux = 0; u.tbl = 0; return true;
    }
};
struct SchedKV {
    const char* memn; const char* memp; const char* wkv; char* kb; char* vt; int G, c;
    __device__ __forceinline__ bool next(int i, Unit& u) const {
        const long L = (long)i * G + c; if (L >= 256) return false;
        const int idx = (int)L, l = idx >> 6, r = idx & 63; u.aux = 0; u.tbl = 0;
        const char* w = wkv + (size_t)l * D * D * 2;
        if (r < 32) { const int pm = r >> 1, pn = r & 1;
            u.A = memn + (size_t)pm * 256 * D * 2; u.B = w + (size_t)pn * 256 * D * 2; u.O = kb + (size_t)l * MROWS * MEM_CH * 2; u.ldc = MEM_CH; u.row0 = pm * 256; u.col0 = pn * 256; }
        else { const int q = r - 32, pm = q >> 4, pn = q & 15;
            u.A = w + (size_t)(512 + pm * 256) * D * 2; u.B = memp + (size_t)pn * 256 * D * 2; u.O = vt + (size_t)l * MROWS * MEM_CH * 2; u.ldc = MROWS; u.row0 = pm * 256; u.col0 = pn * 256; }
        return true;
    }
};
struct SchedGU {
    const char* xb; const char* wgu; const char* wsgu; char* h; const int* ntiles; const int* tile_e; int G, c;
    int nt_[NCH];
    __device__ __forceinline__ void init() {
#pragma unroll
        for (int q = 0; q < NCH; ++q) nt_[q] = ntiles[q]; }
    __device__ __forceinline__ bool next(int i, Unit& u) const {
        int ntot = T / 256;
#pragma unroll
        for (int q = 0; q < NCH; ++q) ntot += nt_[q];
        const int nun = ntot * 2; const long L = (long)i * G + c; if (L >= nun || i >= MAXU) return false;
        const int idx = xcd_remap((int)L, nun), pn = idx & 1; int rt = idx >> 1;
        u.A = xb; u.O = h; u.ldc = EH; u.col0 = pn * 128; u.tbl = i;
        int ch = -1, lt = 0;
#pragma unroll
        for (int q = 0; q < NCH; ++q) { if (ch < 0) { if (rt < nt_[q]) { ch = q; lt = rt; } else rt -= nt_[q]; } }
        if (ch >= 0) { const int e = tile_e[ch * CH_TILES_MAX + lt]; u.B = wgu + (size_t)e * 512 * D * 2 + (size_t)pn * 256 * D * 2; u.row0 = ch * CH_SLOTS + lt * 256; u.aux = -1; }
        else { u.B = wsgu + (size_t)pn * 256 * D * 2; u.row0 = SH_ROW0 + rt * 256; u.aux = rt * 256; }
        return true;
    }
};
struct SchedDN {
    const char* h; const char* wd; const char* wsd; char* y; char* dout; const int* tile_e; int ch, nt, G, c;
    __device__ __forceinline__ bool next(int i, Unit& u) const {
        const int nun = (CH_TOK / 256 + nt) * 4; const long L = (long)i * G + c; if (L >= nun) return false;
        const int idx = xcd_remap((int)L, nun), pn = idx & 3; const int p = idx >> 2; u.tbl = 0; u.ldc = D; u.col0 = pn * 256;
        constexpr int NS = CH_TOK / 256; const int R = NS + nt;
        const unsigned pn_ = (unsigned)p * NS; const int c0 = (int)(pn_ / (unsigned)R); const bool shared_here = pn_ - (unsigned)c0 * (unsigned)R + NS >= (unsigned)R;
        int rt = shared_here ? c0 : NS + (p - c0);
        if (rt < CH_TOK / 256) { const int row = ch * CH_TOK + rt * 256; u.A = h + (size_t)(SH_ROW0 + row) * EH * 2; u.B = wsd + (size_t)pn * 256 * EH * 2; u.O = dout; u.row0 = row; u.aux = -1; }
        else { rt -= CH_TOK / 256; const int e = tile_e[ch * CH_TILES_MAX + rt]; const int slot0 = ch * CH_SLOTS + rt * 256;
            u.A = h + (size_t)slot0 * EH * 2; u.B = wd + (size_t)e * D * EH * 2 + (size_t)pn * 256 * EH * 2; u.O = y; u.row0 = rt * 256; u.aux = slot0; }
        return true;
    }
};
}

struct KArgs { const float* in[25]; float* out; unsigned char* ws; int layer; int chunk; };
typedef const __attribute__((address_space(4))) KArgs* KArgP;
#define KA_OPAQUE(p) asm volatile("" : "+s"(p))
#define PHASE_BEGIN() int z_ = 0; asm volatile("" : "+v"(z_)); int tid = (wave_s << 6) | (int)__builtin_amdgcn_mbcnt_hi(~0u, __builtin_amdgcn_mbcnt_lo(~0u, (unsigned)z_)); asm volatile("" : "+v"(tid)); asm volatile("" : "+s"(bid), "+s"(G)); KA_OPAQUE(ka)
enum { I_X = 0, I_MEM, I_WIN, I_WPOOL, I_PSCALE, I_WDW, I_BDW, I_CNG, I_CNB, I_WKV, I_WOUT, I_LN1G, I_LN1B, I_WR, I_RB, I_WG, I_WU, I_WD, I_WGS, I_WUS, I_WDS, I_LN2G, I_LN2B, I_MNG, I_MNB };

__device__ __forceinline__ void transpose_item(const float* W, int N, bf16* WT, int ldk, int row_off, LAS float* scr, int k0, int n0, int lane, bf16* WTlo = nullptr) {
    { f32x4 ld[8]; const int c4 = lane & 7, kr = lane >> 3;
#pragma unroll
        for (int i = 0; i < 8; ++i) ld[i] = __builtin_nontemporal_load((const f32x4*)(W + (size_t)(k0 + kr + 8 * i) * N + n0 + 4 * c4));
#pragma unroll
        for (int i = 0; i < 8; ++i) { LAS float* d = scr + (kr + 8 * i) * 33 + 4 * c4; d[0] = ld[i][0]; d[1] = ld[i][1]; d[2] = ld[i][2]; d[3] = ld[i][3]; } }
    LDS_WAIT(); asm volatile("" ::: "memory");
    const int c = lane & 7;
#pragma unroll
    for (int j = 0; j < 4; ++j) { const int n = (lane >> 3) + 8 * j; const LAS float* s = scr + (8 * c) * 33 + n;
        float f[8];
#pragma unroll
        for (int i = 0; i < 8; ++i) f[i] = s[i * 33];
        const u32x4 o = pack8(f);
        *(u32x4*)(WT + (size_t)(row_off + n) * ldk + k0 + 8 * c) = o;
        if (WTlo) { float h[8]; unpack8(o, h);
#pragma unroll
            for (int i = 0; i < 8; ++i) f[i] -= h[i];
            *(u32x4*)(WTlo + (size_t)(row_off + n) * ldk + k0 + 8 * c) = pack8(f); } }
    LDS_WAIT(); asm volatile("" ::: "memory");
}

struct CItem { const float* src; bf16* dst; int ld, ldk, k0, gu_half; };
__device__ __forceinline__ CItem cdecode(KArgP ka, unsigned char* ws, int l, int it) {
    if (it < 2 * NE * 16) { const int half = it / (NE * 16), r = it % (NE * 16), e = r >> 4, kb = r & 15;
        return CItem{ka->in[half ? I_WU : I_WG] + ((size_t)l * NE + e) * D * EH + (size_t)kb * 64 * EH, (bf16*)(ws + WS_WGU) + (size_t)e * 512 * D, EH, D, kb * 64, half}; }
    const int r = it - 2 * NE * 16, e = r >> 4, kb = (r >> 2) & 3, nb = r & 3;
    return CItem{ka->in[I_WD] + ((size_t)l * NE + e) * EH * D + (size_t)kb * 64 * D + nb * 256, (bf16*)(ws + WS_WD) + (size_t)e * D * EH + (size_t)nb * 256 * EH, D, EH, kb * 64, -1};
}
__device__ __forceinline__ void phase_convert_layer(KArgP ka, const int wave_s, int l, LAS unsigned char* lds, int bid, int G) {
    PHASE_BEGIN();
    const int lane = tid & 63, wave = __builtin_amdgcn_readfirstlane(tid >> 6);
    unsigned char* ws = ka->ws;
    { float* dwt = (float*)(ws + W_DWT); const float* wdw = ka->in[I_WDW] + (size_t)l * 31 * CONV_CH; const float* bdw = ka->in[I_BDW] + (size_t)l * CONV_CH;
        for (int i = bid * NTHREADS + tid; i < 256 * 32; i += G * NTHREADS) { const int j = i >> 8, ch = i & 255; dwt[ch * 32 + j] = (j < 31) ? wdw[j * CONV_CH + ch] : bdw[ch]; } }
    {
        constexpr int NCI = 2 * NE * 16 + NE * 16, TS = 257, TBYTES = 64 * TS * 4;
        f32x4 ld[8];
        int it = bid; int buf = 0;
        CItem d = cdecode(ka, ws, l, it < NCI ? it : 0);
        if (it < NCI) {
#pragma unroll
            for (int i = 0; i < 8; ++i) ld[i] = __builtin_nontemporal_load((const f32x4*)(d.src + (size_t)(i * 8 + wave) * d.ld + lane * 4));
        }
#pragma unroll 1
        for (; it < NCI; it += G) {
            LAS float* Tt = (LAS float*)(lds + buf * TBYTES);
#pragma unroll
            for (int i = 0; i < 8; ++i) { LAS float* p = Tt + (i * 8 + wave) * TS + lane * 4; p[0] = ld[i][0]; p[1] = ld[i][1]; p[2] = ld[i][2]; p[3] = ld[i][3]; }
            __syncthreads();
            const CItem dc = d;
            const int itn = it + G;
            if (itn < NCI) { d = cdecode(ka, ws, l, itn);
#pragma unroll
                for (int i = 0; i < 8; ++i) ld[i] = __builtin_nontemporal_load((const f32x4*)(d.src + (size_t)(i * 8 + wave) * d.ld + lane * 4)); }
#pragma unroll
            for (int p = 0; p < 4; ++p) { const int idx = p * NTHREADS + tid, n = idx >> 3, kc = idx & 7;
                float f[8];
#pragma unroll
                for (int i = 0; i < 8; ++i) f[i] = Tt[(8 * kc + i) * TS + n];
                const int row = dc.gu_half >= 0 ? ((n >> 7) * 256 + dc.gu_half * 128 + (n & 127)) : n;
                *(u32x4*)(dc.dst + (size_t)row * dc.ldk + dc.k0 + 8 * kc) = pack8(f); }
            buf ^= 1;
        }
        __syncthreads();
    }
    LAS float* scr = (LAS float*)(lds + wave * 16384);
    constexpr int I_IN = 16 * 40, I_OUT = 16 * 32, I_SH = 128, I_R = 16 * 2, I_P = 4 * 2;
    constexpr int NIT = I_IN + I_OUT + 3 * I_SH + I_R + I_P;
    for (int it = bid * NWAVES + wave; it < NIT; it += G * NWAVES) {
        int r = it;
        if (r < I_IN) { const int kb = r / 40, nb = r % 40; transpose_item(ka->in[I_WIN] + (size_t)l * D * NPROJ, NPROJ, (bf16*)(ws + WS_WIN), D, 32 * nb, scr, 64 * kb, 32 * nb, lane); continue; } r -= I_IN;
        if (r < I_OUT) { const int kb = r / 32, nb = r % 32; transpose_item(ka->in[I_WOUT] + (size_t)l * D * D, D, (bf16*)(ws + WS_WOUT), D, 32 * nb, scr, 64 * kb, 32 * nb, lane); continue; } r -= I_OUT;
        if (r < 2 * I_SH) { const int half = r / I_SH; r %= I_SH; const int kb = r / 8, nb = r % 8, n0 = 32 * nb;
            transpose_item(ka->in[half ? I_WUS : I_WGS] + (size_t)l * D * EH, EH, (bf16*)(ws + WS_WSGU), D, (n0 >> 7) * 256 + half * 128 + (n0 & 127), scr, 64 * kb, n0, lane); continue; } r -= 2 * I_SH;
        if (r < I_SH) { const int kb = r / 32, nb = r % 32; transpose_item(ka->in[I_WDS] + (size_t)l * EH * D, D, (bf16*)(ws + WS_WSD), EH, 32 * nb, scr, 64 * kb, 32 * nb, lane); continue; } r -= I_SH;
        if (r < I_R) { const int kb = r / 2, nb = r % 2; transpose_item(ka->in[I_WR] + (size_t)l * D * NE, NE, (bf16*)(ws + W_RT), D, 32 * nb, scr, 64 * kb, 32 * nb, lane, (bf16*)(ws + W_RTL)); continue; } r -= I_R;
        { const int g = r / 2, nb = r % 2; transpose_item(ka->in[I_WPOOL] + ((size_t)l * 4 + g) * 64 * 64, 64, (bf16*)(ws + W_PT) + (size_t)g * 64 * 64, 64, 32 * nb, scr, 0, 32 * nb, lane); }
    }
}

__device__ __forceinline__ void phase_prologue(KArgP ka, const int wave_s, LAS unsigned char* lds, int bid, int G) {
    PHASE_BEGIN();
    const int lane = tid & 63, wave = __builtin_amdgcn_readfirstlane(tid >> 6);
    LAS float* scr = (LAS float*)(lds + wave * 16384);
    unsigned char* ws = ka->ws;
    const int gw = bid * NWAVES + wave, NGW = G * NWAVES;
    for (int it = gw; it < DEPTH * 512; it += NGW) { const int l = it / 512, q = it % 512, kb = q / 32, nb = q % 32;
        transpose_item(ka->in[I_WKV] + (size_t)l * D * D, D, (bf16*)(ws + WS_WKV) + (size_t)l * D * D, D, 32 * nb, scr, 64 * kb, 32 * nb, lane); }
    const float* g = ka->in[I_MNG]; const float* b = ka->in[I_MNB];
    for (int m = gw; m < MROWS; m += NGW) {
        const f32x4* xr = (const f32x4*)(ka->in[I_MEM] + (size_t)m * D) + lane;
        f32x4 v[4]; float s = 0.f;
#pragma unroll
        for (int j = 0; j < 4; ++j) { v[j] = xr[64 * j]; s += (v[j][0] + v[j][1]) + (v[j][2] + v[j][3]); }
        const float mean = wave_sum(s, lane) * (1.f / D); float s2 = 0.f;
#pragma unroll
        for (int j = 0; j < 4; ++j) { v[j] = v[j] - mean; s2 += (v[j][0] * v[j][0] + v[j][1] * v[j][1]) + (v[j][2] * v[j][2] + v[j][3] * v[j][3]); }
        const float rstd = __builtin_amdgcn_rsqf(wave_sum(s2, lane) * (1.f / D) + LN_EPS);
        u32x2* o8 = (u32x2*)((bf16*)(ws + WS_MEMN) + (size_t)m * D) + lane;
        const int ml = m & 31, mp = (m & ~31) + 8 * ((ml >> 2) & 3) + 4 * (ml >> 4) + (ml & 3);
        u32x2* p8 = (u32x2*)((bf16*)(ws + WS_MEMP) + (size_t)mp * D) + lane;
#pragma unroll
        for (int j = 0; j < 4; ++j) { const f32x4 gg = ((const f32x4*)g)[lane + 64 * j], bb = ((const f32x4*)b)[lane + 64 * j]; const f32x4 y = v[j] * rstd * gg + bb;
            u32x2 w; w.x = cvt_pk_bf16(y[0], y[1]); w.y = cvt_pk_bf16(y[2], y[3]); o8[64 * j] = w; p8[64 * j] = w; }
    }
    const size_t n8 = (size_t)T * D / 8;
    for (size_t i = (size_t)bid * NTHREADS + tid; i < n8; i += (size_t)G * NTHREADS) {
        const f32x4 p0 = __builtin_nontemporal_load((const f32x4*)ka->in[I_X] + 2 * i), p1 = __builtin_nontemporal_load((const f32x4*)ka->in[I_X] + 2 * i + 1);
        u32x4 w; w.x = cvt_pk_bf16(p0[0], p0[1]); w.y = cvt_pk_bf16(p0[2], p0[3]); w.z = cvt_pk_bf16(p1[0], p1[1]); w.w = cvt_pk_bf16(p1[2], p1[3]);
        ((u32x4*)(ws + WS_XB))[i] = w;
    }
}

#define OPAQUE_TID() int z2_ = 0; asm volatile("" : "+v"(z2_)); int tid = (wave_s << 6) | (int)__builtin_amdgcn_mbcnt_hi(~0u, __builtin_amdgcn_mbcnt_lo(~0u, (unsigned)z2_)); asm volatile("" : "+v"(tid)); const int lane = tid & 63, wave = __builtin_amdgcn_readfirstlane(tid >> 6); (void)lane; (void)wave
__device__ __forceinline__ void phase_mixers(KArgP ka, const int wave_s, int l, LAS unsigned char* lds, int bid, int G) {
    PHASE_BEGIN();
    unsigned char* ws = ka->ws;
    const bf16* proj = (const bf16*)(ws + U_PROJ); bf16* cat = (bf16*)(ws + U_CAT);
    const bf16* wpt = (const bf16*)(ws + W_PT);
    const bf16* Kb = (const bf16*)(ws + WS_KB) + (size_t)l * MROWS * MEM_CH; const bf16* Vt = (const bf16*)(ws + WS_VT) + (size_t)l * MROWS * MEM_CH;
    const float* pscale = ka->in[I_PSCALE] + (size_t)l * POOL_CH;
    const float* dwt = (const float*)(ws + W_DWT);
    const float* cng = ka->in[I_CNG] + (size_t)l * CONV_CH; const float* cnb = ka->in[I_CNB] + (size_t)l * CONV_CH;
#pragma unroll 1
    for (int item = bid; item < T / 256; item += G) {
        const int b = item >> 4, s256 = (item & 15) * 256; const size_t t256 = (size_t)b * SEQ + s256;
        {
            OPAQUE_TID();
            const int fr = lane & 15, fq = lane >> 4, x2 = fr >> 2, x0 = fq ^ (fr & 3);
            constexpr float SC = 0.08838834764831845f * 1.4426950408889634f;
            const __amdgpu_buffer_rsrc_t qR = __builtin_amdgcn_make_buffer_rsrc((void*)(proj + (t256 + wave * 32) * NPROJ + 768), (short)0, 32 * NPROJ * 2, RSRC_W3);
            const unsigned qlane = (unsigned)(fr * NPROJ + 8 * fq) * 2u;
            const unsigned kbase = (unsigned)(fr * 256), vbase = 65536u + (unsigned)(fr * 512);
            const int kr = tid >> 4, ksw = (tid & 15) ^ (kr & 15), vr = tid >> 5, vsw = (tid & 31) ^ (vr & 15);
#define ATT_STAGE_K(h_) do { const char* ksrc = (const char*)(Kb + ((size_t)b * MEMT + kr) * MEM_CH + (h_) * HD + ksw * 8); _Pragma("unroll") \
                for (int i = 0; i < 8; ++i) __builtin_amdgcn_global_load_lds((const unsigned*)(ksrc + (size_t)i * 32 * MEM_CH * 2), (LAS unsigned*)(lds + (i * 512 + wave * 64) * 16), 16, 0, 0); } while (0)
#define ATT_STAGE_V(h_) do { const char* vsrc = (const char*)(Vt + (size_t)((h_) * HD + vr) * MROWS + b * MEMT + vsw * 8); _Pragma("unroll") \
                for (int i = 0; i < 8; ++i) __builtin_amdgcn_global_load_lds((const unsigned*)(vsrc + (size_t)i * 16 * MROWS * 2), (LAS unsigned*)(lds + 65536 + (i * 512 + wave * 64) * 16), 16, 0, 0); } while (0)
#define ATT_LOAD_Q(h_) do { _Pragma("unroll") for (int qt = 0; qt < 2; ++qt) _Pragma("unroll") for (int ks = 0; ks < 4; ++ks) { const unsigned so_ = (unsigned)(qt * 16 * NPROJ + (h_) * HD + ks * 32) * 2u; \
                asm volatile("buffer_load_dwordx4 %0, %1, %2, %3 offen" : "=v"(bq[qt][ks]) : "v"(qlane), "s"(qR), "s"(so_) : "memory"); } } while (0)
            bf16x8 bq[2][4];
#define ATT_Q_READY(n_) do { asm volatile("s_waitcnt vmcnt(" #n_ ")" ::: "memory"); _Pragma("unroll") for (int qt = 0; qt < 2; ++qt) _Pragma("unroll") for (int ks = 0; ks < 4; ++ks) asm volatile("" : "+v"(bq[qt][ks])); \
                __builtin_amdgcn_sched_barrier(0); } while (0)
            ATT_STAGE_K(0); ATT_LOAD_Q(0); ATT_Q_READY(0);
#pragma unroll 1
            for (int hh = 0; hh < HEADS; ++hh) {
                __builtin_amdgcn_s_barrier();
                ATT_STAGE_V(hh);
                f32x4 s[2][16];
#pragma unroll
                for (int ct = 0; ct < 16; ++ct) { s[0][ct] = (f32x4){0.f, 0.f, 0.f, 0.f}; s[1][ct] = (f32x4){0.f, 0.f, 0.f, 0.f};
#pragma unroll
                    for (int ks = 0; ks < 4; ++ks) { const bf16x8 kf = *(const LAS bf16x8*)(lds + kbase + (unsigned)((((ks ^ x2) << 2) | x0) << 4) + ct * 4096);
                        s[0][ct] = __builtin_amdgcn_mfma_f32_16x16x32_bf16(kf, bq[0][ks], s[0][ct], 0, 0, 0); s[1][ct] = __builtin_amdgcn_mfma_f32_16x16x32_bf16(kf, bq[1][ks], s[1][ct], 0, 0, 0); } }
                float inv[2];
                bf16x8 pb[2][8];
#pragma unroll
                for (int qt = 0; qt < 2; ++qt) { float m = s[qt][0][0];
#pragma unroll
                    for (int ct = 0; ct < 16; ++ct)
#pragma unroll
                        for (int j = 0; j < 4; ++j) m = fmaxf(m, s[qt][ct][j]);
                    m = fmaxf(m, swz_xor<16>(m)); m = fmaxf(m, bperm_f(lane ^ 32, m));
                    const float nm = -m * SC; float sum = 0.f;
#pragma unroll
                    for (int ks = 0; ks < 8; ++ks) { float p[8];
#pragma unroll
                        for (int j = 0; j < 4; ++j) { p[j] = __builtin_amdgcn_exp2f(__builtin_fmaf(s[qt][2 * ks][j], SC, nm)); p[4 + j] = __builtin_amdgcn_exp2f(__builtin_fmaf(s[qt][2 * ks + 1][j], SC, nm)); }
#pragma unroll
                        for (int j = 0; j < 8; ++j) sum += p[j];
                        pb[qt][ks] = __builtin_bit_cast(bf16x8, pack8(p)); }
                    sum += swz_xor<16>(sum); sum += bperm_f(lane ^ 32, sum);
                    inv[qt] = __builtin_amdgcn_rcpf(sum); }
                asm volatile("s_waitcnt vmcnt(0)" ::: "memory");
                __builtin_amdgcn_s_barrier();
                if (hh + 1 < HEADS) { ATT_STAGE_K(hh + 1); ATT_LOAD_Q(hh + 1); }
                __builtin_amdgcn_sched_barrier(0);
                f32x4 o[2][8];
#pragma unroll
                for (int dt = 0; dt < 8; ++dt) { o[0][dt] = (f32x4){0.f, 0.f, 0.f, 0.f}; o[1][dt] = (f32x4){0.f, 0.f, 0.f, 0.f}; }
#pragma unroll
                for (int ks = 0; ks < 8; ++ks) {
#pragma unroll
                    for (int dt = 0; dt < 8; ++dt) { const bf16x8 vf = *(const LAS bf16x8*)(lds + vbase + (unsigned)((((ks ^ x2) << 2) | x0) << 4) + dt * 8192);
                        o[0][dt] = __builtin_amdgcn_mfma_f32_16x16x32_bf16(vf, pb[0][ks], o[0][dt], 0, 0, 0); o[1][dt] = __builtin_amdgcn_mfma_f32_16x16x32_bf16(vf, pb[1][ks], o[1][dt], 0, 0, 0); } }
#pragma unroll
                for (int qt = 0; qt < 2; ++qt) { bf16* orow = cat + (t256 + wave * 32 + qt * 16 + fr) * D + 512 + hh * HD + 4 * fq;
#pragma unroll
                    for (int dt = 0; dt < 8; ++dt) { u32x2 w; w.x = cvt_pk_bf16(o[qt][dt][0] * inv[qt], o[qt][dt][1] * inv[qt]); w.y = cvt_pk_bf16(o[qt][dt][2] * inv[qt], o[qt][dt][3] * inv[qt]); *(u32x2*)(orow + dt * 16) = w; } }
                ATT_Q_READY(16);
            }
            __syncthreads();
#undef ATT_STAGE_K
#undef ATT_STAGE_V
#undef ATT_LOAD_Q
#undef ATT_Q_READY
        }
#pragma unroll 1
        for (int hp = 0; hp < 2; ++hp) {
            const int s0 = s256 + hp * 128;
            OPAQUE_TID();
            LAS bf16* Gb = (LAS bf16*)lds;
            LAS float* Yc = (LAS float*)(lds + 81920);
            const int c2 = tid & 127, rg = tid >> 7; f32x2 wv[32];
#pragma unroll
            for (int j = 0; j < 8; ++j) { const f32x4 wa = ((const f32x4*)(dwt + (2 * c2) * 32))[j], wb = ((const f32x4*)(dwt + (2 * c2 + 1) * 32))[j];
#pragma unroll
                for (int i = 0; i < 4; ++i) wv[4 * j + i] = (f32x2){wa[i], wb[i]}; }
            const f32x4 gg = ((const f32x4*)cng)[lane], bb = ((const f32x4*)cnb)[lane];
            { u32x4 av[10], gv[10];
#pragma unroll
                for (int q = 0; q < 10; ++q) { const int i = tid + q * NTHREADS, r = i >> 5, c8 = i & 31, sp = s0 - 15 + r;
                    av[q] = (u32x4){0u, 0u, 0u, 0u}; gv[q] = av[q];
                    if (i < 158 * 32 && sp >= 0 && sp < SEQ) { const bf16* pr = proj + ((size_t)b * SEQ + sp) * NPROJ + 256 + c8 * 8; av[q] = __builtin_nontemporal_load((const u32x4*)pr); gv[q] = __builtin_nontemporal_load((const u32x4*)(pr + 256)); } }
#pragma unroll
                for (int q = 0; q < 10; ++q) { const int i = tid + q * NTHREADS, r = i >> 5, c8 = i & 31;
                    float a8[8], g8[8]; unpack8(av[q], a8); unpack8(gv[q], g8);
#pragma unroll
                    for (int j = 0; j < 8; j += 2) { const f32x2 r2 = (f32x2){a8[j], a8[j + 1]} * fast_sigmoid2((f32x2){g8[j], g8[j + 1]}); a8[j] = r2[0]; a8[j + 1] = r2[1]; }
                    if (i < 158 * 32) *(LAS u32x4*)(Gb + r * 256 + c8 * 8) = pack8(a8); } }
            __syncthreads();
#pragma unroll 1
            for (int sub2 = 0; sub2 < 2; ++sub2) { const size_t t0 = t256 + hp * 128 + sub2 * 64;
                { const f32x2 bias = wv[31];
#pragma unroll 1
                    for (int rb = 0; rb < 4; ++rb) { const int r0 = rg * 16 + rb * 4; f32x2 gv[34];
#pragma unroll
                        for (int j = 0; j < 34; ++j) { const unsigned w = *(const LAS unsigned*)(Gb + (sub2 * 64 + r0 + j) * 256 + 2 * c2); gv[j] = (f32x2){bf2f(w & 0xffffu), bf2f(w >> 16)}; }
#pragma unroll
                        for (int q = 0; q < 4; ++q) { f32x2 y = bias;
#pragma unroll
                            for (int j = 0; j < 31; ++j) y = gv[q + j] * wv[j] + y;
                            *(LAS f32x2*)(Yc + (r0 + q) * 256 + 2 * c2) = y; } } }
                __syncthreads();
                {
#pragma unroll 2
                    for (int r = wave; r < 64; r += NWAVES) { const f32x4 v = *(const LAS f32x4*)(Yc + r * 256 + lane * 4);
                        const float mean = wave_sum((v[0] + v[1]) + (v[2] + v[3]), lane) * (1.f / 256.f); const f32x4 d = v - mean;
                        const float rstd = __builtin_amdgcn_rsqf(wave_sum((d[0] * d[0] + d[1] * d[1]) + (d[2] * d[2] + d[3] * d[3]), lane) * (1.f / 256.f) + LN_EPS);
                        const f32x4 y = d * rstd * gg + bb;
                        const f32x2 ya = (f32x2){y[0], y[1]}, yb = (f32x2){y[2], y[3]}; const f32x2 za = ya * fast_sigmoid2(ya), zb2 = yb * fast_sigmoid2(yb);
                        u32x2 w; w.x = cvt_pk_bf16(za[0], za[1]); w.y = cvt_pk_bf16(zb2[0], zb2[1]);
                        *(u32x2*)(cat + (t0 + r) * D + 256 + lane * 4) = w; } }
                __syncthreads();
            }
        }
        constexpr int PR = 128;
#pragma unroll 1
        for (int pt = 0; pt < 256 / PR; ++pt) {
            const int s0 = s256 + pt * PR; const size_t t0 = t256 + pt * PR;
            {
                OPAQUE_TID();
                LAS bf16* Ub = (LAS bf16*)lds;
                LAS bf16* Db = (LAS bf16*)(lds + (PR + 16) * 528);
                bf16x8 wfp[4][2]; float scp[4];
                { const int g = wave >> 1, fr = lane & 15, fq = lane >> 4;
#pragma unroll
                    for (int ct = 0; ct < 4; ++ct) { scp[ct] = pscale[g * 64 + ct * 16 + fr];
#pragma unroll
                        for (int ks = 0; ks < 2; ++ks) wfp[ct][ks] = *(const bf16x8*)(wpt + (size_t)g * 4096 + (ct * 16 + fr) * 64 + ks * 32 + 8 * fq); } }
                { u32x4 uv[(PR + 16) / 16];
#pragma unroll
                    for (int q = 0; q < (PR + 16) / 16; ++q) { const int i = tid + q * NTHREADS, r = i >> 5, c8 = i & 31, sp = s0 - 8 + r;
                        uv[q] = (u32x4){0u, 0u, 0u, 0u}; if (sp >= 0 && sp < SEQ) uv[q] = __builtin_nontemporal_load((const u32x4*)(proj + ((size_t)b * SEQ + sp) * NPROJ + c8 * 8)); }
#pragma unroll
                    for (int q = 0; q < (PR + 16) / 16; ++q) { const int i = tid + q * NTHREADS, r = i >> 5, c8 = i & 31; *(LAS u32x4*)(Ub + r * 264 + c8 * 8) = uv[q]; } }
                __syncthreads();
                { const int c2 = tid & 127, rg = tid >> 7, g = c2 >> 5; const int w = 2 << g, lo = w >> 1, hi = w - 1 - lo;
#define POOL_LD2(row) ({ const unsigned _w = *(const LAS unsigned*)(Ub + (row) * 264 + 2 * c2); (f32x2){bf2f(_w & 0xffffu), bf2f(_w >> 16)}; })
                    const int r0 = rg * (PR / 4); f32x2 run = (f32x2){0.f, 0.f};
#pragma unroll
                    for (int k = 0; k < 16; ++k) { const f32x2 t = POOL_LD2(r0 - lo + k + 8); if (k < w) run += t; }
                    if (s0 != 0 && s0 + PR != SEQ) {
                        const float invw = 1.0f / (float)w;
#pragma unroll 1
                        for (int rb = r0; rb < r0 + PR / 4; rb += 8) {
                            f32x2 cv[8], av[8], sv[8];
#pragma unroll
                            for (int i = 0; i < 8; ++i) { cv[i] = POOL_LD2(rb + i + 8); av[i] = POOL_LD2(rb + i + 9 + hi); sv[i] = POOL_LD2(rb + i + 8 - lo); }
#pragma unroll
                            for (int i = 0; i < 8; ++i) { const f32x2 d = run * invw - cv[i];
                                *(LAS unsigned*)(Db + (rb + i) * 264 + 2 * c2) = cvt_pk_bf16(d[0], d[1]);
                                run += av[i] - sv[i]; } }
                    } else {
#pragma unroll 4
                        for (int r = r0; r < r0 + PR / 4; ++r) { const int sp = s0 + r; const int st = max(sp - lo, 0), en = min(sp + hi + 1, SEQ);
                            const f32x2 d = run * __builtin_amdgcn_rcpf((float)(en - st)) - POOL_LD2(r + 8);
                            *(LAS unsigned*)(Db + r * 264 + 2 * c2) = cvt_pk_bf16(d[0], d[1]);
                            run += POOL_LD2(r + 9 + hi) - POOL_LD2(r + 8 - lo); }
                    }
#undef POOL_LD2
                }
                __syncthreads();
                { const int g = wave >> 1, rh = wave & 1, fr = lane & 15, fq = lane >> 4;
#pragma unroll
                    for (int rt = 0; rt < PR / 32; ++rt) {
                        bf16x8 af[2];
#pragma unroll
                        for (int ks = 0; ks < 2; ++ks) af[ks] = *(const LAS bf16x8*)(Db + (rh * (PR / 2) + rt * 16 + fr) * 264 + g * 64 + ks * 32 + 8 * fq);
#pragma unroll
                        for (int ct = 0; ct < 4; ++ct) { f32x4 c = (f32x4){0.f, 0.f, 0.f, 0.f};
#pragma unroll
                            for (int ks = 0; ks < 2; ++ks) c = __builtin_amdgcn_mfma_f32_16x16x32_bf16(af[ks], wfp[ct][ks], c, 0, 0, 0);
                            const int col = g * 64 + ct * 16 + fr; const float sc = scp[ct];
#pragma unroll
                            for (int j = 0; j < 4; ++j) Ub[(rh * (PR / 2) + rt * 16 + fq * 4 + j) * 264 + col] = (bf16)(cvt_pk_bf16(c[j] * sc, 0.f) & 0xffffu); } } }
                __syncthreads();
#pragma unroll
                for (int q = 0; q < PR / 16; ++q) { const int i = tid + q * NTHREADS, r = i >> 5, c8 = i & 31; *(u32x4*)(cat + (t0 + r) * D + c8 * 8) = *(const LAS u32x4*)(Ub + r * 264 + c8 * 8); }
                __syncthreads();
            }
        }
    }
}

__device__ __forceinline__ void ln_row16r(float* v, const f32x4* gv, const f32x4* bv, int lane) {
    float s = 0.f;
#pragma unroll
    for (int i = 0; i < 16; ++i) s += v[i];
    const float mean = wave_sum(s, lane) * (1.f / D); float s2 = 0.f;
#pragma unroll
    for (int i = 0; i < 16; ++i) { v[i] -= mean; s2 += v[i] * v[i]; }
    const float rstd = __builtin_amdgcn_rsqf(wave_sum(s2, lane) * (1.f / D) + LN_EPS);
#pragma unroll
    for (int q = 0; q < 4; ++q)
#pragma unroll
        for (int i = 0; i < 4; ++i) v[4 * q + i] = v[4 * q + i] * rstd * gv[q][i] + bv[q][i];
}
__device__ __forceinline__ void phase_ln1_router(KArgP ka, const int wave_s, int l, LAS unsigned char* lds, int bid, int G) {
    PHASE_BEGIN();
    const int lane = tid & 63, wave = __builtin_amdgcn_readfirstlane(tid >> 6), fr = lane & 15, fq = lane >> 4;
    unsigned char* ws = ka->ws;
    const bf16* zb = (const bf16*)(ws + WS_ZB); bf16* xb = (bf16*)(ws + WS_XB);
    const float* g = ka->in[I_LN1G] + (size_t)l * D; const float* bta = ka->in[I_LN1B] + (size_t)l * D;
    const float* rbias = ka->in[I_RB] + (size_t)l * NE;
    int* tok_e = (int*)(ws + TOK_E); float* tok_g = (float*)(ws + TOK_G); int* tok_r = (int*)(ws + TOK_R); int* hist = (int*)(ws + TAB_HIST);
    int* row_tok = (int*)(ws + ROW_TOK);
    for (int i = bid * NTHREADS + tid; i < NCH * CH_SLOTS; i += G * NTHREADS) row_tok[i] = 0;
    LAS bf16* Xh = (LAS bf16*)lds;
    LAS float* Lg = (LAS float*)(lds + 32 * 2064);
    LAS int* hl = (LAS int*)(lds + 32 * 2064 + 65536);
    const int kw = wave * 128;
    bf16x8 wf[4][2][4];
#pragma unroll
    for (int ct = 0; ct < 4; ++ct)
#pragma unroll
        for (int part = 0; part < 2; ++part)
#pragma unroll
            for (int ks = 0; ks < 4; ++ks) wf[ct][part][ks] = *(const bf16x8*)((const bf16*)(ws + (part ? W_RTL : W_RT)) + (size_t)(ct * 16 + fr) * D + kw + ks * 32 + 8 * fq);
    const float rb = rbias[lane];
    f32x4 gv[4], bv[4];
#pragma unroll
    for (int q = 0; q < 4; ++q) { gv[q] = *(const f32x4*)(g + 8 * lane + 512 * (q >> 1) + 4 * (q & 1)); bv[q] = *(const f32x4*)(bta + 8 * lane + 512 * (q >> 1) + 4 * (q & 1)); }
#pragma unroll 1
    for (int tb = bid; tb < NTB; tb += G) {
        if (tid < 64) hl[tid] = 0;
        __syncthreads();
        u32x4 zv[4][2];
#pragma unroll
        for (int rr = 0; rr < 4; ++rr) { const size_t t = (size_t)tb * TBLK + wave * 4 + rr;
#pragma unroll
            for (int j = 0; j < 2; ++j) zv[rr][j] = __builtin_nontemporal_load((const u32x4*)(zb + t * D + 8 * lane + 512 * j)); }
#pragma unroll 1
        for (int st = 0; st < 8; ++st) {
            {
#pragma unroll
                for (int rr = 0; rr < 4; ++rr) { const int lr = wave * 4 + rr; const size_t t = (size_t)tb * TBLK + st * 32 + lr;
                    float v[16]; unpack8(zv[rr][0], v); unpack8(zv[rr][1], v + 8);
                    ln_row16r(v, gv, bv, lane);
#pragma unroll
                    for (int j = 0; j < 2; ++j) { const u32x4 w = pack8(v + 8 * j); *(u32x4*)(xb + t * D + 8 * lane + 512 * j) = w; *(LAS u32x4*)(Xh + lr * 1032 + 8 * lane + 512 * j) = w;
                        } }
                if (st < 7) {
#pragma unroll
                    for (int rr = 0; rr < 4; ++rr) { const size_t t = (size_t)tb * TBLK + (st + 1) * 32 + wave * 4 + rr;
#pragma unroll
                        for (int j = 0; j < 2; ++j) zv[rr][j] = __builtin_nontemporal_load((const u32x4*)(zb + t * D + 8 * lane + 512 * j)); } } }
            __syncthreads();
#pragma unroll
            for (int rt = 0; rt < 2; ++rt) { bf16x8 a[4];
#pragma unroll
                for (int ks = 0; ks < 4; ++ks) a[ks] = *(const LAS bf16x8*)(Xh + (rt * 16 + fr) * 1032 + kw + ks * 32 + 8 * fq);
#pragma unroll
                for (int ct = 0; ct < 4; ++ct) { f32x4 c = (f32x4){0.f, 0.f, 0.f, 0.f};
#pragma unroll
                    for (int ks = 0; ks < 4; ++ks) { c = __builtin_amdgcn_mfma_f32_16x16x32_bf16(a[ks], wf[ct][0][ks], c, 0, 0, 0); c = __builtin_amdgcn_mfma_f32_16x16x32_bf16(a[ks], wf[ct][1][ks], c, 0, 0, 0); }
#pragma unroll
                    for (int j = 0; j < 4; ++j) Lg[(wave * 32 + rt * 16 + fq * 4 + j) * 64 + ct * 16 + fr] = c[j]; } }
            __syncthreads();
#pragma unroll 1
            for (int rr = 0; rr < 4; ++rr) { const int lr = wave * 4 + rr; const size_t t = (size_t)tb * TBLK + st * 32 + lr;
                float lg = 0.f;
#pragma unroll
                for (int w = 0; w < NWAVES; ++w) lg += Lg[(w * 32 + lr) * 64 + lane];
                const float sc = fast_sigmoid(lg); float sel = sc + rb;
                Lg[lr * 64 + lane] = sel;
                int r4[4] = {0, 0, 0, 0};
#pragma unroll
                for (int j4 = 0; j4 < 16; ++j4) { const f32x4 q = *(const LAS f32x4*)(Lg + lr * 64 + 4 * j4);
#pragma unroll
                    for (int c = 0; c < 4; ++c) r4[c] += (q[c] > sel) ? 1 : 0; }
                const bool selb = ((r4[0] + r4[1]) + (r4[2] + r4[3])) < TOPK; const unsigned long long smask = __ballot(selb);
                if (__popcll(smask) == TOPK) {
                    const int k = (int)__builtin_amdgcn_mbcnt_hi((unsigned)(smask >> 32), __builtin_amdgcn_mbcnt_lo((unsigned)smask, 0u));
                    const float ssum = wave_sum(selb ? sc : 0.f, lane);
                    if (selb) { const int rank = __hip_atomic_fetch_add(&hl[lane], 1, __ATOMIC_RELAXED, __HIP_MEMORY_SCOPE_WORKGROUP);
                        tok_e[t * TOPK + k] = lane; tok_g[t * TOPK + k] = sc * __builtin_amdgcn_rcpf(ssum) * ROUTED_SCALE; tok_r[t * TOPK + k] = rank; }
                } else {
                    int my_e = 0; float my_s = 0.f, ssum = 0.f;
#pragma unroll 1
                    for (int k = 0; k < TOPK; ++k) { const float m = wave_max(sel, lane); const unsigned long long mask = __ballot(sel == m); const int idx = mask ? (__ffsll((long long)mask) - 1) : k;
                        const float sk = rl_f(sc, idx); ssum += sk; if (lane == idx) sel = -3.0e38f; if (lane == k) { my_e = idx; my_s = sk; } }
                    if (lane < TOPK) { const int rank = __hip_atomic_fetch_add(&hl[my_e], 1, __ATOMIC_RELAXED, __HIP_MEMORY_SCOPE_WORKGROUP);
                        tok_e[t * TOPK + lane] = my_e; tok_g[t * TOPK + lane] = my_s / ssum * ROUTED_SCALE; tok_r[t * TOPK + lane] = rank; }
                }
            }
            __syncthreads();
        }
        if (tid < 64) hist[tb * 64 + tid] = hl[tid];
        __syncthreads();
    }
}

__device__ __forceinline__ void phase_scatter(KArgP ka, const int wave_s, LAS unsigned char* lds, int bid, int G) {
    PHASE_BEGIN();
    const int lane = tid & 63;
    unsigned char* ws = ka->ws;
    const int* tok_e = (const int*)(ws + TOK_E); const int* tok_r = (const int*)(ws + TOK_R); int* slot_of = (int*)(ws + TOK_SLOT);
    const int* hist = (const int*)(ws + TAB_HIST); int* ntiles = (int*)(ws + TAB_NT); int* tile_e = (int*)(ws + TAB_TE);
    int* row_tok = (int*)(ws + ROW_TOK);
    LAS int* ptot = (LAS int*)lds; LAS int* pbef = ptot + 512; LAS int* base = pbef + 512;
    for (int tb = bid; tb < NTB; tb += G) {
        const int ch = tb / TB_PER_CH;
        int te[TBLK * TOPK / NTHREADS], tr[TBLK * TOPK / NTHREADS];
#pragma unroll
        for (int j = 0; j < TBLK * TOPK / NTHREADS; ++j) { const size_t i = (size_t)tb * TBLK * TOPK + tid + j * NTHREADS; te[j] = tok_e[i]; tr[j] = tok_r[i]; }
        { const int e = tid & 63, part = tid >> 6; int tot = 0, bef = 0;
            for (int j = 0; j < TB_PER_CH / 8; ++j) { const int blk = ch * TB_PER_CH + part * (TB_PER_CH / 8) + j; const int v = hist[blk * 64 + e]; tot += v; if (blk < tb) bef += v; }
            ptot[part * 64 + e] = tot; pbef[part * 64 + e] = bef; }
        __syncthreads();
        if (tid < 64) { int tot = 0, bef = 0;
#pragma unroll
            for (int p = 0; p < 8; ++p) { tot += ptot[p * 64 + tid]; bef += pbef[p * 64 + tid]; }
            const int padded = (tot + 255) & ~255; int inc = padded;
#pragma unroll
            for (int o = 1; o < 64; o <<= 1) { const int v = bperm_i((lane - o) & 63, inc); if (lane >= o) inc += v; }
            const int ebase = inc - padded;
            base[tid] = ebase + bef;
            if (tb % TB_PER_CH == 0) { if (tid == 63) ntiles[ch] = inc >> 8; for (int j = 0; j < (padded >> 8); ++j) tile_e[ch * CH_TILES_MAX + (ebase >> 8) + j] = tid; }
        }
        __syncthreads();
#pragma unroll
        for (int j = 0; j < TBLK * TOPK / NTHREADS; ++j) { const size_t i = (size_t)tb * TBLK * TOPK + tid + j * NTHREADS; const int slot = ch * CH_SLOTS + base[te[j]] + tr[j];
            row_tok[slot] = (int)(i >> 3); slot_of[i] = slot; }
        __syncthreads();
    }
}

__device__ __forceinline__ void add_fp8x16(const u32x4 w, float* v, float g) {
#pragma unroll
    for (int q = 0; q < 4; ++q) { const f32x2 a = __builtin_amdgcn_cvt_pk_f32_fp8((int)w[q], false), b = __builtin_amdgcn_cvt_pk_f32_fp8((int)w[q], true);
        v[4 * q] += a[0] * g; v[4 * q + 1] += a[1] * g; v[4 * q + 2] += b[0] * g; v[4 * q + 3] += b[1] * g; }
}
__device__ __forceinline__ void phase_combine_ln2(KArgP ka, const int wave_s, int l, int ch, int bid, int G) {
    PHASE_BEGIN();
    const int lane = tid & 63, wave = __builtin_amdgcn_readfirstlane(tid >> 6);
    unsigned char* ws = ka->ws;
    float* dout = ka->out; bf16* xb = (bf16*)(ws + WS_XB); const bf16* zb = (const bf16*)(ws + WS_ZB); const unsigned char* Y = (const unsigned char*)(ws + WS_Y); const int* slot_of = (const int*)(ws + TOK_SLOT);
    const float* tok_g = (const float*)(ws + TOK_G);
    const float* g = ka->in[I_LN2G] + (size_t)l * D; const float* bta = ka->in[I_LN2B] + (size_t)l * D;
    const bool last = (l == DEPTH - 1);
    f32x4 gg[4], bb[4];
#pragma unroll
    for (int q = 0; q < 4; ++q) { gg[q] = *(const f32x4*)(g + 16 * lane + 4 * q); bb[q] = *(const f32x4*)(bta + 16 * lane + 4 * q); }
#pragma unroll 1
    for (int q0 = bid * NWAVES + wave; q0 < CH_TOK; q0 += G * NWAVES) { const size_t t = (size_t)ch * CH_TOK + q0;
        int sl[TOPK]; float gk[TOPK];
#pragma unroll
        for (int k = 0; k < TOPK; ++k) { sl[k] = __builtin_amdgcn_readfirstlane(slot_of[t * TOPK + k]) - ch * CH_SLOTS; gk[k] = __int_as_float(__builtin_amdgcn_readfirstlane(__float_as_int(tok_g[t * TOPK + k]))) * Y_INV; }
        u32x4 zv[2], yv[TOPK];
#pragma unroll
        for (int j = 0; j < 2; ++j) zv[j] = __builtin_nontemporal_load((const u32x4*)(zb + t * D + 16 * lane + 8 * j));
#pragma unroll
        for (int k = 0; k < TOPK; ++k) yv[k] = __builtin_nontemporal_load((const u32x4*)(Y + ((size_t)(sl[k] >> 8) * 4 + (lane >> 4)) * 65536 + (sl[k] & 255) * 256 + (lane & 15) * 16));
        float y[16];
#pragma unroll
        for (int i = 0; i < 16; ++i) y[i] = 0.f;
#pragma unroll
        for (int k = 0; k < TOPK; ++k) add_fp8x16(yv[k], y, gk[k]);
        float v[16]; unpack8(zv[0], v); unpack8(zv[1], v + 8);
        float s = 0.f;
#pragma unroll
        for (int i = 0; i < 16; ++i) { v[i] += y[i]; s += v[i]; }
        const float mean = wave_sum(s, lane) * (1.f / D); float s2 = 0.f;
#pragma unroll
        for (int i = 0; i < 16; ++i) { v[i] -= mean; s2 += v[i] * v[i]; }
        const float rstd = __builtin_amdgcn_rsqf(wave_sum(s2, lane) * (1.f / D) + LN_EPS);
#pragma unroll
        for (int q = 0; q < 4; ++q)
#pragma unroll
            for (int i = 0; i < 4; ++i) v[4 * q + i] = v[4 * q + i] * rstd * gg[q][i] + bb[q][i];
        if (!last) {
#pragma unroll
            for (int j = 0; j < 2; ++j) *(u32x4*)(xb + t * D + 16 * lane + 8 * j) = pack8(v + 8 * j); }
        if (last) {
#pragma unroll
            for (int q = 0; q < 4; ++q) *(f32x4*)(dout + t * D + 16 * lane + 4 * q) = (f32x4){v[4 * q], v[4 * q + 1], v[4 * q + 2], v[4 * q + 3]}; }
    }
}

__device__ __forceinline__ void phase_gemm_kv(KArgP ka, const int wave_s, LAS unsigned char* lds, int bid, int G) {
    PHASE_BEGIN();
    unsigned char* ws = ka->ws;
    ge::SchedKV S{(const char*)(ws + WS_MEMN), (const char*)(ws + WS_MEMP), (const char*)(ws + WS_WKV), (char*)(ws + WS_KB), (char*)(ws + WS_VT), G, bid};
    ge::EpiBf16 E;
    ge::gemm_phase<D, false, ge::EpiBf16, ge::SchedKV>(tid, lds, (const LAS int*)(lds + LDS_TBL), S, E);
}
__device__ __forceinline__ void phase_gemm_in(KArgP ka, const int wave_s, LAS unsigned char* lds, int bid, int G) {
    PHASE_BEGIN();
    unsigned char* ws = ka->ws;
    ge::SchedDense<D> S{(const char*)(ws + WS_XB), (const char*)(ws + WS_WIN), (char*)(ws + U_PROJ), NPROJ, T / 256, NPROJ / 256, G, bid};
    ge::EpiBf16 E;
    ge::gemm_phase<D, false, ge::EpiBf16, ge::SchedDense<D>>(tid, lds, (const LAS int*)(lds + LDS_TBL), S, E);
}
__device__ __forceinline__ void phase_gemm_out(KArgP ka, const int wave_s, int l, LAS unsigned char* lds, int bid, int G) {
    PHASE_BEGIN();
    unsigned char* ws = ka->ws;
    ge::SchedDense<D> S{(const char*)(ws + U_CAT), (const char*)(ws + WS_WOUT), (char*)(ws + WS_ZB), D, T / 256, D / 256, G, bid};
    ge::EpiResBf16 E{(const bf16*)(ws + WS_XB), (bf16*)(ws + WS_ZB)};
    ge::gemm_phase<D, false, ge::EpiResBf16, ge::SchedDense<D>>(tid, lds, (const LAS int*)(lds + LDS_TBL), S, E);
}
__device__ __forceinline__ void phase_gemm_gu(KArgP ka, const int wave_s, LAS unsigned char* lds, int bid, int G) {
    PHASE_BEGIN();
    unsigned char* ws = ka->ws;
    ge::SchedGU S{(const char*)(ws + WS_XB), (const char*)(ws + WS_WGU), (const char*)(ws + WS_WSGU), (char*)(ws + U_H), (const int*)(ws + TAB_NT), (const int*)(ws + TAB_TE), G, bid, {}};
    S.init();
    LAS int* tbl = (LAS int*)(lds + LDS_TBL);
    const int* row_tok = (const int*)(ws + ROW_TOK);
    { ge::Unit u; for (int i = 0; i < MAXU && S.next(i, u); ++i) { const int r = tid; if (r < 256) tbl[i * 256 + r] = (u.aux >= 0) ? (u.aux + r) : row_tok[u.row0 + r]; } }
    __syncthreads();
    ge::EpiSwiGLU E;
    ge::gemm_phase<D, true, ge::EpiSwiGLU, ge::SchedGU, (PROBE_TPH == 9 ? PROBE_T : 0)>(tid, lds, tbl, S, E);
}
__device__ __forceinline__ void phase_gemm_dn(KArgP ka, const int wave_s, int ch, LAS unsigned char* lds, int bid, int G) {
    PHASE_BEGIN();
    unsigned char* ws = ka->ws;
    ge::SchedDN S{(const char*)(ws + U_H), (const char*)(ws + WS_WD), (const char*)(ws + WS_WSD), (char*)(ws + WS_Y), (char*)(ws + WS_ZB), (const int*)(ws + TAB_TE), ch, ((const int*)(ws + TAB_NT))[ch], G, bid};
    ge::EpiDown E{(const float*)(ws + ROW_GATE), (const bf16*)(ws + WS_XB)};
    ge::gemm_phase<EH, false, ge::EpiDown, ge::SchedDN, (PROBE_TPH == 10 ? PROBE_T : 0), 1>(tid, lds, (const LAS int*)(lds + LDS_TBL), S, E);
}

#define KERNEL_HEAD extern __shared__ __attribute__((aligned(16))) unsigned char lds_raw[]; LAS unsigned char* lds = (LAS unsigned char*)lds_raw; const int bid = blockIdx.x, G = gridDim.x; KArgP ka = (KArgP)__builtin_amdgcn_kernarg_segment_ptr(); (void)a; const int wave_s = __builtin_amdgcn_readfirstlane((int)(threadIdx.x >> 6));
#if MK_ONE_LAUNCH
#define RUN(id, call) do { KA_OPAQUE(ka); call; if ((PROBE_DUP >> (id)) & 1) { grid_bar(bar, wave_s); KA_OPAQUE(ka); call; } } while (0)
__global__ void __launch_bounds__(NTHREADS, 2) k_mega(KArgs a) {
    KERNEL_HEAD
    volatile LAS unsigned* misc = (volatile LAS unsigned*)(lds + LDS_CTLW);
    if (threadIdx.x < 64) misc[threadIdx.x] = 0u;
    __syncthreads();
    const XcdBarrier bar = xcd_barrier_post((unsigned*)(ka->ws + WS_CTL), misc + 8, (int)threadIdx.x);
    RUN(1, phase_prologue(ka, wave_s, lds, bid, G));
    RUN(2, phase_convert_layer(ka, wave_s, 0, lds, bid, G));
    grid_bar(bar, wave_s);
    RUN(3, phase_gemm_kv(ka, wave_s, lds, bid, G));
#pragma unroll 1
    for (int l = 0; l < DEPTH; ++l) {
        RUN(4, phase_gemm_in(ka, wave_s, lds, bid, G));
        grid_bar(bar, wave_s);
        RUN(5, phase_mixers(ka, wave_s, l, lds, bid, G));
        grid_bar(bar, wave_s);
        RUN(6, phase_gemm_out(ka, wave_s, l, lds, bid, G));
        grid_bar(bar, wave_s);
        RUN(7, phase_ln1_router(ka, wave_s, l, lds, bid, G));
        grid_bar(bar, wave_s);
        RUN(8, phase_scatter(ka, wave_s, lds, bid, G));
        grid_bar(bar, wave_s);
        RUN(9, phase_gemm_gu(ka, wave_s, lds, bid, G));
        grid_bar(bar, wave_s);
#pragma unroll 1
        for (int c = 0; c < NCH; ++c) {
            RUN(10, phase_gemm_dn(ka, wave_s, c, lds, bid, G));
            grid_bar(bar, wave_s);
            RUN(11, phase_combine_ln2(ka, wave_s, l, c, bid, G));
            if (c == NCH - 1) { if (l == DEPTH - 1) break; RUN(2, phase_convert_layer(ka, wave_s, l + 1, lds, bid, G)); }
            grid_bar(bar, wave_s);
        }
    }
}
#else
__global__ void __launch_bounds__(NTHREADS, 2) k_prologue(KArgs a) { KERNEL_HEAD phase_prologue(ka, wave_s, lds, bid, G); }
__global__ void __launch_bounds__(NTHREADS, 2) k_convert(KArgs a) { KERNEL_HEAD phase_convert_layer(ka, wave_s, ka->layer, lds, bid, G); }
__global__ void __launch_bounds__(NTHREADS, 2) k_gemm_kv(KArgs a) { KERNEL_HEAD phase_gemm_kv(ka, wave_s, lds, bid, G); }
__global__ void __launch_bounds__(NTHREADS, 2) k_gemm_in(KArgs a) { KERNEL_HEAD phase_gemm_in(ka, wave_s, lds, bid, G); }
__global__ void __launch_bounds__(NTHREADS, 2) k_mixers(KArgs a) { KERNEL_HEAD phase_mixers(ka, wave_s, ka->layer, lds, bid, G); }
__global__ void __launch_bounds__(NTHREADS, 2) k_gemm_out(KArgs a) { KERNEL_HEAD phase_gemm_out(ka, wave_s, ka->layer, lds, bid, G); }
__global__ void __launch_bounds__(NTHREADS, 2) k_ln1_router(KArgs a) { KERNEL_HEAD phase_ln1_router(ka, wave_s, ka->layer, lds, bid, G); }
__global__ void __launch_bounds__(NTHREADS, 2) k_scatter(KArgs a) { KERNEL_HEAD phase_scatter(ka, wave_s, lds, bid, G); }
__global__ void __launch_bounds__(NTHREADS, 2) k_gemm_gu(KArgs a) { KERNEL_HEAD phase_gemm_gu(ka, wave_s, lds, bid, G); }
__global__ void __launch_bounds__(NTHREADS, 2) k_gemm_dn(KArgs a) { KERNEL_HEAD phase_gemm_dn(ka, wave_s, ka->chunk, lds, bid, G); }
__global__ void __launch_bounds__(NTHREADS, 2) k_combine(KArgs a) { KERNEL_HEAD (void)lds; phase_combine_ln2(ka, wave_s, ka->layer, ka->chunk, bid, G); }
#endif

extern "C" void kernel_launch(void* const* d_in, const int* in_sizes, int n_in, void* d_out, int out_size, void* d_ws, size_t ws_size, hipStream_t stream) {
    static int grid = 0;
    if (!grid) {
        if (n_in != 25 || out_size != T * D || ws_size < WS_END) { fprintf(stderr, "kernel_launch: unexpected shapes (n_in %d out %d ws %zu need %zu)\n", n_in, out_size, ws_size, (size_t)WS_END); grid = -1; return; }
        int dev = 0, cus = 0; (void)hipGetDevice(&dev); (void)hipDeviceGetAttribute(&cus, hipDeviceAttributeMultiprocessorCount, dev);
#if MK_ONE_LAUNCH
        const void* ks[] = {(const void*)k_mega};
#else
        const void* ks[] = {(const void*)k_prologue, (const void*)k_convert, (const void*)k_gemm_kv, (const void*)k_gemm_in, (const void*)k_mixers, (const void*)k_gemm_out, (const void*)k_ln1_router,
                            (const void*)k_scatter, (const void*)k_gemm_gu, (const void*)k_gemm_dn, (const void*)k_combine};
#endif
        for (const void* k : ks) if (hipFuncSetAttribute(k, hipFuncAttributeMaxDynamicSharedMemorySize, LDS_BYTES) != hipSuccess) { fprintf(stderr, "kernel_launch: hipFuncSetAttribute failed\n"); grid = -1; return; }
        grid = cus > 0 ? cus : 256; if (grid > 256) grid = 256;
#if MK_ONE_LAUNCH
        int per_cu = 0;
        if (hipOccupancyMaxActiveBlocksPerMultiprocessor(&per_cu, (const void*)k_mega, NTHREADS, LDS_BYTES) != hipSuccess || per_cu < 1) { fprintf(stderr, "kernel_launch: occupancy query says %d blocks per CU\n", per_cu); grid = -1; return; }
#endif
    }
    if (grid < 0) return;
    KArgs a{};
    for (int i = 0; i < 25; ++i) a.in[i] = (const float*)d_in[i];
    a.out = (float*)d_out; a.ws = (unsigned char*)d_ws; a.layer = 0; a.chunk = 0;
    const dim3 g(grid), b(NTHREADS);
#if MK_ONE_LAUNCH
    (void)hipMemsetAsync((char*)d_ws + WS_CTL, 0, 65536, stream);
    hipLaunchKernelGGL(k_mega, g, b, LDS_BYTES, stream, a);
#else
    hipLaunchKernelGGL(k_prologue, g, b, LDS_BYTES, stream, a);
    hipLaunchKernelGGL(k_gemm_kv, g, b, LDS_BYTES, stream, a);
    for (int l = 0; l < DEPTH; ++l) {
        a.layer = l; a.chunk = 0;
        hipLaunchKernelGGL(k_convert, g, b, LDS_BYTES, stream, a);
        hipLaunchKernelGGL(k_gemm_in, g, b, LDS_BYTES, stream, a);
        hipLaunchKernelGGL(k_mixers, g, b, LDS_BYTES, stream, a);
        hipLaunchKernelGGL(k_gemm_out, g, b, LDS_BYTES, stream, a);
        hipLaunchKernelGGL(k_ln1_router, g, b, LDS_BYTES, stream, a);
        hipLaunchKernelGGL(k_scatter, g, b, LDS_BYTES, stream, a);
        hipLaunchKernelGGL(k_gemm_gu, g, b, LDS_BYTES, stream, a);
        for (int c = 0; c < NCH; ++c) { a.chunk = c;
            hipLaunchKernelGGL(k_gemm_dn, g, b, LDS_BYTES, stream, a);
            hipLaunchKernelGGL(k_combine, g, b, LDS_BYTES, stream, a); }
    }
#endif
}
```
